# Optimizing an MI355X kernel written in HIP

```python
import math
import jax, jax.numpy as jnp
from jax import lax
import numpy as np

D_MODEL = 1024
BATCH = 2
SEQ = 8192
DEPTH = 2

CHUNK = 64
Q_BLOCK = 128
ROPE_THETA = 500000.0
ROPE_FRACTION = 4
NORM_EPS = 1e-6
N_MIXERS = 2
DIFF_HEAD_DIM = 64
DIFF_HEADS = D_MODEL // (2 * DIFF_HEAD_DIM)
DIFF_V_DIM = 2 * DIFF_HEAD_DIM
DSA_HEAD_DIM = 64
DSA_HEADS = D_MODEL // DSA_HEAD_DIM
DSA_Q_RANK = D_MODEL // 4
IDX_HEADS = 8
IDX_DIM = 64
TOPK_MAX = 256
D_FF = 4 * D_MODEL

N_DIFF_LAYERS = (DEPTH + 1) // 2
N_DSA_LAYERS = DEPTH // 2

kernel_name = "hybrid_diffattn_dsa_chunk_causal"


def rms_norm(x, g=None):
    xf = x.astype(jnp.float32)
    y = xf * lax.rsqrt(jnp.mean(xf * xf, axis=-1, keepdims=True) + NORM_EPS)
    if g is not None:
        y = y * g.astype(jnp.float32)
    return y.astype(x.dtype)


def rope_tables(positions, head_dim):
    rot = head_dim // ROPE_FRACTION
    inv = ROPE_THETA ** (-jnp.arange(0, rot, 2, dtype=jnp.float32) / rot)
    ang = positions.astype(jnp.float32)[..., None] * inv
    return jnp.cos(ang)[:, :, None, :], jnp.sin(ang)[:, :, None, :]


def apply_partial_rope(x, cos, sin):
    half = cos.shape[-1]
    rot = 2 * half
    x1 = x[..., :half].astype(jnp.float32)
    x2 = x[..., half:rot].astype(jnp.float32)
    r = jnp.concatenate([x1 * cos - x2 * sin, x2 * cos + x1 * sin], axis=-1).astype(x.dtype)
    return jnp.concatenate([r, x[..., rot:]], axis=-1)


def diff_attention(h, w_in, q_g, k_g, lam_q1, lam_k1, lam_q2, lam_k2, subln_g, w_out,
                   cos, sin, lam_init):
    B, S, _ = h.shape
    H, d = DIFF_HEADS, DIFF_HEAD_DIM
    proj = h @ w_in
    q, k, v = jnp.split(proj, [2 * H * d, 4 * H * d], axis=-1)
    q = apply_partial_rope(rms_norm(q.reshape(B, S, 2 * H, d), q_g), cos, sin) * (d ** -0.5)
    k = apply_partial_rope(rms_norm(k.reshape(B, S, 2 * H, d), k_g), cos, sin)
    q = q.reshape(B, S, H, 2, d)
    k = k.reshape(B, S, H, 2, d)
    v = v.reshape(B, S, H, DIFF_V_DIM)
    lam = (jnp.exp(jnp.sum(lam_q1.astype(jnp.float32) * lam_k1.astype(jnp.float32)))
           - jnp.exp(jnp.sum(lam_q2.astype(jnp.float32) * lam_k2.astype(jnp.float32)))
           + lam_init)
    n_blocks = S // Q_BLOCK
    key_chunk = jnp.arange(S) // CHUNK
    q_blocks = q.reshape(B, n_blocks, Q_BLOCK, H, 2, d).swapaxes(0, 1)

    def block(args):
        qb, start = args
        q_chunk = (start + jnp.arange(Q_BLOCK)) // CHUNK
        mask = key_chunk[None, :] <= q_chunk[:, None]
        s = jnp.einsum('bqhcd,bkhcd->bhcqk', qb, k).astype(jnp.float32)
        p = jax.nn.softmax(jnp.where(mask, s, -jnp.inf), axis=-1)
        a = p[:, :, 0] - lam * p[:, :, 1]
        return jnp.einsum('bhqk,bkhe->bqhe', a.astype(v.dtype), v)

    o = lax.map(block, (q_blocks, jnp.arange(n_blocks) * Q_BLOCK))
    o = o.swapaxes(0, 1).reshape(B, S, H, DIFF_V_DIM)
    o = rms_norm(o, subln_g) * (1.0 - lam_init)
    return o.reshape(B, S, H * DIFF_V_DIM) @ w_out


def dsa_attention(h, w_in, cq_g, w_uq, w_uq_idx, q_g, k_g, w_out, cos, sin):
    B, S, _ = h.shape
    H, d, R, HI, DI = DSA_HEADS, DSA_HEAD_DIM, DSA_Q_RANK, IDX_HEADS, IDX_DIM
    proj = h @ w_in
    c_q, k, v, k_idx, w_idx = jnp.split(
        proj, [R, R + H * d, R + 2 * H * d, R + 2 * H * d + DI], axis=-1)
    c_q = rms_norm(c_q, cq_g)
    q = (c_q @ w_uq).reshape(B, S, H, d)
    q_idx = apply_partial_rope((c_q @ w_uq_idx).reshape(B, S, HI, DI), cos, sin)
    k_idx = apply_partial_rope(rms_norm(k_idx)[:, :, None, :], cos, sin)[:, :, 0]
    w_idx = w_idx * ((HI ** -0.5) * (DI ** -0.5))
    q = apply_partial_rope(rms_norm(q, q_g), cos, sin) * (d ** -0.5)
    k = apply_partial_rope(rms_norm(k.reshape(B, S, H, d), k_g), cos, sin)
    v = v.reshape(B, S, H, d)
    topk = min(TOPK_MAX, S // 4)
    n_blocks = S // Q_BLOCK
    key_chunk = jnp.arange(S) // CHUNK
    qb_all = q.reshape(B, n_blocks, Q_BLOCK, H, d).swapaxes(0, 1)
    qib_all = q_idx.reshape(B, n_blocks, Q_BLOCK, HI, DI).swapaxes(0, 1)
    wb_all = w_idx.reshape(B, n_blocks, Q_BLOCK, HI).swapaxes(0, 1)
    gather = jax.vmap(lambda arr, ids: arr[ids])

    def block(args):
        qb, qib, wb, start = args
        q_chunk = (start + jnp.arange(Q_BLOCK)) // CHUNK
        mask = key_chunk[None, :] <= q_chunk[:, None]
        dots = jnp.einsum('bqhe,bke->bqhk', qib, k_idx).astype(jnp.float32)
        score = jnp.einsum('bqh,bqhk->bqk', wb.astype(jnp.float32), jax.nn.relu(dots))
        score = jnp.where(mask, score, -jnp.inf)
        vals, idx = lax.top_k(score, topk)
        valid = jnp.isfinite(vals)
        kg = gather(k, idx)
        vg = gather(v, idx)
        s = jnp.einsum('bqhd,bqkhd->bhqk', qb, kg).astype(jnp.float32)
        p = jax.nn.softmax(jnp.where(valid[:, None], s, -jnp.inf), axis=-1)
        return jnp.einsum('bhqk,bqkhd->bqhd', p.astype(vg.dtype), vg)

    o = lax.map(block, (qb_all, qib_all, wb_all, jnp.arange(n_blocks) * Q_BLOCK))
    o = o.swapaxes(0, 1).reshape(B, S, H * d)
    return o @ w_out


def sq_relu_mlp(h, w1, w2):
    u = jax.nn.relu(h @ w1)
    return (u * u) @ w2


def setup_inputs(seed: int = 0) -> dict:
    key = jax.random.key(seed)
    ks = iter(jax.random.split(key, 32))
    D = D_MODEL

    def nrm(shape, scale):
        return jax.random.normal(next(ks), shape, jnp.float32) * scale

    def gain(shape):
        return 1.0 + nrm(shape, 0.02)

    nA, nB = N_DIFF_LAYERS, N_DSA_LAYERS
    dsa_in = DSA_Q_RANK + 2 * DSA_HEADS * DSA_HEAD_DIM + IDX_DIM + IDX_HEADS
    x = nrm((BATCH, SEQ, D), 1.0)
    offset = jax.random.randint(next(ks), (BATCH, 1), 0, 4096, dtype=jnp.int32)
    positions = (offset + jnp.arange(SEQ, dtype=jnp.int32)[None, :]).astype(jnp.int32)
    return {
        "x": x,
        "positions": positions,
        "norm_mix": gain((DEPTH, D)),
        "norm_mlp": gain((DEPTH, D)),
        "mlp_w1": nrm((DEPTH, D, D_FF), D ** -0.5),
        "mlp_w2": nrm((DEPTH, D_FF, D), D_FF ** -0.5),
        "diff_w_in": nrm((nA, D, 6 * DIFF_HEADS * DIFF_HEAD_DIM), D ** -0.5),
        "diff_q_norm": gain((nA, DIFF_HEAD_DIM)),
        "diff_k_norm": gain((nA, DIFF_HEAD_DIM)),
        "diff_lam_q1": nrm((nA, DIFF_HEAD_DIM), 0.1),
        "diff_lam_k1": nrm((nA, DIFF_HEAD_DIM), 0.1),
        "diff_lam_q2": nrm((nA, DIFF_HEAD_DIM), 0.1),
        "diff_lam_k2": nrm((nA, DIFF_HEAD_DIM), 0.1),
        "diff_subln": gain((nA, DIFF_V_DIM)),
        "diff_w_out": nrm((nA, DIFF_HEADS * DIFF_V_DIM, D), (DIFF_HEADS * DIFF_V_DIM) ** -0.5),
        "dsa_w_in": nrm((nB, D, dsa_in), D ** -0.5),
        "dsa_cq_norm": gain((nB, DSA_Q_RANK)),
        "dsa_w_uq": nrm((nB, DSA_Q_RANK, DSA_HEADS * DSA_HEAD_DIM), DSA_Q_RANK ** -0.5),
        "dsa_w_uq_idx": nrm((nB, DSA_Q_RANK, IDX_HEADS * IDX_DIM), DSA_Q_RANK ** -0.5),
        "dsa_q_norm": gain((nB, DSA_HEAD_DIM)),
        "dsa_k_norm": gain((nB, DSA_HEAD_DIM)),
        "dsa_w_out": nrm((nB, DSA_HEADS * DSA_HEAD_DIM, D), (DSA_HEADS * DSA_HEAD_DIM) ** -0.5),
    }


def reference(x, positions, norm_mix, norm_mlp, mlp_w1, mlp_w2,
              diff_w_in, diff_q_norm, diff_k_norm, diff_lam_q1, diff_lam_k1,
              diff_lam_q2, diff_lam_k2, diff_subln, diff_w_out,
              dsa_w_in, dsa_cq_norm, dsa_w_uq, dsa_w_uq_idx, dsa_q_norm, dsa_k_norm,
              dsa_w_out):
    cos, sin = rope_tables(positions, DIFF_HEAD_DIM)
    for i in range(DEPTH):
        h = rms_norm(x, norm_mix[i])
        j = i // N_MIXERS
        if i % N_MIXERS == 0:
            lam_init = 0.8 - 0.6 * math.exp(-0.3 * i)
            mix = diff_attention(h, diff_w_in[j], diff_q_norm[j], diff_k_norm[j],
                                 diff_lam_q1[j], diff_lam_k1[j], diff_lam_q2[j],
                                 diff_lam_k2[j], diff_subln[j], diff_w_out[j],
                                 cos, sin, lam_init)
        else:
            mix = dsa_attention(h, dsa_w_in[j], dsa_cq_norm[j], dsa_w_uq[j],
                                dsa_w_uq_idx[j], dsa_q_norm[j], dsa_k_norm[j],
                                dsa_w_out[j], cos, sin)
        x = x + mix
        x = x + sq_relu_mlp(rms_norm(x, norm_mlp[i]), mlp_w1[i], mlp_w2[i])
    return x
```

```cpp
#include <hip/hip_runtime.h>
#include <stdint.h>
#include <math.h>
#include <hip/hip_runtime.h>
#include <stdint.h>
#include <math.h>

namespace nv {
constexpr int BATCH = 2, SEQ = 8192, DM = 1024, DFF = 4096, TOK = BATCH * SEQ;
constexpr float EPS = 1e-6f;

__global__ void k_rope_table(const int* __restrict__ pos, float* __restrict__ cs, int ntok) {
    int t = blockIdx.x * blockDim.x + threadIdx.x;
    if (t >= ntok) return;
    float p = (float)pos[t];
    for (int i = 0; i < 8; ++i) {
        float inv = (float)pow(500000.0, -(double)i / 8.0);
        float ang = p * inv;
        cs[t * 16 + i] = (float)cos((double)ang);
        cs[t * 16 + 8 + i] = (float)sin((double)ang);
    }
}

__global__ void k_rmsnorm(const float* __restrict__ x, int ldx, const float* __restrict__ g, float* __restrict__ out, int ldo, int nrows, int nh, int cols) {
    int r = blockIdx.x * (blockDim.x >> 6) + (threadIdx.x >> 6);
    int lane = threadIdx.x & 63;
    if (r >= nrows) return;
    const float* xp = x + (size_t)(r / nh) * ldx + (size_t)(r % nh) * cols;
    float* op = out + (size_t)(r / nh) * ldo + (size_t)(r % nh) * cols;
    float s = 0.f;
    for (int c = lane; c < cols; c += 64) { float v = xp[c]; s += v * v; }
    for (int o = 32; o > 0; o >>= 1) s += __shfl_xor(s, o);
    float rs = 1.0f / sqrtf(s / (float)cols + EPS);
    for (int c = lane; c < cols; c += 64) { float v = xp[c] * rs; if (g) v *= g[c]; op[c] = v; }
}

__global__ void k_rope(float* __restrict__ x, int ld, const float* __restrict__ cs, int tok0, int ntok, int nh, float scale) {
    int idx = blockIdx.x * blockDim.x + threadIdx.x;
    int total = ntok * nh * 64;
    if (idx >= total) return;
    int d = idx & 63, h = (idx >> 6) % nh, t = idx / (64 * nh);
    float* p = x + (size_t)t * ld + h * 64;
    const float* c = cs + (size_t)(tok0 + t) * 16;
    float v = p[d];
    float o = v;
    if (d < 8) { float x2 = p[d + 8]; o = v * c[d] - x2 * c[8 + d]; }
    else if (d < 16) { float x1 = p[d - 8]; o = v * c[d - 8] + x1 * c[8 + d - 8]; }
    __syncthreads();
    p[d] = o * scale;
}

__global__ void __launch_bounds__(256) k_gemm(const float* __restrict__ A, int lda, const float* __restrict__ W, int ldw, float* C, int ldc,
                                              const float* R, int M, int N, int K, int mode) {
    __shared__ float As[16][64 + 4];
    __shared__ float Ws[16][64 + 4];
    int bm = blockIdx.y * 64, bn = blockIdx.x * 64;
    int tx = threadIdx.x & 15, ty = threadIdx.x >> 4;
    float acc[4][4] = {};
    for (int k0 = 0; k0 < K; k0 += 16) {
        for (int i = threadIdx.x; i < 64 * 16; i += 256) {
            int m = i >> 4, k = i & 15;
            As[k][m] = A[(size_t)(bm + m) * lda + k0 + k];
        }
        for (int i = threadIdx.x; i < 16 * 64; i += 256) {
            int k = i >> 6, n = i & 63;
            Ws[k][n] = (bn + n < N) ? W[(size_t)(k0 + k) * ldw + bn + n] : 0.f;
        }
        __syncthreads();
#pragma unroll
        for (int k = 0; k < 16; ++k) {
            float a[4], b[4];
#pragma unroll
            for (int i = 0; i < 4; ++i) { a[i] = As[k][ty * 4 + i]; b[i] = Ws[k][tx * 4 + i]; }
#pragma unroll
            for (int i = 0; i < 4; ++i)
#pragma unroll
                for (int j = 0; j < 4; ++j) acc[i][j] += a[i] * b[j];
        }
        __syncthreads();
    }
    for (int i = 0; i < 4; ++i)
        for (int j = 0; j < 4; ++j) {
            int m = bm + ty * 4 + i, n = bn + tx * 4 + j;
            if (n < N) {
                float v = acc[i][j];
                if (mode == 1) { v = v > 0.f ? v : 0.f; v = v * v; }
                else if (mode == 2) v += R[(size_t)m * ldc + n];
                C[(size_t)m * ldc + n] = v;
            }
        }
}

__global__ void __launch_bounds__(256) k_diff_attn(const float* __restrict__ q, const float* __restrict__ k, const float* __restrict__ v, int ld,
                                                   float* __restrict__ o, int ldo, const float* __restrict__ lamp, const float* __restrict__ subg, float one_minus_li) {
    __shared__ float Ks[2][32][68];
    __shared__ float Vs[32][128];
    __shared__ float Qs[2][16][64];
    __shared__ float Ss[2][16][32];
    __shared__ float Ls[2][16];
    const int qb = blockIdx.x, h = blockIdx.y, tid = threadIdx.x;
    const int q0 = qb * 16;
    const int ntile = (q0 / 64 + 1) * 2;
    for (int i = tid; i < 2 * 16 * 64; i += 256) { int c = i >> 10, qq = (i >> 6) & 15, d = i & 63; Qs[c][qq][d] = q[(size_t)(q0 + qq) * ld + (2 * h + c) * 64 + d]; }
    if (tid < 32) Ls[tid >> 4][tid & 15] = 0.f;
    float acc[2][8];
    for (int c = 0; c < 2; ++c) for (int i = 0; i < 8; ++i) acc[c][i] = 0.f;
    const int dd = tid & 127, qh = tid >> 7;
    const int j = tid & 31, g = tid >> 5, cc = g >> 2, qg = (g & 3) * 4;
    __syncthreads();
    for (int t = 0; t < ntile; ++t) {
        for (int i = tid; i < 2 * 32 * 64; i += 256) { int c = i >> 11, kk = (i >> 6) & 31, d = i & 63; Ks[c][kk][d] = k[(size_t)(t * 32 + kk) * ld + (2 * h + c) * 64 + d]; }
        for (int i = tid; i < 32 * 128; i += 256) { int kk = i >> 7, d = i & 127; Vs[kk][d] = v[(size_t)(t * 32 + kk) * ld + h * 128 + d]; }
        __syncthreads();
        {
            float s[4] = {0.f, 0.f, 0.f, 0.f};
            for (int d4 = 0; d4 < 16; ++d4) {
                float4 k4 = *(const float4*)&Ks[cc][j][d4 * 4];
#pragma unroll
                for (int i = 0; i < 4; ++i) { float4 q4 = *(const float4*)&Qs[cc][qg + i][d4 * 4]; s[i] += k4.x * q4.x + k4.y * q4.y + k4.z * q4.z + k4.w * q4.w; }
            }
#pragma unroll
            for (int i = 0; i < 4; ++i) Ss[cc][qg + i][j] = expf(s[i]);
        }
        __syncthreads();
        if (tid < 32) { int c = tid >> 4, qq = tid & 15; float l = 0.f; for (int jj = 0; jj < 32; ++jj) l += Ss[c][qq][jj]; Ls[c][qq] += l; }
        for (int j4 = 0; j4 < 8; ++j4) {
            float v0 = Vs[j4 * 4 + 0][dd], v1 = Vs[j4 * 4 + 1][dd], v2 = Vs[j4 * 4 + 2][dd], v3 = Vs[j4 * 4 + 3][dd];
#pragma unroll
            for (int c = 0; c < 2; ++c)
#pragma unroll
                for (int i = 0; i < 8; ++i) { float4 s4 = *(const float4*)&Ss[c][qh * 8 + i][j4 * 4]; acc[c][i] += s4.x * v0 + s4.y * v1 + s4.z * v2 + s4.w * v3; }
        }
        __syncthreads();
    }
    const float lam = lamp[0];
    float* red = &Ks[0][0][0];
    for (int i = 0; i < 8; ++i) { float val = acc[0][i] / Ls[0][qh * 8 + i] - lam * acc[1][i] / Ls[1][qh * 8 + i]; acc[0][i] = val; red[(qh * 8 + i) * 128 + dd] = val * val; }
    __syncthreads();
    float* ssum = &Ss[0][0][0];
    if (tid < 16) { float s = 0.f; for (int d = 0; d < 128; ++d) s += red[tid * 128 + d]; ssum[tid] = 1.0f / sqrtf(s / 128.f + EPS); }
    __syncthreads();
    for (int i = 0; i < 8; ++i) { int qq = qh * 8 + i; o[(size_t)(q0 + qq) * ldo + h * 128 + dd] = acc[0][i] * ssum[qq] * subg[dd] * one_minus_li; }
}

__global__ void k_lambda(const float* q1, const float* k1, const float* q2, const float* k2, float lam_init, float* out) {
    if (threadIdx.x == 0 && blockIdx.x == 0) {
        float s1 = 0.f, s2 = 0.f;
        for (int i = 0; i < 64; ++i) { s1 += q1[i] * k1[i]; s2 += q2[i] * k2[i]; }
        out[0] = expf(s1) - expf(s2) + lam_init;
    }
}

__global__ void __launch_bounds__(256) k_idx_scores(const float* __restrict__ qi, int ldq, const float* __restrict__ ki, int ldk, const float* __restrict__ wi, int ldw,
                                                    float* __restrict__ S, int q0) {
    __shared__ float Qs[16][512];
    __shared__ float Kt[64][68];
    __shared__ float Wq[16][8];
    const int qb = blockIdx.y, kb = blockIdx.x, tid = threadIdx.x;
    const int qs = q0 + qb * 16;
    const int kk0 = kb * 64;
    const int j = tid & 63, g = tid >> 6;
    float* Sp = S + (size_t)(qb * 16) * SEQ;
    if (kk0 / 64 > qs / 64) { for (int i = 0; i < 4; ++i) Sp[(size_t)(g * 4 + i) * SEQ + kk0 + j] = -INFINITY; return; }
    for (int i = tid; i < 16 * 512; i += 256) Qs[i >> 9][i & 511] = qi[(size_t)(qs + (i >> 9)) * ldq + (i & 511)];
    for (int i = tid; i < 64 * 64; i += 256) Kt[i >> 6][i & 63] = ki[(size_t)(kk0 + (i >> 6)) * ldk + (i & 63)];
    if (tid < 128) Wq[tid >> 3][tid & 7] = wi[(size_t)(qs + (tid >> 3)) * ldw + (tid & 7)];
    __syncthreads();
    for (int i = 0; i < 4; ++i) {
        int qq = g * 4 + i;
        float sc = 0.f;
        for (int hh = 0; hh < 8; ++hh) {
            float d = 0.f;
            for (int d4 = 0; d4 < 16; ++d4) { float4 k4 = *(const float4*)&Kt[j][d4 * 4]; float4 q4 = *(const float4*)&Qs[qq][hh * 64 + d4 * 4]; d += k4.x * q4.x + k4.y * q4.y + k4.z * q4.z + k4.w * q4.w; }
            sc += Wq[qq][hh] * fmaxf(d, 0.f);
        }
        Sp[(size_t)qq * SEQ + kk0 + j] = sc;
    }
}

__device__ __forceinline__ unsigned f2ord(float f) { unsigned u = __float_as_uint(f); return (u & 0x80000000u) ? ~u : (u | 0x80000000u); }

__global__ void __launch_bounds__(256) k_topk(const float* __restrict__ S, int q0, int* __restrict__ idx_out, int* __restrict__ cnt_out) {
    __shared__ unsigned keys[SEQ];
    __shared__ unsigned hist[256];
    __shared__ unsigned sh_prefix, sh_krem, sh_cnt;
    __shared__ unsigned scan[256];
    const int qq = blockIdx.x, tid = threadIdx.x;
    const int qabs = q0 + qq;
    const int n = 64 * (qabs / 64 + 1);
    const float* row = S + (size_t)qq * SEQ;
    int* io = idx_out + (size_t)qabs * 256;
    if (n <= 256) { for (int i = tid; i < 256; i += 256) io[i] = i < n ? i : 0; if (tid == 0) cnt_out[qabs] = n; return; }
    for (int i = tid; i < n; i += 256) keys[i] = f2ord(row[i]);
    if (tid == 0) { sh_prefix = 0; sh_krem = 256; }
    __syncthreads();
    for (int pass = 0; pass < 4; ++pass) {
        const int shift = 24 - 8 * pass;
        hist[tid] = 0;
        __syncthreads();
        const unsigned prefix = sh_prefix;
        for (int i = tid; i < n; i += 256) { unsigned u = keys[i]; bool match = (pass == 0) || ((u >> (shift + 8)) == prefix); if (match) atomicAdd(&hist[(u >> shift) & 255], 1u); }
        __syncthreads();
        if (tid == 0) {
            unsigned krem = sh_krem, cum = 0; int b = 255;
            for (; b >= 0; --b) { if (cum + hist[b] >= krem) break; cum += hist[b]; }
            sh_prefix = (prefix << 8) | (unsigned)b; sh_krem = krem - cum;
        }
        __syncthreads();
    }
    const unsigned tau = sh_prefix; const unsigned krem = sh_krem;
    const int per = (n + 255) / 256; const int lo = tid * per, hi = min(n, lo + per);
    unsigned ties = 0; for (int i = lo; i < hi; ++i) ties += (keys[i] == tau);
    scan[tid] = ties; __syncthreads();
    if (tid == 0) { unsigned c = 0; for (int i = 0; i < 256; ++i) { unsigned t = scan[i]; scan[i] = c; c += t; } sh_cnt = 0; }
    __syncthreads();
    unsigned before = scan[tid];
    for (int i = lo; i < hi; ++i) {
        unsigned u = keys[i]; bool sel = u > tau;
        if (u == tau) { sel = before < krem; ++before; }
        if (sel) { unsigned p = atomicAdd(&sh_cnt, 1u); if (p < 256) io[p] = i; }
    }
    __syncthreads();
    if (tid == 0) cnt_out[qabs] = 256;
}

__global__ void __launch_bounds__(256) k_dsa_attn(const float* __restrict__ q, int ldq, const float* __restrict__ k, const float* __restrict__ v, int ld,
                                                  const int* __restrict__ idx, const int* __restrict__ cnt, float* __restrict__ o, int ldo) {
    __shared__ float Qs[1024];
    __shared__ float Ps[256];
    __shared__ float red[4];
    __shared__ int Is[256];
    const int qq = blockIdx.x, tid = threadIdx.x;
    const int n = cnt[qq];
    for (int i = tid; i < 1024; i += 256) Qs[i] = q[(size_t)qq * ldq + i];
    Is[tid] = idx[(size_t)qq * 256 + tid];
    __syncthreads();
    const int key = Is[tid];
    for (int h = 0; h < 16; ++h) {
        float s = -INFINITY;
        if (tid < n) { const float* kp = k + (size_t)key * ld + h * 64; float d = 0.f; for (int dd = 0; dd < 64; ++dd) d += Qs[h * 64 + dd] * kp[dd]; s = d; }
        float p = (tid < n) ? expf(s) : 0.f;
        Ps[tid] = p;
        float l = p;
        for (int of = 32; of > 0; of >>= 1) l += __shfl_xor(l, of);
        if ((tid & 63) == 0) red[tid >> 6] = l;
        __syncthreads();
        const float lsum = red[0] + red[1] + red[2] + red[3];
        const int d = tid & 63, part = tid >> 6;
        float acc = 0.f;
        for (int jj = part * 64; jj < min(n, part * 64 + 64); ++jj) acc += Ps[jj] * v[(size_t)Is[jj] * ld + h * 64 + d];
        __syncthreads();
        Ps[tid] = acc;
        __syncthreads();
        if (tid < 64) o[(size_t)qq * ldo + h * 64 + tid] = (Ps[tid] + Ps[64 + tid] + Ps[128 + tid] + Ps[192 + tid]) / lsum;
        __syncthreads();
    }
}

__global__ void k_scale_cols(float* x, int ld, int ntok, int ncols, float s) {
    int i = blockIdx.x * blockDim.x + threadIdx.x;
    if (i < ntok * ncols) x[(size_t)(i / ncols) * ld + (i % ncols)] *= s;
}
__global__ void k_copy(const float* a, float* b, size_t n) { size_t i = (size_t)blockIdx.x * blockDim.x + threadIdx.x; if (i < n) b[i] = a[i]; }
}
namespace nv {
constexpr size_t MB = 1u << 20;
constexpr size_t OFF_CS = 0, OFF_MISC = 1 * MB, OFF_H = 2 * MB, OFF_P = 34 * MB, OFF_Q = 130 * MB, OFF_QI = 162 * MB, OFF_S = 178 * MB, OFF_IDX = 210 * MB, OFF_CNT = 218 * MB;

static void gemm(hipStream_t st, const float* A, int lda, const float* W, int ldw, float* C, int ldc, const float* R, int M, int N, int K, int mode) {
    dim3 grid((N + 63) / 64, M / 64);
    hipLaunchKernelGGL(k_gemm, grid, dim3(256), 0, st, A, lda, W, ldw, C, ldc, R, M, N, K, mode);
}
static void rmsnorm(hipStream_t st, const float* x, int ldx, const float* g, float* out, int ldo, int nrows, int nh, int cols) {
    hipLaunchKernelGGL(k_rmsnorm, dim3((nrows + 3) / 4), dim3(256), 0, st, x, ldx, g, out, ldo, nrows, nh, cols);
}
static void rope(hipStream_t st, float* x, int ld, const float* cs, int tok0, int ntok, int nh, float scale) {
    int total = ntok * nh * 64;
    hipLaunchKernelGGL(k_rope, dim3((total + 255) / 256), dim3(256), 0, st, x, ld, cs, tok0, ntok, nh, scale);
}
static void mlp(hipStream_t st, char* ws, float* outb, const float* g, const float* w1, const float* w2) {
    float* H = (float*)(ws + OFF_H); float* U = (float*)(ws + OFF_P);
    for (int s = 0; s < 4; ++s) {
        float* xs = outb + (size_t)s * 2048 * DM;
        rmsnorm(st, xs, DM, g, H, DM, 2048, 1, DM);
        gemm(st, H, DM, w1, DFF, U, DFF, nullptr, 2048, DFF, DM, 1);
        gemm(st, U, DFF, w2, DM, xs, DM, xs, 2048, DM, DFF, 2);
    }
}

static void layer0_naive(hipStream_t st, void* const* d_in, char* ws, const float* xin_b, float* out_b, int b) {
    const float* norm_mix = (const float*)d_in[2]; const float* norm_mlp = (const float*)d_in[3];
    const float* w1 = (const float*)d_in[4]; const float* w2 = (const float*)d_in[5];
    const float* w_in = (const float*)d_in[6]; const float* qg = (const float*)d_in[7]; const float* kg = (const float*)d_in[8];
    const float* subln = (const float*)d_in[13]; const float* w_out = (const float*)d_in[14];
    float* CS = (float*)(ws + OFF_CS); float* LAM = (float*)(ws + OFF_MISC);
    float* H = (float*)(ws + OFF_H); float* P = (float*)(ws + OFF_P);
    rmsnorm(st, xin_b, DM, norm_mix, H, DM, SEQ, 1, DM);
    gemm(st, H, DM, w_in, 3072, P, 3072, nullptr, SEQ, 3072, DM, 0);
    rmsnorm(st, P, 3072, qg, P, 3072, SEQ * 16, 16, 64);
    rmsnorm(st, P + 1024, 3072, kg, P + 1024, 3072, SEQ * 16, 16, 64);
    rope(st, P, 3072, CS, b * SEQ, SEQ, 16, 0.125f);
    rope(st, P + 1024, 3072, CS, b * SEQ, SEQ, 16, 1.0f);
    hipLaunchKernelGGL(k_diff_attn, dim3(SEQ / 16, 8), dim3(256), 0, st, P, P + 1024, P + 2048, 3072, H, DM, LAM, subln, 0.8f);
    gemm(st, H, DM, w_out, DM, out_b, DM, xin_b, SEQ, DM, DM, 2);
    mlp(st, ws, out_b, norm_mlp, w1, w2);
}
static void layer1_naive(hipStream_t st, void* const* d_in, char* ws, float* out_b, int b) {
    const float* norm_mix = (const float*)d_in[2] + DM; const float* norm_mlp = (const float*)d_in[3] + DM;
    const float* w1 = (const float*)d_in[4] + (size_t)DM * DFF; const float* w2 = (const float*)d_in[5] + (size_t)DM * DFF;
    const float* w_in = (const float*)d_in[15]; const float* cqg = (const float*)d_in[16]; const float* w_uq = (const float*)d_in[17];
    const float* w_uqi = (const float*)d_in[18]; const float* qg = (const float*)d_in[19]; const float* kg = (const float*)d_in[20]; const float* w_out = (const float*)d_in[21];
    float* CS = (float*)(ws + OFF_CS);
    float* H = (float*)(ws + OFF_H); float* P = (float*)(ws + OFF_P); float* Q = (float*)(ws + OFF_Q); float* QI = (float*)(ws + OFF_QI);
    float* S = (float*)(ws + OFF_S); int* IDX = (int*)(ws + OFF_IDX); int* CNT = (int*)(ws + OFF_CNT);
    const int LD = 2376;
    rmsnorm(st, out_b, DM, norm_mix, H, DM, SEQ, 1, DM);
    gemm(st, H, DM, w_in, LD, P, LD, nullptr, SEQ, LD, DM, 0);
    rmsnorm(st, P, LD, cqg, P, LD, SEQ, 1, 256);
    gemm(st, P, LD, w_uq, DM, Q, DM, nullptr, SEQ, DM, 256, 0);
    gemm(st, P, LD, w_uqi, 512, QI, 512, nullptr, SEQ, 512, 256, 0);
    rope(st, QI, 512, CS, b * SEQ, SEQ, 8, 1.0f);
    rmsnorm(st, P + 2304, LD, nullptr, P + 2304, LD, SEQ, 1, 64);
    rope(st, P + 2304, LD, CS, b * SEQ, SEQ, 1, 1.0f);
    hipLaunchKernelGGL(k_scale_cols, dim3((SEQ * 8 + 255) / 256), dim3(256), 0, st, P + 2368, LD, SEQ, 8, 0.35355339059327373f * 0.125f);
    rmsnorm(st, Q, DM, qg, Q, DM, SEQ * 16, 16, 64);
    rope(st, Q, DM, CS, b * SEQ, SEQ, 16, 0.125f);
    rmsnorm(st, P + 256, LD, kg, P + 256, LD, SEQ * 16, 16, 64);
    rope(st, P + 256, LD, CS, b * SEQ, SEQ, 16, 1.0f);
    for (int s = 0; s < 8; ++s) {
        hipLaunchKernelGGL(k_idx_scores, dim3(SEQ / 64, 1024 / 16), dim3(256), 0, st, QI, 512, P + 2304, LD, P + 2368, LD, S, s * 1024);
        hipLaunchKernelGGL(k_topk, dim3(1024), dim3(256), 0, st, S, s * 1024, IDX, CNT);
    }
    hipLaunchKernelGGL(k_dsa_attn, dim3(SEQ), dim3(256), 0, st, Q, DM, P + 256, P + 1280, LD, IDX, CNT, H, DM);
    gemm(st, H, DM, w_out, DM, out_b, DM, out_b, SEQ, DM, DM, 2);
    mlp(st, ws, out_b, norm_mlp, w1, w2);
}
static void prep_naive(hipStream_t st, void* const* d_in, char* ws) {
    hipLaunchKernelGGL(k_rope_table, dim3(TOK / 256), dim3(256), 0, st, (const int*)d_in[1], (float*)(ws + OFF_CS), TOK);
    hipLaunchKernelGGL(k_lambda, dim3(1), dim3(64), 0, st, (const float*)d_in[9], (const float*)d_in[10], (const float*)d_in[11], (const float*)d_in[12], 0.2f, (float*)(ws + OFF_MISC));
}
}

extern "C" void kernel_launch(void* const* d_in, const int* in_sizes, int n_in, void* d_out, int out_size, void* d_ws, size_t ws_size, hipStream_t stream) {
    using namespace nv;
    char* ws = (char*)d_ws;
    const float* x = (const float*)d_in[0];
    float* out = (float*)d_out;
    prep_naive(stream, d_in, ws);
    for (int b = 0; b < BATCH; ++b) layer0_naive(stream, d_in, ws, x + (size_t)b * SEQ * DM, out + (size_t)b * SEQ * DM, b);
    for (int b = 0; b < BATCH; ++b) layer1_naive(stream, d_in, ws, out + (size_t)b * SEQ * DM, b);
}
```

```cpp
#include <hip/hip_runtime.h>
#include <stdint.h>
#include <math.h>
#include <hip/hip_runtime.h>
#include <stdint.h>
#include <math.h>

namespace nv {
constexpr int BATCH = 2, SEQ = 8192, DM = 1024, DFF = 4096, TOK = BATCH * SEQ;
constexpr float EPS = 1e-6f;

__global__ void k_rope_table(const int* __restrict__ pos, float* __restrict__ cs, int ntok) {
    int t = blockIdx.x * blockDim.x + threadIdx.x;
    if (t >= ntok) return;
    float p = (float)pos[t];
    for (int i = 0; i < 8; ++i) {
        float inv = (float)pow(500000.0, -(double)i / 8.0);
        float ang = p * inv;
        cs[t * 16 + i] = (float)cos((double)ang);
        cs[t * 16 + 8 + i] = (float)sin((double)ang);
    }
}

__global__ void k_rmsnorm(const float* __restrict__ x, int ldx, const float* __restrict__ g, float* __restrict__ out, int ldo, int nrows, int nh, int cols) {
    int r = blockIdx.x * (blockDim.x >> 6) + (threadIdx.x >> 6);
    int lane = threadIdx.x & 63;
    if (r >= nrows) return;
    const float* xp = x + (size_t)(r / nh) * ldx + (size_t)(r % nh) * cols;
    float* op = out + (size_t)(r / nh) * ldo + (size_t)(r % nh) * cols;
    float s = 0.f;
    for (int c = lane; c < cols; c += 64) { float v = xp[c]; s += v * v; }
    for (int o = 32; o > 0; o >>= 1) s += __shfl_xor(s, o);
    float rs = 1.0f / sqrtf(s / (float)cols + EPS);
    for (int c = lane; c < cols; c += 64) { float v = xp[c] * rs; if (g) v *= g[c]; op[c] = v; }
}

__global__ void k_rope(float* __restrict__ x, int ld, const float* __restrict__ cs, int tok0, int ntok, int nh, float scale) {
    int idx = blockIdx.x * blockDim.x + threadIdx.x;
    int total = ntok * nh * 64;
    if (idx >= total) return;
    int d = idx & 63, h = (idx >> 6) % nh, t = idx / (64 * nh);
    float* p = x + (size_t)t * ld + h * 64;
    const float* c = cs + (size_t)(tok0 + t) * 16;
    float v = p[d];
    float o = v;
    if (d < 8) { float x2 = p[d + 8]; o = v * c[d] - x2 * c[8 + d]; }
    else if (d < 16) { float x1 = p[d - 8]; o = v * c[d - 8] + x1 * c[8 + d - 8]; }
    __syncthreads();
    p[d] = o * scale;
}

__global__ void __launch_bounds__(256) k_gemm(const float* __restrict__ A, int lda, const float* __restrict__ W, int ldw, float* C, int ldc,
                                              const float* R, int M, int N, int K, int mode) {
    __shared__ float As[16][64 + 4];
    __shared__ float Ws[16][64 + 4];
    int bm = blockIdx.y * 64, bn = blockIdx.x * 64;
    int tx = threadIdx.x & 15, ty = threadIdx.x >> 4;
    float acc[4][4] = {};
    for (int k0 = 0; k0 < K; k0 += 16) {
        for (int i = threadIdx.x; i < 64 * 16; i += 256) {
            int m = i >> 4, k = i & 15;
            As[k][m] = A[(size_t)(bm + m) * lda + k0 + k];
        }
        for (int i = threadIdx.x; i < 16 * 64; i += 256) {
            int k = i >> 6, n = i & 63;
            Ws[k][n] = (bn + n < N) ? W[(size_t)(k0 + k) * ldw + bn + n] : 0.f;
        }
        __syncthreads();
#pragma unroll
        for (int k = 0; k < 16; ++k) {
            float a[4], b[4];
#pragma unroll
            for (int i = 0; i < 4; ++i) { a[i] = As[k][ty * 4 + i]; b[i] = Ws[k][tx * 4 + i]; }
#pragma unroll
            for (int i = 0; i < 4; ++i)
#pragma unroll
                for (int j = 0; j < 4; ++j) acc[i][j] += a[i] * b[j];
        }
        __syncthreads();
    }
    for (int i = 0; i < 4; ++i)
        for (int j = 0; j < 4; ++j) {
            int m = bm + ty * 4 + i, n = bn + tx * 4 + j;
            if (n < N) {
                float v = acc[i][j];
                if (mode == 1) { v = v > 0.f ? v : 0.f; v = v * v; }
                else if (mode == 2) v += R[(size_t)m * ldc + n];
                C[(size_t)m * ldc + n] = v;
            }
        }
}

__global__ void __launch_bounds__(256) k_diff_attn(const float* __restrict__ q, const float* __restrict__ k, const float* __restrict__ v, int ld,
                                                   float* __restrict__ o, int ldo, const float* __restrict__ lamp, const float* __restrict__ subg, float one_minus_li) {
    __shared__ float Ks[2][32][68];
    __shared__ float Vs[32][128];
    __shared__ float Qs[2][16][64];
    __shared__ float Ss[2][16][32];
    __shared__ float Ls[2][16];
    const int qb = blockIdx.x, h = blockIdx.y, tid = threadIdx.x;
    const int q0 = qb * 16;
    const int ntile = (q0 / 64 + 1) * 2;
    for (int i = tid; i < 2 * 16 * 64; i += 256) { int c = i >> 10, qq = (i >> 6) & 15, d = i & 63; Qs[c][qq][d] = q[(size_t)(q0 + qq) * ld + (2 * h + c) * 64 + d]; }
    if (tid < 32) Ls[tid >> 4][tid & 15] = 0.f;
    float acc[2][8];
    for (int c = 0; c < 2; ++c) for (int i = 0; i < 8; ++i) acc[c][i] = 0.f;
    const int dd = tid & 127, qh = tid >> 7;
    const int j = tid & 31, g = tid >> 5, cc = g >> 2, qg = (g & 3) * 4;
    __syncthreads();
    for (int t = 0; t < ntile; ++t) {
        for (int i = tid; i < 2 * 32 * 64; i += 256) { int c = i >> 11, kk = (i >> 6) & 31, d = i & 63; Ks[c][kk][d] = k[(size_t)(t * 32 + kk) * ld + (2 * h + c) * 64 + d]; }
        for (int i = tid; i < 32 * 128; i += 256) { int kk = i >> 7, d = i & 127; Vs[kk][d] = v[(size_t)(t * 32 + kk) * ld + h * 128 + d]; }
        __syncthreads();
        {
            float s[4] = {0.f, 0.f, 0.f, 0.f};
            for (int d4 = 0; d4 < 16; ++d4) {
                float4 k4 = *(const float4*)&Ks[cc][j][d4 * 4];
#pragma unroll
                for (int i = 0; i < 4; ++i) { float4 q4 = *(const float4*)&Qs[cc][qg + i][d4 * 4]; s[i] += k4.x * q4.x + k4.y * q4.y + k4.z * q4.z + k4.w * q4.w; }
            }
#pragma unroll
            for (int i = 0; i < 4; ++i) Ss[cc][qg + i][j] = expf(s[i]);
        }
        __syncthreads();
        if (tid < 32) { int c = tid >> 4, qq = tid & 15; float l = 0.f; for (int jj = 0; jj < 32; ++jj) l += Ss[c][qq][jj]; Ls[c][qq] += l; }
        for (int j4 = 0; j4 < 8; ++j4) {
            float v0 = Vs[j4 * 4 + 0][dd], v1 = Vs[j4 * 4 + 1][dd], v2 = Vs[j4 * 4 + 2][dd], v3 = Vs[j4 * 4 + 3][dd];
#pragma unroll
            for (int c = 0; c < 2; ++c)
#pragma unroll
                for (int i = 0; i < 8; ++i) { float4 s4 = *(const float4*)&Ss[c][qh * 8 + i][j4 * 4]; acc[c][i] += s4.x * v0 + s4.y * v1 + s4.z * v2 + s4.w * v3; }
        }
        __syncthreads();
    }
    const float lam = lamp[0];
    float* red = &Ks[0][0][0];
    for (int i = 0; i < 8; ++i) { float val = acc[0][i] / Ls[0][qh * 8 + i] - lam * acc[1][i] / Ls[1][qh * 8 + i]; acc[0][i] = val; red[(qh * 8 + i) * 128 + dd] = val * val; }
    __syncthreads();
    float* ssum = &Ss[0][0][0];
    if (tid < 16) { float s = 0.f; for (int d = 0; d < 128; ++d) s += red[tid * 128 + d]; ssum[tid] = 1.0f / sqrtf(s / 128.f + EPS); }
    __syncthreads();
    for (int i = 0; i < 8; ++i) { int qq = qh * 8 + i; o[(size_t)(q0 + qq) * ldo + h * 128 + dd] = acc[0][i] * ssum[qq] * subg[dd] * one_minus_li; }
}

__global__ void k_lambda(const float* q1, const float* k1, const float* q2, const float* k2, float lam_init, float* out) {
    if (threadIdx.x == 0 && blockIdx.x == 0) {
        float s1 = 0.f, s2 = 0.f;
        for (int i = 0; i < 64; ++i) { s1 += q1[i] * k1[i]; s2 += q2[i] * k2[i]; }
        out[0] = expf(s1) - expf(s2) + lam_init;
    }
}

__global__ void __launch_bounds__(256) k_idx_scores(const float* __restrict__ qi, int ldq, const float* __restrict__ ki, int ldk, const float* __restrict__ wi, int ldw,
                                                    float* __restrict__ S, int q0) {
    __shared__ float Qs[16][512];
    __shared__ float Kt[64][68];
    __shared__ float Wq[16][8];
    const int qb = blockIdx.y, kb = blockIdx.x, tid = threadIdx.x;
    const int qs = q0 + qb * 16;
    const int kk0 = kb * 64;
    const int j = tid & 63, g = tid >> 6;
    float* Sp = S + (size_t)(qb * 16) * SEQ;
    if (kk0 / 64 > qs / 64) { for (int i = 0; i < 4; ++i) Sp[(size_t)(g * 4 + i) * SEQ + kk0 + j] = -INFINITY; return; }
    for (int i = tid; i < 16 * 512; i += 256) Qs[i >> 9][i & 511] = qi[(size_t)(qs + (i >> 9)) * ldq + (i & 511)];
    for (int i = tid; i < 64 * 64; i += 256) Kt[i >> 6][i & 63] = ki[(size_t)(kk0 + (i >> 6)) * ldk + (i & 63)];
    if (tid < 128) Wq[tid >> 3][tid & 7] = wi[(size_t)(qs + (tid >> 3)) * ldw + (tid & 7)];
    __syncthreads();
    for (int i = 0; i < 4; ++i) {
        int qq = g * 4 + i;
        float sc = 0.f;
        for (int hh = 0; hh < 8; ++hh) {
            float d = 0.f;
            for (int d4 = 0; d4 < 16; ++d4) { float4 k4 = *(const float4*)&Kt[j][d4 * 4]; float4 q4 = *(const float4*)&Qs[qq][hh * 64 + d4 * 4]; d += k4.x * q4.x + k4.y * q4.y + k4.z * q4.z + k4.w * q4.w; }
            sc += Wq[qq][hh] * fmaxf(d, 0.f);
        }
        Sp[(size_t)qq * SEQ + kk0 + j] = sc;
    }
}

__device__ __forceinline__ unsigned f2ord(float f) { unsigned u = __float_as_uint(f); return (u & 0x80000000u) ? ~u : (u | 0x80000000u); }

__global__ void __launch_bounds__(256) k_topk(const float* __restrict__ S, int q0, int* __restrict__ idx_out, int* __restrict__ cnt_out) {
    __shared__ unsigned keys[SEQ];
    __shared__ unsigned hist[256];
    __shared__ unsigned sh_prefix, sh_krem, sh_cnt;
    __shared__ unsigned scan[256];
    const int qq = blockIdx.x, tid = threadIdx.x;
    const int qabs = q0 + qq;
    const int n = 64 * (qabs / 64 + 1);
    const float* row = S + (size_t)qq * SEQ;
    int* io = idx_out + (size_t)qabs * 256;
    if (n <= 256) { for (int i = tid; i < 256; i += 256) io[i] = i < n ? i : 0; if (tid == 0) cnt_out[qabs] = n; return; }
    for (int i = tid; i < n; i += 256) keys[i] = f2ord(row[i]);
    if (tid == 0) { sh_prefix = 0; sh_krem = 256; }
    __syncthreads();
    for (int pass = 0; pass < 4; ++pass) {
        const int shift = 24 - 8 * pass;
        hist[tid] = 0;
        __syncthreads();
        const unsigned prefix = sh_prefix;
        for (int i = tid; i < n; i += 256) { unsigned u = keys[i]; bool match = (pass == 0) || ((u >> (shift + 8)) == prefix); if (match) atomicAdd(&hist[(u >> shift) & 255], 1u); }
        __syncthreads();
        if (tid == 0) {
            unsigned krem = sh_krem, cum = 0; int b = 255;
            for (; b >= 0; --b) { if (cum + hist[b] >= krem) break; cum += hist[b]; }
            sh_prefix = (prefix << 8) | (unsigned)b; sh_krem = krem - cum;
        }
        __syncthreads();
    }
    const unsigned tau = sh_prefix; const unsigned krem = sh_krem;
    const int per = (n + 255) / 256; const int lo = tid * per, hi = min(n, lo + per);
    unsigned ties = 0; for (int i = lo; i < hi; ++i) ties += (keys[i] == tau);
    scan[tid] = ties; __syncthreads();
    if (tid == 0) { unsigned c = 0; for (int i = 0; i < 256; ++i) { unsigned t = scan[i]; scan[i] = c; c += t; } sh_cnt = 0; }
    __syncthreads();
    unsigned before = scan[tid];
    for (int i = lo; i < hi; ++i) {
        unsigned u = keys[i]; bool sel = u > tau;
        if (u == tau) { sel = before < krem; ++before; }
        if (sel) { unsigned p = atomicAdd(&sh_cnt, 1u); if (p < 256) io[p] = i; }
    }
    __syncthreads();
    if (tid == 0) cnt_out[qabs] = 256;
}

__global__ void __launch_bounds__(256) k_dsa_attn(const float* __restrict__ q, int ldq, const float* __restrict__ k, const float* __restrict__ v, int ld,
                                                  const int* __restrict__ idx, const int* __restrict__ cnt, float* __restrict__ o, int ldo) {
    __shared__ float Qs[1024];
    __shared__ float Ps[256];
    __shared__ float red[4];
    __shared__ int Is[256];
    const int qq = blockIdx.x, tid = threadIdx.x;
    const int n = cnt[qq];
    for (int i = tid; i < 1024; i += 256) Qs[i] = q[(size_t)qq * ldq + i];
    Is[tid] = idx[(size_t)qq * 256 + tid];
    __syncthreads();
    const int key = Is[tid];
    for (int h = 0; h < 16; ++h) {
        float s = -INFINITY;
        if (tid < n) { const float* kp = k + (size_t)key * ld + h * 64; float d = 0.f; for (int dd = 0; dd < 64; ++dd) d += Qs[h * 64 + dd] * kp[dd]; s = d; }
        float p = (tid < n) ? expf(s) : 0.f;
        Ps[tid] = p;
        float l = p;
        for (int of = 32; of > 0; of >>= 1) l += __shfl_xor(l, of);
        if ((tid & 63) == 0) red[tid >> 6] = l;
        __syncthreads();
        const float lsum = red[0] + red[1] + red[2] + red[3];
        const int d = tid & 63, part = tid >> 6;
        float acc = 0.f;
        for (int jj = part * 64; jj < min(n, part * 64 + 64); ++jj) acc += Ps[jj] * v[(size_t)Is[jj] * ld + h * 64 + d];
        __syncthreads();
        Ps[tid] = acc;
        __syncthreads();
        if (tid < 64) o[(size_t)qq * ldo + h * 64 + tid] = (Ps[tid] + Ps[64 + tid] + Ps[128 + tid] + Ps[192 + tid]) / lsum;
        __syncthreads();
    }
}

__global__ void k_scale_cols(float* x, int ld, int ntok, int ncols, float s) {
    int i = blockIdx.x * blockDim.x + threadIdx.x;
    if (i < ntok * ncols) x[(size_t)(i / ncols) * ld + (i % ncols)] *= s;
}
__global__ void k_copy(const float* a, float* b, size_t n) { size_t i = (size_t)blockIdx.x * blockDim.x + threadIdx.x; if (i < n) b[i] = a[i]; }
}
namespace nv {
constexpr size_t MB = 1u << 20;
constexpr size_t OFF_CS = 204 * MB, OFF_MISC = 205 * MB, OFF_H = 2 * MB, OFF_P = 34 * MB, OFF_Q = 130 * MB, OFF_QI = 162 * MB, OFF_S = 178 * MB, OFF_IDX = 194 * MB, OFF_CNT = 202 * MB;

static void gemm(hipStream_t st, const float* A, int lda, const float* W, int ldw, float* C, int ldc, const float* R, int M, int N, int K, int mode) {
    dim3 grid((N + 63) / 64, M / 64);
    hipLaunchKernelGGL(k_gemm, grid, dim3(256), 0, st, A, lda, W, ldw, C, ldc, R, M, N, K, mode);
}
static void rmsnorm(hipStream_t st, const float* x, int ldx, const float* g, float* out, int ldo, int nrows, int nh, int cols) {
    hipLaunchKernelGGL(k_rmsnorm, dim3((nrows + 3) / 4), dim3(256), 0, st, x, ldx, g, out, ldo, nrows, nh, cols);
}
static void rope(hipStream_t st, float* x, int ld, const float* cs, int tok0, int ntok, int nh, float scale) {
    int total = ntok * nh * 64;
    hipLaunchKernelGGL(k_rope, dim3((total + 255) / 256), dim3(256), 0, st, x, ld, cs, tok0, ntok, nh, scale);
}
static void mlp(hipStream_t st, char* ws, float* outb, const float* g, const float* w1, const float* w2) {
    float* H = (float*)(ws + OFF_H); float* U = (float*)(ws + OFF_P);
    for (int s = 0; s < 4; ++s) {
        float* xs = outb + (size_t)s * 2048 * DM;
        rmsnorm(st, xs, DM, g, H, DM, 2048, 1, DM);
        gemm(st, H, DM, w1, DFF, U, DFF, nullptr, 2048, DFF, DM, 1);
        gemm(st, U, DFF, w2, DM, xs, DM, xs, 2048, DM, DFF, 2);
    }
}

static void layer0_naive(hipStream_t st, void* const* d_in, char* ws, const float* xin_b, float* out_b, int b, bool do_mix = true, bool do_mlp = true) {
    const float* norm_mix = (const float*)d_in[2]; const float* norm_mlp = (const float*)d_in[3];
    const float* w1 = (const float*)d_in[4]; const float* w2 = (const float*)d_in[5];
    const float* w_in = (const float*)d_in[6]; const float* qg = (const float*)d_in[7]; const float* kg = (const float*)d_in[8];
    const float* subln = (const float*)d_in[13]; const float* w_out = (const float*)d_in[14];
    float* CS = (float*)(ws + OFF_CS); float* LAM = (float*)(ws + OFF_MISC);
    float* H = (float*)(ws + OFF_H); float* P = (float*)(ws + OFF_P);
    if (do_mix) {
    rmsnorm(st, xin_b, DM, norm_mix, H, DM, SEQ, 1, DM);
    gemm(st, H, DM, w_in, 3072, P, 3072, nullptr, SEQ, 3072, DM, 0);
    rmsnorm(st, P, 3072, qg, P, 3072, SEQ * 16, 16, 64);
    rmsnorm(st, P + 1024, 3072, kg, P + 1024, 3072, SEQ * 16, 16, 64);
    rope(st, P, 3072, CS, b * SEQ, SEQ, 16, 0.125f);
    rope(st, P + 1024, 3072, CS, b * SEQ, SEQ, 16, 1.0f);
    hipLaunchKernelGGL(k_diff_attn, dim3(SEQ / 16, 8), dim3(256), 0, st, P, P + 1024, P + 2048, 3072, H, DM, LAM, subln, 0.8f);
    gemm(st, H, DM, w_out, DM, out_b, DM, xin_b, SEQ, DM, DM, 2);
    }
    if (do_mlp) mlp(st, ws, out_b, norm_mlp, w1, w2);
}
static void layer1_naive(hipStream_t st, void* const* d_in, char* ws, float* out_b, int b, bool do_mix = true, bool do_mlp = true) {
    const float* norm_mix = (const float*)d_in[2] + DM; const float* norm_mlp = (const float*)d_in[3] + DM;
    const float* w1 = (const float*)d_in[4] + (size_t)DM * DFF; const float* w2 = (const float*)d_in[5] + (size_t)DM * DFF;
    const float* w_in = (const float*)d_in[15]; const float* cqg = (const float*)d_in[16]; const float* w_uq = (const float*)d_in[17];
    const float* w_uqi = (const float*)d_in[18]; const float* qg = (const float*)d_in[19]; const float* kg = (const float*)d_in[20]; const float* w_out = (const float*)d_in[21];
    float* CS = (float*)(ws + OFF_CS);
    float* H = (float*)(ws + OFF_H); float* P = (float*)(ws + OFF_P); float* Q = (float*)(ws + OFF_Q); float* QI = (float*)(ws + OFF_QI);
    float* S = (float*)(ws + OFF_S); int* IDX = (int*)(ws + OFF_IDX); int* CNT = (int*)(ws + OFF_CNT);
    const int LD = 2376;
    if (do_mix) {
    rmsnorm(st, out_b, DM, norm_mix, H, DM, SEQ, 1, DM);
    gemm(st, H, DM, w_in, LD, P, LD, nullptr, SEQ, LD, DM, 0);
    rmsnorm(st, P, LD, cqg, P, LD, SEQ, 1, 256);
    gemm(st, P, LD, w_uq, DM, Q, DM, nullptr, SEQ, DM, 256, 0);
    gemm(st, P, LD, w_uqi, 512, QI, 512, nullptr, SEQ, 512, 256, 0);
    rope(st, QI, 512, CS, b * SEQ, SEQ, 8, 1.0f);
    rmsnorm(st, P + 2304, LD, nullptr, P + 2304, LD, SEQ, 1, 64);
    rope(st, P + 2304, LD, CS, b * SEQ, SEQ, 1, 1.0f);
    hipLaunchKernelGGL(k_scale_cols, dim3((SEQ * 8 + 255) / 256), dim3(256), 0, st, P + 2368, LD, SEQ, 8, 0.35355339059327373f * 0.125f);
    rmsnorm(st, Q, DM, qg, Q, DM, SEQ * 16, 16, 64);
    rope(st, Q, DM, CS, b * SEQ, SEQ, 16, 0.125f);
    rmsnorm(st, P + 256, LD, kg, P + 256, LD, SEQ * 16, 16, 64);
    rope(st, P + 256, LD, CS, b * SEQ, SEQ, 16, 1.0f);
    for (int s = 0; s < 16; ++s) {
        hipLaunchKernelGGL(k_idx_scores, dim3(SEQ / 64, 512 / 16), dim3(256), 0, st, QI, 512, P + 2304, LD, P + 2368, LD, S, s * 512);
        hipLaunchKernelGGL(k_topk, dim3(512), dim3(256), 0, st, S, s * 512, IDX, CNT);
    }
    hipLaunchKernelGGL(k_dsa_attn, dim3(SEQ), dim3(256), 0, st, Q, DM, P + 256, P + 1280, LD, IDX, CNT, H, DM);
    gemm(st, H, DM, w_out, DM, out_b, DM, out_b, SEQ, DM, DM, 2);
    }
    if (do_mlp) mlp(st, ws, out_b, norm_mlp, w1, w2);
}
static void prep_naive(hipStream_t st, void* const* d_in, char* ws) {
    hipLaunchKernelGGL(k_rope_table, dim3(TOK / 256), dim3(256), 0, st, (const int*)d_in[1], (float*)(ws + OFF_CS), TOK);
    hipLaunchKernelGGL(k_lambda, dim3(1), dim3(64), 0, st, (const float*)d_in[9], (const float*)d_in[10], (const float*)d_in[11], (const float*)d_in[12], 0.2f, (float*)(ws + OFF_MISC));
}
}
#define LAS __attribute__((address_space(3)))
#define GAS __attribute__((address_space(1)))
typedef unsigned short bf16_t;
typedef short bf16x8 __attribute__((ext_vector_type(8)));
typedef float f32x4 __attribute__((ext_vector_type(4)));
typedef float f32x16 __attribute__((ext_vector_type(16)));
typedef unsigned u32x4 __attribute__((ext_vector_type(4)));
typedef unsigned u32x2 __attribute__((ext_vector_type(2)));

constexpr int BATCH = 2, SEQ = 8192, DM = 1024, DFF = 4096, TOK = BATCH * SEQ;
constexpr float EPS = 1e-6f;
constexpr float LOG2E = 1.4426950408889634f;
constexpr int NIN1 = 2376, NIN1P = 2560;
constexpr size_t MiB = 1u << 20;
constexpr size_t WS_XB = 0, WS_Q = 32 * MiB, WS_K = 64 * MiB, WS_V = 96 * MiB, WS_U = 32 * MiB;
constexpr size_t WS_CQ = 160 * MiB, WS_QI = 168 * MiB, WS_KI = 184 * MiB, WS_MASK = 186 * MiB;
constexpr size_t WS_CS = 204 * MiB, WS_MISC = 205 * MiB, WS_PART = 206 * MiB, WS_CQP = 207 * MiB, WS_WIDX = 207 * MiB + 256 * 1024;
constexpr size_t WS_QIN = WS_MISC + 512 * 1024;
constexpr size_t WS_CTL = WS_MISC + 4096;
constexpr size_t CTL_BYTES = 64 * 1024;
constexpr size_t WS_WIN0 = 208 * MiB, WS_WOUT0 = 214 * MiB, WS_W1_0 = 216 * MiB, WS_W2_0 = 224 * MiB, WS_WIN1 = 232 * MiB, WS_WUQ = 237 * MiB,
                 WS_WOUT1 = 238 * MiB, WS_W1_1 = 240 * MiB, WS_W2_1 = 248 * MiB, WS_END = 256 * MiB;

__device__ __forceinline__ unsigned cvt_pk_bf16(float lo, float hi) {
    typedef float f32x2_t __attribute__((ext_vector_type(2))); typedef __bf16 bf16x2_t __attribute__((ext_vector_type(2)));
    f32x2_t v = {lo, hi}; bf16x2_t b = __builtin_convertvector(v, bf16x2_t); return __builtin_bit_cast(unsigned, b);
}
__host__ __device__ __forceinline__ int tile_pos(int cl) { const int wc = cl >> 6, fq = (cl >> 4) & 3, bj = (cl >> 3) & 1, n = (cl >> 2) & 1, j = cl & 3; return 128 * bj + 32 * wc + 16 * n + 4 * fq + j; }
__device__ __forceinline__ int fresh_lane() { int l; asm volatile("v_mbcnt_lo_u32_b32 %0, -1, 0\n\tv_mbcnt_hi_u32_b32 %0, -1, %0" : "=v"(l)); return l; }
__device__ __forceinline__ float wave_sum(float v) {
#pragma unroll
    for (int o = 1; o < 64; o <<= 1) v += __shfl_xor(v, o);
    return v;
}
namespace pg8 {
#define PG8_LAS __attribute__((address_space(3)))
typedef unsigned short bf16_t;
typedef short bf16x8 __attribute__((ext_vector_type(8)));
typedef float f32x4 __attribute__((ext_vector_type(4)));
typedef unsigned u32x4 __attribute__((ext_vector_type(4)));
constexpr int BM = 256, BK = 64, HALF = 128, HTB = HALF * BK * 2  , STAGE_BYTES = 8 * HTB, NXCD = 8, WGM = 8;

__host__ __device__ __forceinline__ int lds_byte(int r, int c) { const int st = (r >> 4) * 2 + (c >> 5), rr = r & 15, cc = c & 31, ob = rr * 64 + cc * 2; return st * 1024 + (ob ^ (((ob >> 9) & 1) << 5)); }
__host__ __device__ __forceinline__ void stage_rc(int b, int& R, int& C) { const int st = b / 1024, sb = b % 1024, swz = sb ^ (((sb >> 9) & 1) << 5); R = (st >> 1) * 16 + swz / 64; C = (st & 1) * 32 + (swz % 64) / 2; }
__host__ __device__ __forceinline__ int perm32(int rho) { const int n = rho >> 4, i = rho & 15; return 8 * (i >> 2) + 4 * n + (i & 3); }

struct Unit { int pm, pn; };
struct Gemm { const bf16_t* A; const bf16_t* Bt; int M, N, K; };

struct StaticOrder {
    int nM, nN, nwg, G, c;
    __host__ __device__ void init(int M, int N, int G_, int c_) { nM = M / BM; nN = N / BM; nwg = nM * nN; G = G_; c = c_; }
    __host__ __device__ bool next(int i, Unit& u) const {
        const long L = (long)i * G + c; if (L >= nwg) return false;
        int wgid = (int)L; { const int q = nwg / NXCD, r = nwg % NXCD, xcd = wgid % NXCD, off = wgid / NXCD; wgid = (xcd < r ? xcd * (q + 1) : r * (q + 1) + (xcd - r) * q) + off; }
        const int nig = WGM * nN, gid = wgid / nig, fm = gid * WGM, gsz = (nM - fm) < WGM ? (nM - fm) : WGM;
        u.pm = fm + ((wgid % nig) % gsz); u.pn = (wgid % nig) / gsz; return true;
    }
    __device__ __forceinline__ void a_ready(const Unit&) const {}
    __device__ __forceinline__ void done(const Unit&) const {}
};

__device__ __forceinline__ unsigned cvt_pk_bf16(float lo, float hi) { unsigned r; asm volatile("v_cvt_pk_bf16_f32 %0, %1, %2" : "=v"(r) : "v"(lo), "v"(hi)); return r; }
typedef float f32x2 __attribute__((ext_vector_type(2)));
template <class Epi, class Sched, bool ALIGN_EPI = false, bool SP2 = false>
__device__ __forceinline__ void gemm_phase(PG8_LAS unsigned char* lds, const Gemm g, const Sched& S, const Epi& E, const int wid, const int lane) {
    const int tid = wid * 64 + lane, wr = wid >> 2, wc = wid & 3, fr = lane & 15, fq = lane >> 4;
    const int K = g.K, nt = K / BK;
    unsigned voffA[2], voffB[2];
#pragma unroll
    for (int i = 0; i < 2; ++i) { int R, C; stage_rc(tid * 16 + i * 8192, R, C); const int Rb = Epi::PERM ? ((R & ~31) + perm32(R & 31)) : R;
        voffA[i] = (unsigned)(R * K + C) * 2u; voffB[i] = (unsigned)(Rb * K + C) * 2u; }
    const size_t kstep = (size_t)(BK * 2);
    const size_t hstep = (size_t)HALF * K * 2;
    const size_t tstep = 2 * hstep;
    const unsigned ldsw = (unsigned)wid * 1024u;
    const int aoff = lds_byte(wr * 64 + fr, fq * 8), boff = lds_byte(wc * 32 + fr, fq * 8);
#define PG8_SA(b, h) (((b) * 2 + (h)) * HTB)
#define PG8_SB(b, h) ((4 + (b) * 2 + (h)) * HTB)
#define PG8_STAGE(bufoff, gbase, voff) do { _Pragma("unroll") for (int _i = 0; _i < 2; ++_i) \
        __builtin_amdgcn_global_load_lds((const unsigned*)((const char*)(gbase) + (voff)[_i]), (PG8_LAS unsigned*)(lds + (bufoff) + ldsw + _i * 8192), 16, 0, 0); } while (0)
#define PG8_LDA(dst, b, h) do { _Pragma("unroll") for (int m = 0; m < 4; ++m) _Pragma("unroll") for (int k = 0; k < 2; ++k) dst[m][k] = *(const PG8_LAS bf16x8*)(lds + PG8_SA(b, h) + aoff + m * 2048 + k * 1024); } while (0)
#define PG8_LDB(dst, b, h) do { _Pragma("unroll") for (int n = 0; n < 2; ++n) _Pragma("unroll") for (int k = 0; k < 2; ++k) dst[n][k] = *(const PG8_LAS bf16x8*)(lds + PG8_SB(b, h) + boff + n * 2048 + k * 1024); } while (0)
#define PG8_MMA(ai, bj, At, Bt) do { __builtin_amdgcn_s_setprio(1); _Pragma("unroll") for (int m = 0; m < 4; ++m) _Pragma("unroll") for (int n = 0; n < 2; ++n) _Pragma("unroll") for (int k = 0; k < 2; ++k) \
        acc[ai][bj][m][n] = __builtin_amdgcn_mfma_f32_16x16x32_bf16(Bt[n][k], At[m][k], acc[ai][bj][m][n], 0, 0, 0); __builtin_amdgcn_s_setprio(0); } while (0)
#define PG8_WAIT_V(n) asm volatile("s_waitcnt vmcnt(" #n ")" ::: "memory")
#define PG8_WAIT_L(n) asm volatile("s_waitcnt lgkmcnt(" #n ")" ::: "memory")
#define PG8_BAR __builtin_amdgcn_s_barrier()
#define PG8_SCHED __builtin_amdgcn_sched_barrier(0)
    Unit cur, nxt; int ui = 0;
    if (!S.next(0, cur)) return;
    f32x4 acc[2][2][4][2];
#pragma unroll
    for (int a = 0; a < 2; ++a)
#pragma unroll
        for (int b = 0; b < 2; ++b)
#pragma unroll
            for (int m = 0; m < 4; ++m)
#pragma unroll
                for (int n = 0; n < 2; ++n) acc[a][b][m][n] = (f32x4){0.f, 0.f, 0.f, 0.f};
    bf16x8 At[4][2], B0[2][2], B1[2][2];
    const char* cA = (const char*)g.A + (size_t)cur.pm * tstep; const char* cB = (const char*)g.Bt + (size_t)cur.pn * tstep;
    S.a_ready(cur);
    if constexpr (SP2) {
        PG8_STAGE(PG8_SB(0, 0), cB, voffB); PG8_STAGE(PG8_SB(0, 1), cB + hstep, voffB); PG8_STAGE(PG8_SA(0, 0), cA, voffA); PG8_STAGE(PG8_SA(0, 1), cA + hstep, voffA);
        if (wr == 1) PG8_BAR;
        PG8_WAIT_V(2); PG8_BAR;
        PG8_STAGE(PG8_SB(1, 0), cB + kstep, voffB); PG8_STAGE(PG8_SA(1, 0), cA + kstep, voffA); PG8_STAGE(PG8_SB(1, 1), cB + hstep + kstep, voffB);
        PG8_WAIT_V(6); PG8_BAR;
    } else {
        PG8_STAGE(PG8_SB(0, 0), cB, voffB); PG8_STAGE(PG8_SA(0, 0), cA, voffA); PG8_STAGE(PG8_SB(0, 1), cB + hstep, voffB); PG8_STAGE(PG8_SA(0, 1), cA + hstep, voffA);
        if (wr == 1) PG8_BAR;
        PG8_WAIT_V(4); PG8_BAR;
        PG8_STAGE(PG8_SB(1, 0), cB + kstep, voffB); PG8_STAGE(PG8_SA(1, 0), cA + kstep, voffA); PG8_STAGE(PG8_SB(1, 1), cB + hstep + kstep, voffB);
        PG8_WAIT_V(6); PG8_BAR;
    }
    for (;;) {
        const bool has_next = S.next(ui + 1, nxt);
        const char* nA = has_next ? (const char*)g.A + (size_t)nxt.pm * tstep : cA; const char* nB = has_next ? (const char*)g.Bt + (size_t)nxt.pn * tstep : cB;
        for (int t = 0; t < nt; t += 2) {
            const bool last = (t == nt - 2);
            const char* a1 = cA + (size_t)(t + 1) * kstep;
            const char* a2 = last ? nA : cA + (size_t)(t + 2) * kstep; const char* b2 = last ? nB : cB + (size_t)(t + 2) * kstep;
            const char* a3 = a2 + kstep; const char* b3 = b2 + kstep;
            if (last && has_next) S.a_ready(nxt);
            if constexpr (SP2) {
            PG8_LDB(B0, 0, 0); PG8_LDB(B1, 0, 1); PG8_SCHED; PG8_LDA(At, 0, 0); PG8_STAGE(PG8_SA(1, 1), a1 + hstep, voffA);
            PG8_WAIT_V(8); PG8_WAIT_L(0); PG8_BAR; PG8_MMA(0, 0, At, B0); PG8_MMA(0, 1, At, B1); PG8_BAR; PG8_SCHED;
            PG8_LDA(At, 0, 1); PG8_STAGE(PG8_SB(0, 0), b2, voffB); PG8_STAGE(PG8_SB(0, 1), b2 + hstep, voffB); PG8_STAGE(PG8_SA(0, 0), a2, voffA);
            PG8_WAIT_V(8); PG8_WAIT_L(0); PG8_BAR; PG8_MMA(1, 0, At, B0); PG8_MMA(1, 1, At, B1); PG8_BAR; PG8_SCHED;
            PG8_LDB(B0, 1, 0); PG8_LDB(B1, 1, 1); PG8_SCHED; PG8_LDA(At, 1, 0); PG8_STAGE(PG8_SA(0, 1), a2 + hstep, voffA);
            PG8_WAIT_V(8); PG8_WAIT_L(0); PG8_BAR; PG8_MMA(0, 0, At, B0); PG8_MMA(0, 1, At, B1); PG8_BAR; PG8_SCHED;
            PG8_LDA(At, 1, 1); PG8_STAGE(PG8_SB(1, 0), b3, voffB); PG8_STAGE(PG8_SB(1, 1), b3 + hstep, voffB); PG8_STAGE(PG8_SA(1, 0), a3, voffA);
            PG8_WAIT_V(8); PG8_WAIT_L(0); PG8_BAR; PG8_MMA(1, 0, At, B0); PG8_MMA(1, 1, At, B1); PG8_BAR; PG8_SCHED;
            } else {
            PG8_LDB(B0, 0, 0); PG8_SCHED; PG8_LDA(At, 0, 0); PG8_STAGE(PG8_SA(1, 1), a1 + hstep, voffA);
            PG8_WAIT_L(8); PG8_BAR; PG8_WAIT_L(0); PG8_MMA(0, 0, At, B0); PG8_BAR; PG8_SCHED;
            PG8_LDB(B1, 0, 1); PG8_STAGE(PG8_SB(0, 0), b2, voffB);
            PG8_BAR; PG8_WAIT_L(0); PG8_MMA(0, 1, At, B1); PG8_BAR;
            PG8_LDA(At, 0, 1); PG8_STAGE(PG8_SA(0, 0), a2, voffA);
            PG8_BAR; PG8_WAIT_L(0); PG8_MMA(1, 0, At, B0); PG8_BAR; PG8_SCHED;
            PG8_STAGE(PG8_SB(0, 1), b2 + hstep, voffB);
            PG8_WAIT_V(6); PG8_BAR; PG8_MMA(1, 1, At, B1); PG8_BAR;
            PG8_LDB(B0, 1, 0); PG8_SCHED; PG8_LDA(At, 1, 0); PG8_STAGE(PG8_SA(0, 1), a2 + hstep, voffA);
            PG8_WAIT_L(8); PG8_BAR; PG8_WAIT_L(0); PG8_MMA(0, 0, At, B0); PG8_BAR; PG8_SCHED;
            PG8_LDB(B1, 1, 1); PG8_STAGE(PG8_SB(1, 0), b3, voffB);
            PG8_BAR; PG8_WAIT_L(0); PG8_MMA(0, 1, At, B1); PG8_BAR;
            PG8_LDA(At, 1, 1); PG8_STAGE(PG8_SA(1, 0), a3, voffA);
            PG8_BAR; PG8_WAIT_L(0); PG8_MMA(1, 0, At, B0); PG8_BAR; PG8_SCHED;
            PG8_STAGE(PG8_SB(1, 1), b3 + hstep, voffB);
            PG8_WAIT_V(6); PG8_BAR; PG8_MMA(1, 1, At, B1); PG8_BAR;
            }
        }
        if constexpr (ALIGN_EPI) { if (wr == 0) PG8_BAR; }
        if constexpr (!Epi::AFTER_DRAIN) { E(acc, cur, wr, wc, fr, fq); S.done(cur); }
        if (!has_next) break;
#pragma unroll
        for (int a = 0; a < 2; ++a)
#pragma unroll
            for (int b = 0; b < 2; ++b)
#pragma unroll
                for (int m = 0; m < 4; ++m)
#pragma unroll
                    for (int n = 0; n < 2; ++n) acc[a][b][m][n] = (f32x4){0.f, 0.f, 0.f, 0.f};
        cur = nxt; cA = nA; cB = nB; ++ui;
        if constexpr (ALIGN_EPI) { if (wr == 1) PG8_BAR; }
    }
    PG8_WAIT_V(0);
    if constexpr (!ALIGN_EPI) { if (wr == 0) PG8_BAR; }
    PG8_BAR;
    if constexpr (Epi::AFTER_DRAIN) { E.fused(acc, cur, wr, wc, fr, fq, lds, wid, lane); S.done(cur); }
#undef PG8_SA
#undef PG8_SB
#undef PG8_STAGE
#undef PG8_LDA
#undef PG8_LDB
#undef PG8_MMA
#undef PG8_WAIT_V
#undef PG8_WAIT_L
#undef PG8_BAR
#undef PG8_SCHED
}
}
typedef f32x4 acc_t[2][2][4][2];

__device__ __forceinline__ float rstd_from_parts16(const float* __restrict__ part, int row) {
    const f32x4* p = (const f32x4*)(part + (size_t)row * 16);
    const f32x4 a = p[0], b = p[1], c = p[2], d = p[3];
    const float s = ((a[0] + a[1]) + (a[2] + a[3])) + ((b[0] + b[1]) + (b[2] + b[3])) + ((c[0] + c[1]) + (c[2] + c[3])) + ((d[0] + d[1]) + (d[2] + d[3]));
    return 1.0f / sqrtf(s * (1.0f / 1024.0f) + EPS);
}
__device__ __forceinline__ float quad_sum(float s) { s += __shfl_xor(s, 16); s += __shfl_xor(s, 32); return s; }
__device__ __forceinline__ float sumsq16(const f32x4 (&v)[2][2]) {
    float s = 0.f;
#pragma unroll
    for (int bj = 0; bj < 2; ++bj)
#pragma unroll
        for (int n = 0; n < 2; ++n) s += (v[bj][n][0] * v[bj][n][0] + v[bj][n][1] * v[bj][n][1]) + (v[bj][n][2] * v[bj][n][2] + v[bj][n][3] * v[bj][n][3]);
    return s;
}
__device__ __forceinline__ void head_norm_rope(f32x4 (&v)[2][2], bool do_norm, bool use_gain, const f32x4 (&g)[2][2], const float* __restrict__ cs_row, int fq, float scale) {
    if (do_norm) {
        const float ss = quad_sum(sumsq16(v));
        const float rn = 1.0f / sqrtf(ss * (1.0f / 64.0f) + EPS);
#pragma unroll
        for (int bj = 0; bj < 2; ++bj)
#pragma unroll
            for (int n = 0; n < 2; ++n) { v[bj][n] = v[bj][n] * rn; if (use_gain) v[bj][n] = v[bj][n] * g[bj][n]; }
    }
    if (fq == 0) {
        const f32x4* c4 = (const f32x4*)cs_row;
#pragma unroll
        for (int n = 0; n < 2; ++n) {
            const f32x4 c = c4[n], s = c4[2 + n];
            const f32x4 x1 = v[0][n], x2 = v[1][n];
            v[0][n] = x1 * c - x2 * s;
            v[1][n] = x2 * c + x1 * s;
        }
    }
    if (scale != 1.0f) {
#pragma unroll
        for (int bj = 0; bj < 2; ++bj)
#pragma unroll
            for (int n = 0; n < 2; ++n) v[bj][n] = v[bj][n] * scale;
    }
}
__device__ __forceinline__ void store_bf16x16(bf16_t* p, const f32x4 (&v)[2][2]) {
#pragma unroll
    for (int bj = 0; bj < 2; ++bj) {
        u32x4 w; w.x = cvt_pk_bf16(v[bj][0][0], v[bj][0][1]); w.y = cvt_pk_bf16(v[bj][0][2], v[bj][0][3]); w.z = cvt_pk_bf16(v[bj][1][0], v[bj][1][1]); w.w = cvt_pk_bf16(v[bj][1][2], v[bj][1][3]);
        *(u32x4*)(p + 8 * bj) = w;
    }
}
__device__ __forceinline__ void load_gain16(f32x4 (&g)[2][2], const float* __restrict__ gp, int fq) {
#pragma unroll
    for (int bj = 0; bj < 2; ++bj)
#pragma unroll
        for (int n = 0; n < 2; ++n) g[bj][n] = *(const f32x4*)(gp + 16 * fq + 8 * bj + 4 * n);
}

struct EpiQKV0 {
    static constexpr bool PERM = false, AFTER_DRAIN = false;
    const float* part; const float* cs; const float* qg; const float* kg; bf16_t* QKV; size_t stride; float qscale;
    __device__ __forceinline__ void operator()(const acc_t& acc, const pg8::Unit& u, int wr, int wc, int fr, int fq) const {
        const int kind = u.pn >> 2, head = (u.pn & 3) * 4 + wc;
        bf16_t* dst = QKV + (size_t)kind * stride + head * 64 + 16 * fq;
        f32x4 g[2][2] = {};
        if (kind < 2) load_gain16(g, kind == 0 ? qg : kg, fq);
#pragma unroll
        for (int ai = 0; ai < 2; ++ai)
#pragma unroll
            for (int m = 0; m < 4; ++m) {
                const int row = u.pm * 256 + ai * 128 + wr * 64 + m * 16 + fr;
                const float rs = rstd_from_parts16(part, row);
                f32x4 v[2][2];
#pragma unroll
                for (int bj = 0; bj < 2; ++bj)
#pragma unroll
                    for (int n = 0; n < 2; ++n) v[bj][n] = acc[ai][bj][m][n] * rs;
                if (kind < 2) head_norm_rope(v, true, true, g, cs + (size_t)row * 16, fq, kind == 0 ? qscale : 1.0f);
                store_bf16x16(dst + (size_t)row * DM, v);
            }
    }
};
struct EpiResid {
    static constexpr bool PERM = false, AFTER_DRAIN = false;
    const float* R; float* out; bf16_t* xb; float* part;
    __device__ __forceinline__ void operator()(const acc_t& acc, const pg8::Unit& u, int wr, int wc, int fr, int fq) const {
        const int col0 = u.pn * 256 + wc * 64 + 16 * fq;
#pragma unroll
        for (int ai = 0; ai < 2; ++ai)
#pragma unroll
            for (int m = 0; m < 4; ++m) {
                const int row = u.pm * 256 + ai * 128 + wr * 64 + m * 16 + fr;
                const size_t off = (size_t)row * DM + col0;
                f32x4 v[2][2];
#pragma unroll
                for (int bj = 0; bj < 2; ++bj)
#pragma unroll
                    for (int n = 0; n < 2; ++n) v[bj][n] = *(const f32x4*)(R + off + 8 * bj + 4 * n) + acc[ai][bj][m][n];
#pragma unroll
                for (int bj = 0; bj < 2; ++bj)
#pragma unroll
                    for (int n = 0; n < 2; ++n) *(f32x4*)(out + off + 8 * bj + 4 * n) = v[bj][n];
                if (xb) store_bf16x16(xb + off, v);
                if (part) { const float ss = quad_sum(sumsq16(v)); if (fq == 0) part[(size_t)row * 16 + u.pn * 4 + wc] = ss; }
            }
    }
};
struct EpiUp {
    static constexpr bool PERM = false, AFTER_DRAIN = false;
    const float* part; bf16_t* U;
    __device__ __forceinline__ void operator()(const acc_t& acc, const pg8::Unit& u, int wr, int wc, int fr, int fq) const {
        const int col0 = u.pn * 256 + wc * 64 + 16 * fq;
#pragma unroll
        for (int ai = 0; ai < 2; ++ai)
#pragma unroll
            for (int m = 0; m < 4; ++m) {
                const int row = u.pm * 256 + ai * 128 + wr * 64 + m * 16 + fr;
                const float rs = rstd_from_parts16(part, row);
                f32x4 v[2][2];
#pragma unroll
                for (int bj = 0; bj < 2; ++bj)
#pragma unroll
                    for (int n = 0; n < 2; ++n) {
                        f32x4 t = acc[ai][bj][m][n] * rs;
#pragma unroll
                        for (int j = 0; j < 4; ++j) { const float r = fmaxf(t[j], 0.f); t[j] = r * r; }
                        v[bj][n] = t;
                    }
                store_bf16x16(U + (size_t)row * DFF + col0, v);
            }
    }
};
struct EpiIn1 {
    static constexpr bool PERM = false, AFTER_DRAIN = false;
    const float* part; const float* cs; const float* kg; bf16_t* CQ; float* cqp; bf16_t* K; bf16_t* V; bf16_t* KI; float* widx; float wscale;
    __device__ __forceinline__ void operator()(const acc_t& acc, const pg8::Unit& u, int wr, int wc, int fr, int fq) const {
        const int pn = u.pn;
        if (pn == 9 && wc >= 2) return;
        f32x4 g[2][2] = {};
        if (pn >= 1 && pn <= 4) load_gain16(g, kg, fq);
#pragma unroll
        for (int ai = 0; ai < 2; ++ai)
#pragma unroll
            for (int m = 0; m < 4; ++m) {
                const int row = u.pm * 256 + ai * 128 + wr * 64 + m * 16 + fr;
                const float rs = rstd_from_parts16(part, row);
                f32x4 v[2][2];
#pragma unroll
                for (int bj = 0; bj < 2; ++bj)
#pragma unroll
                    for (int n = 0; n < 2; ++n) v[bj][n] = acc[ai][bj][m][n] * rs;
                if (pn == 0) {
                    store_bf16x16(CQ + (size_t)row * 256 + wc * 64 + 16 * fq, v);
                    const float ss = quad_sum(sumsq16(v)); if (fq == 0) cqp[(size_t)row * 4 + wc] = ss;
                } else if (pn <= 4) {
                    head_norm_rope(v, true, true, g, cs + (size_t)row * 16, fq, 1.0f);
                    store_bf16x16(K + (size_t)row * DM + ((pn - 1) * 4 + wc) * 64 + 16 * fq, v);
                } else if (pn <= 8) {
                    store_bf16x16(V + (size_t)row * DM + ((pn - 5) * 4 + wc) * 64 + 16 * fq, v);
                } else if (wc == 0) {
                    head_norm_rope(v, true, false, g, cs + (size_t)row * 16, fq, 1.0f);
                    store_bf16x16(KI + (size_t)row * 64 + 16 * fq, v);
                } else if (fq == 0) {
                    *(f32x4*)(widx + (size_t)row * 8) = v[0][0] * wscale; *(f32x4*)(widx + (size_t)row * 8 + 4) = v[0][1] * wscale;
                }
            }
    }
};
struct EpiQup {
    static constexpr bool PERM = false, AFTER_DRAIN = false;
    const float* cqp; const float* cs; const float* qg; const float* widx; bf16_t* Q; bf16_t* QI; float* qin; float qscale;
    __device__ __forceinline__ void operator()(const acc_t& acc, const pg8::Unit& u, int wr, int wc, int fr, int fq) const {
        const int pn = u.pn;
        f32x4 g[2][2] = {};
        if (pn < 4) load_gain16(g, qg, fq);
#pragma unroll
        for (int ai = 0; ai < 2; ++ai)
#pragma unroll
            for (int m = 0; m < 4; ++m) {
                const int row = u.pm * 256 + ai * 128 + wr * 64 + m * 16 + fr;
                const f32x4 cp = *(const f32x4*)(cqp + (size_t)row * 4);
                const float rs = 1.0f / sqrtf(((cp[0] + cp[1]) + (cp[2] + cp[3])) * (1.0f / 256.0f) + EPS);
                f32x4 v[2][2];
#pragma unroll
                for (int bj = 0; bj < 2; ++bj)
#pragma unroll
                    for (int n = 0; n < 2; ++n) v[bj][n] = acc[ai][bj][m][n] * rs;
                if (pn < 4) {
                    head_norm_rope(v, true, true, g, cs + (size_t)row * 16, fq, qscale);
                    store_bf16x16(Q + (size_t)row * DM + (pn * 4 + wc) * 64 + 16 * fq, v);
                } else {
                    const int hh = (pn - 4) * 4 + wc;
                    head_norm_rope(v, false, false, g, cs + (size_t)row * 16, fq, fabsf(widx[(size_t)row * 8 + hh]));
                    store_bf16x16(QI + (size_t)row * 512 + hh * 64 + 16 * fq, v);
                    const float ss = quad_sum(sumsq16(v)); if (fq == 0) qin[(size_t)row * 8 + hh] = sqrtf(ss);
                }
            }
    }
};
typedef GAS unsigned gu32;
#define RLX_AGENT __ATOMIC_RELAXED, __HIP_MEMORY_SCOPE_AGENT
#define LDS_WAIT() asm volatile("s_waitcnt lgkmcnt(0)" ::: "memory")
#define VM_WAIT() asm volatile("s_waitcnt vmcnt(0)" ::: "memory")

constexpr int RING_BYTES = 143360;
constexpr int MISC_OFF = RING_BYTES + 320;
constexpr int LDS_BYTES = 147456;
constexpr int NWAVES = 8;

#define XB_TMO      128
#define XB_XCNT(j)  (256  + 64 * (j))
#define XB_XSUB(j)  (1280 + 64 * (j))
#define XB_XGEN(j)  (2304 + 64 * (j))
#define XB_TOP      3328
#define XB_TOPGEN   3392
#define XCD_BAR_WORDS 3456
#define XB_SPIN_CAP (1u << 18)
__device__ __forceinline__ unsigned xb_ld(unsigned* p)              { return __hip_atomic_load(p, __ATOMIC_RELAXED, __HIP_MEMORY_SCOPE_AGENT); }
__device__ __forceinline__ unsigned xb_add(unsigned* p, unsigned v) { return __hip_atomic_fetch_add(p, v, __ATOMIC_RELAXED, __HIP_MEMORY_SCOPE_AGENT); }
__device__ __forceinline__ unsigned xb_xcc_id() { return (unsigned)__builtin_amdgcn_s_getreg((3 << 11) | 20) & 0xFu; }
#define XB_SPIN(cond, bar) do { unsigned _sp = 0; while (cond) { __builtin_amdgcn_s_sleep(1); \
    if ((++_sp & 255u) == 0u) { if (xb_ld(&(bar)[XB_TMO])) break; if (_sp > XB_SPIN_CAP) { atomicAdd(&(bar)[XB_TMO], 1u); break; } } } } while (0)
struct XcdBarrier { unsigned* bar; unsigned x; volatile LAS unsigned* st; };
__device__ __forceinline__ XcdBarrier xcd_barrier_post(unsigned* bar, volatile LAS unsigned* st) {
    XcdBarrier b; b.bar = bar; b.x = xb_xcc_id(); b.st = st;
    if (threadIdx.x == 0) (void)xb_add(&bar[XB_XCNT(b.x)], 1u);
    return b;
}
__device__ __forceinline__ void xcd_barrier_complete(unsigned* bar, unsigned x, unsigned& nloc, unsigned& nx) {
    const unsigned G = gridDim.x * gridDim.y * gridDim.z;
    unsigned sum, cnt, mine, sp = 0u;
    for (;;) {
        sum = 0u; cnt = 0u; mine = 0u;
#pragma unroll
        for (unsigned j = 0; j < 16; ++j) { const unsigned c = xb_ld(&bar[XB_XCNT(j)]); sum += c; cnt += (c > 0u) ? 1u : 0u; mine = (j == x) ? c : mine; }
        if (sum == G) break;
        __builtin_amdgcn_s_sleep(1);
        if ((++sp & 255u) == 0u) { if (xb_ld(&bar[XB_TMO])) break; if (sp > XB_SPIN_CAP) { atomicAdd(&bar[XB_TMO], 1u); break; } }
    }
    nloc = mine > 0u ? mine : 1u; nx = cnt > 0u ? cnt : 1u;
}
__device__ __forceinline__ void xcd_barrier(const XcdBarrier& b, const int wave) {
    asm volatile("s_waitcnt vmcnt(0)" ::: "memory");
    __syncthreads();
    if (wave == 0 && fresh_lane() == 0) {
        unsigned* bar = b.bar;
        __builtin_amdgcn_s_waitcnt(0);
        unsigned nloc = b.st[0], nx = b.st[1];
        if (nloc == 0u) { xcd_barrier_complete(bar, b.x, nloc, nx); b.st[0] = nloc; b.st[1] = nx; }
        const unsigned old = xb_add(&bar[XB_XSUB(b.x)], 1u);
        const unsigned gen = old / nloc;
        if (old + 1u == (gen + 1u) * nloc) {
            __builtin_amdgcn_fence(__ATOMIC_RELEASE, "agent");
            asm volatile("s_waitcnt vmcnt(0)" ::: "memory");
            const unsigned og = xb_add(&bar[XB_TOP], 1u);
            const unsigned tg = og / nx;
            if (og + 1u == (tg + 1u) * nx) xb_add(&bar[XB_TOPGEN], 1u);
            else XB_SPIN(xb_ld(&bar[XB_TOPGEN]) == tg, bar);
            __builtin_amdgcn_fence(__ATOMIC_ACQUIRE, "agent");
            xb_add(&bar[XB_XGEN(b.x)], 1u);
            asm volatile("s_waitcnt vmcnt(0)" ::: "memory");
        } else {
            XB_SPIN(xb_ld(&bar[XB_XGEN(b.x)]) == gen, bar);
            __builtin_amdgcn_fence(__ATOMIC_ACQUIRE, "agent");
            asm volatile("s_waitcnt vmcnt(0)" ::: "memory");
        }
    }
    __syncthreads();
}

__device__ __forceinline__ unsigned f2bf(float f) { unsigned u = __builtin_bit_cast(unsigned, f); return (u + 0x7fffu + ((u >> 16) & 1u)) >> 16; }
__device__ __forceinline__ unsigned pk2(float lo, float hi) { return f2bf(lo) | (f2bf(hi) << 16); }
__device__ __forceinline__ void p0_transpose_item(const float* __restrict__ W, int K, int N, const float* __restrict__ gain, bf16_t* WT, int row_off, LAS float* scr, int item, int nblk, int lane) {
    const int kb = item / nblk, nb = item % nblk, k0 = 64 * kb, n0 = 32 * nb;
    const int cc = n0 + (lane & 31);
#pragma unroll 8
    for (int i = 0; i < 32; ++i) { const int kk = 2 * i + (lane >> 5); float w = (cc < N) ? W[(size_t)(k0 + kk) * N + cc] : 0.f; if (gain) w *= gain[k0 + kk]; scr[kk * 33 + (lane & 31)] = w; }
    LDS_WAIT(); asm volatile("" ::: "memory");
    const int c = lane & 7;
#pragma unroll
    for (int j = 0; j < 4; ++j) { const int n = (lane >> 3) + 8 * j; const LAS float* s = scr + (8 * c) * 33 + n;
        u32x4 o; o.x = pk2(s[0 * 33], s[1 * 33]); o.y = pk2(s[2 * 33], s[3 * 33]); o.z = pk2(s[4 * 33], s[5 * 33]); o.w = pk2(s[6 * 33], s[7 * 33]);
        const int cl = n0 + n; const int drow = row_off + (cl & ~255) + tile_pos(cl & 255);
        *(GAS u32x4*)(WT + (size_t)drow * K + k0 + 8 * c) = o; }
    LDS_WAIT(); asm volatile("" ::: "memory");
}
struct WJob { const float* W; const float* gain; bf16_t* WT; int K, N, Npad, row_off; };
__device__ __forceinline__ void row_to_bf16(const float* xrow, bf16_t* orow, float* prow, int lane) {
    const GAS f32x4* xr = (const GAS f32x4*)xrow + lane;
    f32x4 v[4]; float s = 0.f;
#pragma unroll
    for (int j = 0; j < 4; ++j) { v[j] = xr[64 * j]; s += (v[j][0] * v[j][0] + v[j][1] * v[j][1]) + (v[j][2] * v[j][2] + v[j][3] * v[j][3]); }
    s = wave_sum(s);
    GAS u32x2* o8 = (GAS u32x2*)orow + lane;
#pragma unroll
    for (int j = 0; j < 4; ++j) { u32x2 w; w.x = cvt_pk_bf16(v[j][0], v[j][1]); w.y = cvt_pk_bf16(v[j][2], v[j][3]); o8[64 * j] = w; }
    if (lane < 16) prow[lane] = (lane == 0) ? s : 0.f;
}
constexpr int ATT_SCR = 98304;
typedef short v4i16_t __attribute__((ext_vector_type(4)));
typedef short s16x4 __attribute__((ext_vector_type(4)));
__device__ __forceinline__ int crow(int r, int hi) { return (r & 3) + 8 * (r >> 2) + 4 * hi; }
__device__ __forceinline__ s16x4 vtr(const LAS unsigned char* p) { return __builtin_bit_cast(s16x4, __builtin_amdgcn_ds_read_tr16_b64_v4i16((LAS v4i16_t*)p)); }
__device__ __forceinline__ void glds16(const void* gsrc, LAS unsigned char* dst) { __builtin_amdgcn_global_load_lds((const unsigned*)gsrc, (LAS unsigned*)dst, 16, 0, 0); }
#define ATT_WAIT_BAR() do { asm volatile("s_waitcnt vmcnt(0) lgkmcnt(0)" ::: "memory"); __builtin_amdgcn_s_barrier(); asm volatile("" ::: "memory"); } while (0)

__device__ __forceinline__ void att_qkt(f32x16& p0, f32x16& p1, const LAS unsigned char* Kslot, const bf16x8 (&qr)[4], int r32, int hi) {
    const LAS unsigned char* kb = Kslot + hi * 1024 + r32 * 16;
    p0 = (f32x16){}; p1 = (f32x16){};
#pragma unroll
    for (int d0 = 0; d0 < 4; ++d0) {
        const bf16x8 b0 = *(const LAS bf16x8*)(kb + d0 * 2048);
        const bf16x8 b1 = *(const LAS bf16x8*)(kb + d0 * 2048 + 512);
        p0 = __builtin_amdgcn_mfma_f32_32x32x16_bf16(b0, qr[d0], p0, 0, 0, 0);
        p1 = __builtin_amdgcn_mfma_f32_32x32x16_bf16(b1, qr[d0], p1, 0, 0, 0);
    }
}
__device__ __forceinline__ bf16x8 pack8(const f32x16& p, int base) {
    u32x4 w; w.x = cvt_pk_bf16(p[base], p[base + 1]); w.y = cvt_pk_bf16(p[base + 2], p[base + 3]); w.z = cvt_pk_bf16(p[base + 4], p[base + 5]); w.w = cvt_pk_bf16(p[base + 6], p[base + 7]);
    return __builtin_bit_cast(bf16x8, w);
}
template <int NDB> __device__ __forceinline__ void att_pv(f32x16 (&o)[NDB], const LAS unsigned char* vb, const bf16x8 (&pa)[4]) {
#pragma unroll
    for (int d = 0; d < NDB; ++d)
#pragma unroll
        for (int ks = 0; ks < 4; ++ks) {
            const s16x4 lo = vtr(vb + d * 4096 + ks * 1024), hi4 = vtr(vb + d * 4096 + ks * 1024 + 512);
            const bf16x8 vf = (bf16x8){lo[0], lo[1], lo[2], lo[3], hi4[0], hi4[1], hi4[2], hi4[3]};
            o[d] = __builtin_amdgcn_mfma_f32_32x32x16_bf16(pa[ks], vf, o[d], 0, 0, 0);
        }
}
__device__ __forceinline__ float sum16(const f32x16& p) { return (((p[0] + p[1]) + (p[2] + p[3])) + ((p[4] + p[5]) + (p[6] + p[7]))) + (((p[8] + p[9]) + (p[10] + p[11])) + ((p[12] + p[13]) + (p[14] + p[15]))); }

constexpr int A0_STAGE = 32768;
__device__ __forceinline__ void attn0_unit(LAS unsigned char* lds, const int wave, int b, int h, int qb, const bf16_t* Q, const bf16_t* __restrict__ K, const bf16_t* __restrict__ V, bf16_t* O,
                                           float lam, const float* __restrict__ subg, float outscale) {
    const int lane = fresh_lane(), r32 = lane & 31, hi = lane >> 5;
    const int cc = wave >> 2, rb = wave & 3;
    const size_t rowbase = (size_t)b * SEQ;
    const int q0 = qb * 128 + rb * 32;
    const int NT = 2 * qb + 2;
    const int mylast = 2 * qb + (rb >> 1);
    const bf16_t* ksrc0 = K + (rowbase + lane) * DM + (2 * h + 0) * 64 + wave * 8;
    const bf16_t* ksrc1 = K + (rowbase + lane) * DM + (2 * h + 1) * 64 + wave * 8;
    const int vp0 = wave, vp1 = wave + 8;
    const bf16_t* vsrc0 = V + (rowbase + 16 * (vp0 & 3) + (lane >> 2)) * DM + h * 128 + (vp0 >> 2) * 32 + (lane & 3) * 8;
    const bf16_t* vsrc1 = V + (rowbase + 16 * (vp1 & 3) + (lane >> 2)) * DM + h * 128 + (vp1 >> 2) * 32 + (lane & 3) * 8;
#define A0_ISSUE(t, st) do { LAS unsigned char* sb_ = lds + (st) * A0_STAGE; const size_t go_ = (size_t)(t) * 64 * DM; \
        glds16(ksrc0 + go_, sb_ + wave * 1024); glds16(ksrc1 + go_, sb_ + 8192 + wave * 1024); \
        glds16(vsrc0 + go_, sb_ + 16384 + vp0 * 1024); glds16(vsrc1 + go_, sb_ + 16384 + vp1 * 1024); } while (0)
    A0_ISSUE(0, 0);
    bf16x8 qr[4];
    { const bf16_t* Qw = Q + (rowbase + q0) * DM + (2 * h + cc) * 64;
#pragma unroll
      for (int d0 = 0; d0 < 4; ++d0) qr[d0] = *(const bf16x8*)(Qw + (size_t)r32 * DM + d0 * 16 + hi * 8); }
    f32x16 o[4]; o[0] = (f32x16){}; o[1] = (f32x16){}; o[2] = (f32x16){}; o[3] = (f32x16){};
    float l = 0.f;
    const int vboff = ((lane >> 4) & 1) * 32 + (lane & 3) * 8 + (4 * hi + ((lane & 15) >> 2)) * 64;
    for (int t = 0; t < NT; ++t) {
        ATT_WAIT_BAR();
        if (t + 1 < NT) A0_ISSUE(t + 1, (t + 1) & 1);
        if (t <= mylast) {
            const LAS unsigned char* sb = lds + (t & 1) * A0_STAGE;
            f32x16 p0, p1;
            att_qkt(p0, p1, sb + cc * 8192, qr, r32, hi);
#pragma unroll
            for (int r = 0; r < 16; ++r) { p0[r] = __builtin_amdgcn_exp2f(p0[r]); p1[r] = __builtin_amdgcn_exp2f(p1[r]); }
            l += sum16(p0) + sum16(p1);
            bf16x8 pa[4]; pa[0] = pack8(p0, 0); pa[1] = pack8(p0, 8); pa[2] = pack8(p1, 0); pa[3] = pack8(p1, 8);
            att_pv<4>(o, sb + 16384 + vboff, pa);
        }
    }
#undef A0_ISSUE
    ATT_WAIT_BAR();
    l += __shfl_xor(l, 32);
    LAS float* wsf = (LAS float*)(lds + ATT_SCR + wave * 256);
    if (hi == 0) wsf[r32] = l;
    asm volatile("s_waitcnt lgkmcnt(0)" ::: "memory");
    float rli[16];
#pragma unroll
    for (int r = 0; r < 16; ++r) rli[r] = 1.0f / wsf[crow(r, hi)];
    LAS float* X = (LAS float*)lds;
    if (cc == 1) {
#pragma unroll
        for (int r = 0; r < 16; ++r)
#pragma unroll
            for (int d = 0; d < 4; ++d) X[(rb * 32 + crow(r, hi)) * 128 + d * 32 + r32] = o[d][r] * rli[r];
    }
    ATT_WAIT_BAR();
    if (cc == 0) {
        float gsub[4];
#pragma unroll
        for (int d = 0; d < 4; ++d) gsub[d] = subg[d * 32 + r32] * outscale;
#pragma unroll
        for (int r = 0; r < 16; ++r) {
            float v[4]; float ss = 0.f;
#pragma unroll
            for (int d = 0; d < 4; ++d) { v[d] = o[d][r] * rli[r] - lam * X[(rb * 32 + crow(r, hi)) * 128 + d * 32 + r32]; ss += v[d] * v[d]; }
            ss += __shfl_xor(ss, 1); ss += __shfl_xor(ss, 2); ss += __shfl_xor(ss, 4); ss += __shfl_xor(ss, 8); ss += __shfl_xor(ss, 16);
            const float rn = 1.0f / sqrtf(ss * (1.0f / 128.0f) + EPS);
            bf16_t* op = O + (rowbase + q0 + crow(r, hi)) * DM + h * 128 + r32;
#pragma unroll
            for (int d = 0; d < 4; ++d) op[d * 32] = (bf16_t)(cvt_pk_bf16(v[d] * rn * gsub[d], 0.f) & 0xffffu);
        }
    }
    ATT_WAIT_BAR();
}
__device__ __forceinline__ void attn0_phase(LAS unsigned char* lds, const int wave, unsigned char* ws, const float* subln) {
    const int G = gridDim.x, bx = blockIdx.x;
    const int v = (G % 8 == 0) ? (bx % 8) * (G / 8) + bx / 8 : bx;
    const bf16_t* Q = (const bf16_t*)(ws + WS_Q); const bf16_t* K = (const bf16_t*)(ws + WS_K); const bf16_t* V = (const bf16_t*)(ws + WS_V);
    const float lam = *(const float*)(ws + WS_MISC);
    for (int vv = v; vv < 256; vv += G) {
        const int bh = vv >> 4, s = vv & 15;
#pragma unroll 1
        for (int i = 0; i < 4; ++i) {
            const int qb = (i == 0) ? s : (i == 1) ? 31 - s : (i == 2) ? 32 + s : 63 - s;
            attn0_unit(lds, wave, bh >> 3, bh & 7, qb, Q, K, V, (bf16_t*)(ws + WS_Q), lam, subln, 0.8f);
        }
    }
}

constexpr int A1_STAGE = 16384;
__device__ __forceinline__ void attn1_unit(LAS unsigned char* lds, const int wave, int b, int h, int qb, const bf16_t* Q, const bf16_t* __restrict__ K, const bf16_t* __restrict__ V, bf16_t* O,
                                           const unsigned long long* __restrict__ MASK) {
    const int lane = fresh_lane(), r32 = lane & 31, hi = lane >> 5;
    const size_t rowbase = (size_t)b * SEQ;
    const int q0 = qb * 256 + wave * 32;
    const int NT = 4 * qb + 4;
    const int mylast = 4 * qb + (wave >> 1);
    const bf16_t* ksrc = K + (rowbase + lane) * DM + h * 64 + wave * 8;
    const bf16_t* vsrc = V + (rowbase + 16 * (wave & 3) + (lane >> 2)) * DM + h * 64 + (wave >> 2) * 32 + (lane & 3) * 8;
#define A1_ISSUE(t, st) do { LAS unsigned char* sb_ = lds + (st) * A1_STAGE; const size_t go_ = (size_t)(t) * 64 * DM; \
        glds16(ksrc + go_, sb_ + wave * 1024); glds16(vsrc + go_, sb_ + 8192 + wave * 1024); } while (0)
    A1_ISSUE(0, 0);
    bf16x8 qr[4];
    { const bf16_t* Qw = Q + (rowbase + q0) * DM + h * 64;
#pragma unroll
      for (int d0 = 0; d0 < 4; ++d0) qr[d0] = *(const bf16x8*)(Qw + (size_t)r32 * DM + d0 * 16 + hi * 8); }
    f32x16 o[2]; o[0] = (f32x16){}; o[1] = (f32x16){};
    float l = 0.f;
    const int vboff = ((lane >> 4) & 1) * 32 + (lane & 3) * 8 + (4 * hi + ((lane & 15) >> 2)) * 64;
    const unsigned long long* mrow = MASK + (size_t)b * 128 * SEQ + q0 + r32;
    for (int t = 0; t < NT; ++t) {
        ATT_WAIT_BAR();
        if (t + 1 < NT) A1_ISSUE(t + 1, (t + 1) & 1);
        if (t <= mylast) {
            const unsigned long long mw = mrow[(size_t)t * SEQ];
            const unsigned mlo = (unsigned)mw >> (4 * hi), mhi = (unsigned)(mw >> 32) >> (4 * hi);
            const LAS unsigned char* sb = lds + (t & 1) * A1_STAGE;
            f32x16 p0, p1;
            att_qkt(p0, p1, sb, qr, r32, hi);
#pragma unroll
            for (int r = 0; r < 16; ++r) {
                const int pos = (r & 3) + 8 * (r >> 2);
                const float e0 = __builtin_amdgcn_exp2f(p0[r]), e1 = __builtin_amdgcn_exp2f(p1[r]);
                p0[r] = ((mlo >> pos) & 1u) ? e0 : 0.f; p1[r] = ((mhi >> pos) & 1u) ? e1 : 0.f;
            }
            l += sum16(p0) + sum16(p1);
            bf16x8 pa[4]; pa[0] = pack8(p0, 0); pa[1] = pack8(p0, 8); pa[2] = pack8(p1, 0); pa[3] = pack8(p1, 8);
            att_pv<2>(o, sb + 8192 + vboff, pa);
        }
    }
#undef A1_ISSUE
    l += __shfl_xor(l, 32);
    LAS float* wsf = (LAS float*)(lds + ATT_SCR + wave * 256);
    if (hi == 0) wsf[r32] = l;
    asm volatile("s_waitcnt lgkmcnt(0)" ::: "memory");
#pragma unroll
    for (int r = 0; r < 16; ++r) {
        const float rl = 1.0f / wsf[crow(r, hi)];
        bf16_t* op = O + (rowbase + q0 + crow(r, hi)) * DM + h * 64 + r32;
        op[0] = (bf16_t)(cvt_pk_bf16(o[0][r] * rl, 0.f) & 0xffffu); op[32] = (bf16_t)(cvt_pk_bf16(o[1][r] * rl, 0.f) & 0xffffu);
    }
    ATT_WAIT_BAR();
}
__device__ __forceinline__ void attn1_phase(LAS unsigned char* lds, const int wave, unsigned char* ws) {
    const int G = gridDim.x, bx = blockIdx.x;
    const int v = (G % 8 == 0) ? (bx % 8) * (G / 8) + bx / 8 : bx;
    const bf16_t* Q = (const bf16_t*)(ws + WS_Q); const bf16_t* K = (const bf16_t*)(ws + WS_K); const bf16_t* V = (const bf16_t*)(ws + WS_V);
    for (int vv = v; vv < 256; vv += G) {
        const int bh = vv >> 3, s = vv & 7;
#pragma unroll 1
        for (int i = 0; i < 4; ++i) {
            const int qb = (i == 0) ? s : (i == 1) ? 15 - s : (i == 2) ? 16 + s : 31 - s;
            attn1_unit(lds, wave, bh >> 4, bh & 15, qb, Q, K, V, (bf16_t*)(ws + WS_Q), (const unsigned long long*)(ws + WS_MASK));
        }
    }
}
constexpr int IX_NB = 1024, IX_HSTR = 513, IX_CAP = 320, IX_BSTR = 257;
constexpr int IX_HIST = 0, IX_CK = 0, IX_CI = 32 * IX_CAP * 4, IX_BM = 66560, IX_META = IX_BM + 32 * IX_BSTR * 4 + 128;
constexpr int IX_QF = 100352, IX_QSTR = 1040;
static_assert(IX_CI + 32 * IX_CAP * 2 <= IX_BM && 32 * IX_HSTR * 4 <= IX_BM && IX_META + 512 <= IX_QF && IX_QF + 32 * IX_QSTR <= RING_BYTES, "indexer LDS map");

template <int NT> __device__ __forceinline__ void ix_scores(f32x16 (&sc)[NT], const bf16x8 (&kf)[NT][4], const LAS unsigned char* qrow, const float (&sg)[8]) {
#pragma unroll
    for (int i = 0; i < NT; ++i) sc[i] = (f32x16){};
#pragma unroll
    for (int h = 0; h < 8; ++h) {
        bf16x8 qh[4];
        const LAS unsigned char* qp_ = qrow; asm volatile("" : "+v"(qp_));
#pragma unroll
        for (int s = 0; s < 4; ++s) qh[s] = *(const LAS bf16x8*)(qp_ + h * 128 + s * 32);
#pragma unroll
        for (int i = 0; i < NT; ++i) {
            f32x16 d = (f32x16){};
#pragma unroll
            for (int s = 0; s < 4; ++s) d = __builtin_amdgcn_mfma_f32_32x32x16_bf16(kf[i][s], qh[s], d, 0, 0, 0);
#pragma unroll
            for (int r = 0; r < 16; ++r) sc[i][r] = __builtin_fmaf(sg[h], fmaxf(d[r], 0.f), sc[i][r]);
        }
        if constexpr (NT == 2) asm volatile("" : "+v"(sc[0]), "+v"(sc[1])); else asm volatile("" : "+v"(sc[0]));
        __builtin_amdgcn_sched_barrier(0);
    }
}
__device__ __forceinline__ int ix_bin(float sc, float R, float scale) {
    int b = (int)((sc + R) * scale);
    return b < 0 ? 0 : (b > IX_NB - 1 ? IX_NB - 1 : b);
}
__device__ __forceinline__ void ix_loadk(bf16x8 (&kf)[2][4], const bf16_t* KIb, int kb, int r32, int hi) {
    const bf16_t* p = KIb + (size_t)(kb * 64 + r32) * 64 + hi * 8;
#pragma unroll
    for (int i = 0; i < 2; ++i)
#pragma unroll
        for (int s = 0; s < 4; ++s) kf[i][s] = *(const bf16x8*)(p + i * 32 * 64 + s * 16);
}

__device__ __forceinline__ void idx_unit(LAS unsigned char* lds, const int wave, unsigned char* ws, int b, int qt) {
    const int lane = fresh_lane(), r32 = lane & 31, hi = lane >> 5, tid = wave * 64 + lane;
    const int chunk = qt >> 1;
    const size_t tok0 = (size_t)b * SEQ + (size_t)qt * 32;
    unsigned* MASK32 = (unsigned*)(ws + WS_MASK);
    if (chunk < 4) {
        for (int t = wave; t <= chunk; t += 8) MASK32[((size_t)(b * 128 + t) * SEQ + qt * 32 + r32) * 2 + hi] = 0xFFFFFFFFu;
        return;
    }
    const bf16_t* KIb = (const bf16_t*)(ws + WS_KI) + (size_t)b * SEQ * 64;
    LAS unsigned* HIST = (LAS unsigned*)(lds + IX_HIST);
    LAS float* CK = (LAS float*)(lds + IX_CK);
    LAS unsigned short* CI = (LAS unsigned short*)(lds + IX_CI);
    LAS unsigned* BM = (LAS unsigned*)(lds + IX_BM);
    LAS int* META = (LAS int*)(lds + IX_META);
    { const u32x4* qsrc = (const u32x4*)((const bf16_t*)(ws + WS_QI) + tok0 * 512);
      for (int i = tid; i < 32 * 64; i += NWAVES * 64) *(LAS u32x4*)(lds + IX_QF + (i >> 6) * IX_QSTR + (i & 63) * 16) = qsrc[i]; }
    const LAS unsigned char* qrow = lds + IX_QF + r32 * IX_QSTR + hi * 16;
    float sg[8]; float R;
    { const float* wp = (const float*)(ws + WS_WIDX) + (tok0 + r32) * 8; const float* np = (const float*)(ws + WS_QIN) + (tok0 + r32) * 8;
      const f32x4 w0 = *(const f32x4*)wp, w1 = *(const f32x4*)(wp + 4), n0 = *(const f32x4*)np, n1 = *(const f32x4*)(np + 4);
#pragma unroll
      for (int h = 0; h < 4; ++h) { sg[h] = w0[h] < 0.f ? -1.f : 1.f; sg[4 + h] = w1[h] < 0.f ? -1.f : 1.f; }
      R = (((n0[0] + n0[1]) + (n0[2] + n0[3])) + ((n1[0] + n1[1]) + (n1[2] + n1[3]))) * (8.0f * 1.02f);
      R = fmaxf(R, 1e-20f); }
    const float scale = (float)(IX_NB / 2) / R;
    for (int i = tid; i < 32 * IX_HSTR; i += NWAVES * 64) HIST[i] = 0u;
    for (int i = tid; i < 32 * IX_BSTR; i += NWAVES * 64) BM[i] = 0u;
    if (tid < 128) META[tid] = 0;
    LDS_WAIT(); __builtin_amdgcn_s_barrier(); asm volatile("" ::: "memory");
    {
        bf16x8 kf[2][4];
#pragma unroll 1
        for (int kb = wave; kb <= chunk; kb += 8) {
            ix_loadk(kf, KIb, kb, r32, hi);
            f32x16 sc[2];
            ix_scores<2>(sc, kf, qrow, sg);
#pragma unroll
            for (int i = 0; i < 2; ++i)
#pragma unroll
                for (int r = 0; r < 16; ++r) {
                    const int bin = ix_bin(sc[i][r], R, scale);
                    __hip_atomic_fetch_add(HIST + r32 * IX_HSTR + (bin >> 1), 1u << (16 * (bin & 1)), __ATOMIC_RELAXED, __HIP_MEMORY_SCOPE_WORKGROUP);
                }
        }
    }
    LDS_WAIT(); __builtin_amdgcn_s_barrier(); asm volatile("" ::: "memory");
#pragma unroll 1
    for (int i = 0; i < 4; ++i) {
        const int q = wave * 4 + i;
        int lane8 = 8 * lane; asm volatile("" : "+v"(lane8));
        unsigned wv[8]; unsigned c = 0;
#pragma unroll
        for (int w = 0; w < 8; ++w) { wv[w] = HIST[q * IX_HSTR + lane8 + w]; c += (wv[w] & 0xffffu) + (wv[w] >> 16); }
        unsigned x = c;
#pragma unroll
        for (int off = 1; off < 64; off <<= 1) { const unsigned y = __shfl_down(x, off); if (lane + off < 64) x += y; }
        const unsigned sx = x - c;
        if (sx < 256u && x >= 256u) {
            unsigned cum = sx; int found = 0, tb = 0, kr = 0, tc = 0;
#pragma unroll
            for (int w = 7; w >= 0; --w) {
                const unsigned hc = wv[w] >> 16, lc = wv[w] & 0xffffu;
                if (!found) { if (cum + hc >= 256u) { found = 1; tb = 2 * lane8 + 2 * w + 1; kr = 256 - (int)cum; tc = (int)hc; } else cum += hc; }
                if (!found) { if (cum + lc >= 256u) { found = 1; tb = 2 * lane8 + 2 * w; kr = 256 - (int)cum; tc = (int)lc; } else cum += lc; }
            }
            META[q] = tb; META[32 + q] = kr; META[64 + q] = tc;
        }
    }
    LDS_WAIT(); __builtin_amdgcn_s_barrier(); asm volatile("" ::: "memory");
    {
        const int tb = META[r32];
#pragma unroll 1
        for (int kt = 2 * wave; kt <= 2 * chunk + 1; kt = (kt & 1) ? kt + 15 : kt + 1) {
            bf16x8 kf[1][4];
            { const bf16_t* p = KIb + (size_t)(kt * 32 + r32) * 64 + hi * 8;
#pragma unroll
              for (int s = 0; s < 4; ++s) kf[0][s] = *(const bf16x8*)(p + s * 16); }
            f32x16 sc[1];
            ix_scores<1>(sc, kf, qrow, sg);
            unsigned bits = 0u;
#pragma unroll
            for (int r = 0; r < 16; ++r) {
                const int bin = ix_bin(sc[0][r], R, scale);
                const int pos = (r & 3) + 8 * (r >> 2);
                if (bin > tb) bits |= 1u << pos;
                if (bin == tb) {
                    const int p = __hip_atomic_fetch_add(META + 96 + r32, 1, __ATOMIC_RELAXED, __HIP_MEMORY_SCOPE_WORKGROUP);
                    if (p < IX_CAP) { CK[r32 * IX_CAP + p] = sc[0][r]; CI[r32 * IX_CAP + p] = (unsigned short)(kt * 32 + pos + 4 * hi); }
                }
            }
            bits <<= 4 * hi;
            bits |= __shfl_xor(bits, 32);
            if (hi == 0) BM[r32 * IX_BSTR + kt] = bits;
        }
    }
    LDS_WAIT(); __builtin_amdgcn_s_barrier(); asm volatile("" ::: "memory");
#pragma unroll 1
    for (int i = 0; i < 4; ++i) {
        const int q = wave * 4 + i;
        int c = META[96 + q]; c = c > IX_CAP ? IX_CAP : c;
        const int kr = META[32 + q];
        for (int e = lane; e < c; e += 64) {
            const float ke = CK[q * IX_CAP + e]; const int ie = CI[q * IX_CAP + e];
            int rank = 0;
            for (int j = 0; j < c; ++j) { const float kj = CK[q * IX_CAP + j]; const int ij = CI[q * IX_CAP + j]; rank += (kj > ke || (kj == ke && ij < ie)) ? 1 : 0; }
            if (rank < kr) __hip_atomic_fetch_or(BM + q * IX_BSTR + (ie >> 5), 1u << (ie & 31), __ATOMIC_RELAXED, __HIP_MEMORY_SCOPE_WORKGROUP);
        }
    }
    LDS_WAIT(); __builtin_amdgcn_s_barrier(); asm volatile("" ::: "memory");
    for (int t = wave; t <= chunk; t += 8) MASK32[((size_t)(b * 128 + t) * SEQ + qt * 32 + r32) * 2 + hi] = BM[r32 * IX_BSTR + 2 * t + hi];
    LDS_WAIT(); __builtin_amdgcn_s_barrier(); asm volatile("" ::: "memory");
}
__device__ __forceinline__ void idx_phase(LAS unsigned char* lds, const int wave, unsigned char* ws) {
    for (int v = blockIdx.x; v < 256; v += gridDim.x) {
        const int b = v >> 7, j = v & 127;
#pragma unroll 1
        for (int u = 0; u < 2; ++u) idx_unit(lds, wave, ws, b, u ? 255 - j : j);
    }
}
struct Args { const float* in[22]; float* out; unsigned char* ws; int ph_lo, ph_hi, coop, pad; };
enum Phase { P_PRO = 0, P_IN0, P_ATT0, P_OUT0, P_UP0, P_DN0, P_IN1, P_QUP, P_IDX, P_ATT1, P_OUT1, P_UP1, P_DN1, P_N, P_BRIDGE = 20 };

template <class Epi> __device__ __forceinline__ void run_gemm(LAS unsigned char* lds, const int wave, const bf16_t* A, const bf16_t* Bt, int N, int K, const Epi& E) {
    pg8::Gemm g{A, Bt, TOK, N, K}; pg8::StaticOrder S; S.init(TOK, N, (int)gridDim.x, (int)blockIdx.x);
    pg8::gemm_phase<Epi, pg8::StaticOrder, true, true>(lds, g, S, E, wave, fresh_lane());
}

__global__ void __launch_bounds__(NWAVES * 64, 2) mk_fwd(Args args) {
    extern __shared__ __attribute__((aligned(16))) unsigned char lds_raw[];
    LAS unsigned char* lds = (LAS unsigned char*)lds_raw;
    const int wave = __builtin_amdgcn_readfirstlane(threadIdx.x >> 6);
    const int G = gridDim.x;
    unsigned char* ws = args.ws;
    const int lo = args.ph_lo, hi = args.ph_hi;
    volatile LAS unsigned* MISC = (volatile LAS unsigned*)(lds + MISC_OFF);
    { const int tid = wave * 64 + fresh_lane(); for (int u = tid; u < (LDS_BYTES - RING_BYTES) / 4; u += NWAVES * 64) ((LAS unsigned*)(lds + RING_BYTES))[u] = 0u; }
    __syncthreads();
    XcdBarrier bar; bar.bar = (unsigned*)(ws + WS_CTL); bar.x = 0; bar.st = nullptr;
    if (args.coop) bar = xcd_barrier_post((unsigned*)(ws + WS_CTL), MISC + 8);
#define IN(k) (lo <= (k) && (k) < hi)
#define SEAM(k) do { if (args.coop && IN(k) && IN((k) + 1)) xcd_barrier(bar, wave); } while (0)
    bf16_t* XB = (bf16_t*)(ws + WS_XB); bf16_t* QB = (bf16_t*)(ws + WS_Q); bf16_t* KB = (bf16_t*)(ws + WS_K); bf16_t* VB = (bf16_t*)(ws + WS_V); bf16_t* UB = (bf16_t*)(ws + WS_U);
    float* PART = (float*)(ws + WS_PART); float* CS = (float*)(ws + WS_CS); float* LAM = (float*)(ws + WS_MISC);

    if (IN(P_PRO)) {
        const int lane = fresh_lane(), tid = wave * 64 + lane;
        LAS float* scr = (LAS float*)(lds + wave * 16384);
        const int gw = blockIdx.x * NWAVES + wave, NGW = G * NWAVES;
        const float* nmix = args.in[2]; const float* nmlp = args.in[3];
        int base = 0;
#define DOJOB(W_, gain_, WT_, K_, N_, Npad_, roff_) do { const int nblk = (Npad_) / 32, nitems = ((K_) / 64) * nblk; \
            for (int it = (gw - base % NGW + NGW) % NGW; it < nitems; it += NGW) p0_transpose_item((W_), (K_), (N_), (gain_), (bf16_t*)(ws + (WT_)), (roff_), scr, it, nblk, lane); \
            base += nitems; } while (0)
        DOJOB(args.in[6], nmix, WS_WIN0, DM, 3072, 3072, 0);
        DOJOB(args.in[14], (const float*)nullptr, WS_WOUT0, DM, DM, DM, 0);
        DOJOB(args.in[4], nmlp, WS_W1_0, DM, DFF, DFF, 0);
        DOJOB(args.in[5], (const float*)nullptr, WS_W2_0, DFF, DM, DM, 0);
        DOJOB(args.in[15], nmix + DM, WS_WIN1, DM, NIN1, NIN1P, 0);
        DOJOB(args.in[17], args.in[16], WS_WUQ, 256, DM, DM, 0);
        DOJOB(args.in[18], args.in[16], WS_WUQ, 256, 512, 512, 1024);
        DOJOB(args.in[21], (const float*)nullptr, WS_WOUT1, DM, DM, DM, 0);
        DOJOB(args.in[4] + (size_t)DM * DFF, nmlp + DM, WS_W1_1, DM, DFF, DFF, 0);
        DOJOB(args.in[5] + (size_t)DM * DFF, (const float*)nullptr, WS_W2_1, DFF, DM, DM, 0);
#undef DOJOB
        for (int m = gw; m < TOK; m += NGW) row_to_bf16(args.in[0] + (size_t)m * DM, XB + (size_t)m * DM, PART + (size_t)m * 16, lane);
        const int* pos = (const int*)args.in[1];
        for (int t = blockIdx.x * (NWAVES * 64) + tid; t < TOK * 8; t += G * NWAVES * 64) {
            const int tok = t >> 3, i = t & 7;
            const float inv = (float)pow(500000.0, -(double)i / 8.0);
            const float ang = (float)pos[tok] * inv;
            CS[tok * 16 + i] = (float)cos((double)ang); CS[tok * 16 + 8 + i] = (float)sin((double)ang);
        }
        if (blockIdx.x == 0 && tid == 0) {
            float s1 = 0.f, s2 = 0.f;
            for (int i = 0; i < 64; ++i) { s1 += args.in[9][i] * args.in[10][i]; s2 += args.in[11][i] * args.in[12][i]; }
            LAM[0] = expf(s1) - expf(s2) + 0.2f;
        }
    }
    SEAM(P_PRO);
    if (IN(P_BRIDGE)) {
        const int lane = fresh_lane();
        const int gw = blockIdx.x * NWAVES + wave, NGW = G * NWAVES;
        for (int m = gw; m < TOK; m += NGW) row_to_bf16(args.out + (size_t)m * DM, XB + (size_t)m * DM, PART + (size_t)m * 16, lane);
    }
    if (IN(P_IN0)) { EpiQKV0 E{PART, CS, args.in[7], args.in[8], QB, (size_t)(WS_K - WS_Q) / 2, 0.125f * LOG2E}; run_gemm(lds, wave, XB, (const bf16_t*)(ws + WS_WIN0), 3072, DM, E); }
    SEAM(P_IN0);
    if (IN(P_ATT0)) { attn0_phase(lds, wave, ws, args.in[13]); }
    SEAM(P_ATT0);
    if (IN(P_OUT0)) { EpiResid E{args.in[0], args.out, XB, PART}; run_gemm(lds, wave, QB, (const bf16_t*)(ws + WS_WOUT0), DM, DM, E); }
    SEAM(P_OUT0);
    if (IN(P_UP0)) { EpiUp E{PART, UB}; run_gemm(lds, wave, XB, (const bf16_t*)(ws + WS_W1_0), DFF, DM, E); }
    SEAM(P_UP0);
    if (IN(P_DN0)) { EpiResid E{args.out, args.out, XB, PART}; run_gemm(lds, wave, UB, (const bf16_t*)(ws + WS_W2_0), DM, DFF, E); }
    SEAM(P_DN0);
    if (IN(P_IN1)) { EpiIn1 E{PART, CS, args.in[20], (bf16_t*)(ws + WS_CQ), (float*)(ws + WS_CQP), KB, VB, (bf16_t*)(ws + WS_KI), (float*)(ws + WS_WIDX), 0.35355339059327373f * 0.125f};
        run_gemm(lds, wave, XB, (const bf16_t*)(ws + WS_WIN1), NIN1P, DM, E); }
    SEAM(P_IN1);
    if (IN(P_QUP)) { EpiQup E{(const float*)(ws + WS_CQP), CS, args.in[19], (const float*)(ws + WS_WIDX), QB, (bf16_t*)(ws + WS_QI), (float*)(ws + WS_QIN), 0.125f * LOG2E};
        run_gemm(lds, wave, (const bf16_t*)(ws + WS_CQ), (const bf16_t*)(ws + WS_WUQ), 1536, 256, E); }
    SEAM(P_QUP);
    if (IN(P_IDX)) { idx_phase(lds, wave, ws); }
    SEAM(P_IDX);
    if (IN(P_ATT1)) { attn1_phase(lds, wave, ws); }
    SEAM(P_ATT1);
    if (IN(P_OUT1)) { EpiResid E{args.out, args.out, XB, PART}; run_gemm(lds, wave, QB, (const bf16_t*)(ws + WS_WOUT1), DM, DM, E); }
    SEAM(P_OUT1);
    if (IN(P_UP1)) { EpiUp E{PART, UB}; run_gemm(lds, wave, XB, (const bf16_t*)(ws + WS_W1_1), DFF, DM, E); }
    SEAM(P_UP1);
    if (IN(P_DN1)) { EpiResid E{args.out, args.out, nullptr, nullptr}; run_gemm(lds, wave, UB, (const bf16_t*)(ws + WS_W2_1), DM, DFF, E); }
#undef IN
#undef SEAM
}

static int g_mk_ready = 0;
static void mk_launch(hipStream_t st, void* const* d_in, void* d_out, void* d_ws, int lo, int hi, int coop) {
    if (!g_mk_ready) { (void)hipFuncSetAttribute((const void*)mk_fwd, hipFuncAttributeMaxDynamicSharedMemorySize, LDS_BYTES); g_mk_ready = 1; }
    Args a{};
    for (int i = 0; i < 22; ++i) a.in[i] = (const float*)d_in[i];
    a.out = (float*)d_out; a.ws = (unsigned char*)d_ws; a.ph_lo = lo; a.ph_hi = hi; a.coop = coop; a.pad = 0;
    hipLaunchKernelGGL(mk_fwd, dim3(256), dim3(NWAVES * 64), LDS_BYTES, st, a);
}

extern "C" void kernel_launch(void* const* d_in, const int* in_sizes, int n_in, void* d_out, int out_size, void* d_ws, size_t ws_size, hipStream_t stream) {
    char* ws = (char*)d_ws;
    const float* x = (const float*)d_in[0];
    float* out = (float*)d_out;
    nv::prep_naive(stream, d_in, ws);
    mk_launch(stream, d_in, d_out, d_ws, P_PRO, P_PRO + 1, 0);
    mk_launch(stream, d_in, d_out, d_ws, P_IN0, P_IN0 + 1, 0);
    mk_launch(stream, d_in, d_out, d_ws, P_ATT0, P_ATT0 + 1, 0);
    mk_launch(stream, d_in, d_out, d_ws, P_OUT0, P_OUT0 + 1, 0);
    mk_launch(stream, d_in, d_out, d_ws, P_UP0, P_UP0 + 1, 0);
    mk_launch(stream, d_in, d_out, d_ws, P_DN0, P_DN0 + 1, 0);
    for (int p = P_IN1; p <= P_DN1; ++p) mk_launch(stream, d_in, d_out, d_ws, p, p + 1, 0);
}
```

```cpp
#include <hip/hip_runtime.h>
#include <stdint.h>
#include <math.h>
#include <stdio.h>
#ifndef PROBE_PHASE
#define PROBE_PHASE (-1)
#endif
#define LAS __attribute__((address_space(3)))
#define GAS __attribute__((address_space(1)))
typedef unsigned short bf16_t;
typedef short bf16x8 __attribute__((ext_vector_type(8)));
typedef float f32x4 __attribute__((ext_vector_type(4)));
typedef float f32x16 __attribute__((ext_vector_type(16)));
typedef unsigned u32x4 __attribute__((ext_vector_type(4)));
typedef unsigned u32x2 __attribute__((ext_vector_type(2)));

constexpr int BATCH = 2, SEQ = 8192, DM = 1024, DFF = 4096, TOK = BATCH * SEQ;
constexpr float EPS = 1e-6f;
constexpr float LOG2E = 1.4426950408889634f;
constexpr int NIN1 = 2376, NIN1P = 2560;
constexpr size_t MiB = 1u << 20;
constexpr size_t WS_XB = 0, WS_Q = 32 * MiB, WS_K = 64 * MiB, WS_V = 96 * MiB, WS_U = 32 * MiB;
constexpr size_t WS_CQ = 160 * MiB, WS_QI = 168 * MiB, WS_KI = 184 * MiB, WS_MASK = 186 * MiB;
constexpr size_t WS_CS = 204 * MiB, WS_MISC = 205 * MiB, WS_PART = 206 * MiB, WS_CQP = 207 * MiB, WS_WIDX = 207 * MiB + 256 * 1024;
constexpr size_t WS_QIN = WS_MISC + 512 * 1024;
constexpr size_t WS_CTL = WS_MISC + 4096;
constexpr size_t CTL_BYTES = 64 * 1024;
constexpr size_t WS_WIN0 = 208 * MiB, WS_WOUT0 = 214 * MiB, WS_W1_0 = 216 * MiB, WS_W2_0 = 224 * MiB, WS_WIN1 = 232 * MiB, WS_WUQ = 237 * MiB,
                 WS_WOUT1 = 238 * MiB, WS_W1_1 = 240 * MiB, WS_W2_1 = 248 * MiB, WS_END = 256 * MiB;

__device__ __forceinline__ unsigned cvt_pk_bf16(float lo, float hi) {
    typedef float f32x2_t __attribute__((ext_vector_type(2))); typedef __bf16 bf16x2_t __attribute__((ext_vector_type(2)));
    f32x2_t v = {lo, hi}; bf16x2_t b = __builtin_convertvector(v, bf16x2_t); return __builtin_bit_cast(unsigned, b);
}
__host__ __device__ __forceinline__ int tile_pos(int cl) { const int wc = cl >> 6, fq = (cl >> 4) & 3, bj = (cl >> 3) & 1, n = (cl >> 2) & 1, j = cl & 3; return 128 * bj + 32 * wc + 16 * n + 4 * fq + j; }
__device__ __forceinline__ int fresh_lane() { int l; asm volatile("v_mbcnt_lo_u32_b32 %0, -1, 0\n\tv_mbcnt_hi_u32_b32 %0, -1, %0" : "=v"(l)); return l; }
__device__ __forceinline__ float wave_sum(float v) {
#pragma unroll
    for (int o = 1; o < 64; o <<= 1) v += __shfl_xor(v, o);
    return v;
}
namespace pg8 {
#define PG8_LAS __attribute__((address_space(3)))
typedef unsigned short bf16_t;
typedef short bf16x8 __attribute__((ext_vector_type(8)));
typedef float f32x4 __attribute__((ext_vector_type(4)));
typedef unsigned u32x4 __attribute__((ext_vector_type(4)));
constexpr int BM = 256, BK = 64, HALF = 128, HTB = HALF * BK * 2  , STAGE_BYTES = 8 * HTB, NXCD = 8, WGM = 8;

__host__ __device__ __forceinline__ int lds_byte(int r, int c) { const int st = (r >> 4) * 2 + (c >> 5), rr = r & 15, cc = c & 31, ob = rr * 64 + cc * 2; return st * 1024 + (ob ^ (((ob >> 9) & 1) << 5)); }
__host__ __device__ __forceinline__ void stage_rc(int b, int& R, int& C) { const int st = b / 1024, sb = b % 1024, swz = sb ^ (((sb >> 9) & 1) << 5); R = (st >> 1) * 16 + swz / 64; C = (st & 1) * 32 + (swz % 64) / 2; }
__host__ __device__ __forceinline__ int perm32(int rho) { const int n = rho >> 4, i = rho & 15; return 8 * (i >> 2) + 4 * n + (i & 3); }

struct Unit { int pm, pn; };
struct Gemm { const bf16_t* A; const bf16_t* Bt; int M, N, K; };

struct StaticOrder {
    int nM, nN, nwg, G, c;
    __host__ __device__ void init(int M, int N, int G_, int c_) { nM = M / BM; nN = N / BM; nwg = nM * nN; G = G_; c = c_; }
    __host__ __device__ bool next(int i, Unit& u) const {
        const long L = (long)i * G + c; if (L >= nwg) return false;
        int wgid = (int)L; { const int q = nwg / NXCD, r = nwg % NXCD, xcd = wgid % NXCD, off = wgid / NXCD; wgid = (xcd < r ? xcd * (q + 1) : r * (q + 1) + (xcd - r) * q) + off; }
        const int nig = WGM * nN, gid = wgid / nig, fm = gid * WGM, gsz = (nM - fm) < WGM ? (nM - fm) : WGM;
        u.pm = fm + ((wgid % nig) % gsz); u.pn = (wgid % nig) / gsz; return true;
    }
    __device__ __forceinline__ void a_ready(const Unit&) const {}
    __device__ __forceinline__ void done(const Unit&) const {}
};

__device__ __forceinline__ unsigned cvt_pk_bf16(float lo, float hi) { unsigned r; asm volatile("v_cvt_pk_bf16_f32 %0, %1, %2" : "=v"(r) : "v"(lo), "v"(hi)); return r; }
typedef float f32x2 __attribute__((ext_vector_type(2)));
template <class Epi, class Sched, bool ALIGN_EPI = false, bool SP2 = false>
__device__ __forceinline__ void gemm_phase(PG8_LAS unsigned char* lds, const Gemm g, const Sched& S, const Epi& E, const int wid, const int lane) {
    const int tid = wid * 64 + lane, wr = wid >> 2, wc = wid & 3, fr = lane & 15, fq = lane >> 4;
    const int K = g.K, nt = K / BK;
    unsigned voffA[2], voffB[2];
#pragma unroll
    for (int i = 0; i < 2; ++i) { int R, C; stage_rc(tid * 16 + i * 8192, R, C); const int Rb = Epi::PERM ? ((R & ~31) + perm32(R & 31)) : R;
        voffA[i] = (unsigned)(R * K + C) * 2u; voffB[i] = (unsigned)(Rb * K + C) * 2u; }
    const size_t kstep = (size_t)(BK * 2);
    const size_t hstep = (size_t)HALF * K * 2;
    const size_t tstep = 2 * hstep;
    const unsigned ldsw = (unsigned)wid * 1024u;
    const int aoff = lds_byte(wr * 64 + fr, fq * 8), boff = lds_byte(wc * 32 + fr, fq * 8);
#define PG8_SA(b, h) (((b) * 2 + (h)) * HTB)
#define PG8_SB(b, h) ((4 + (b) * 2 + (h)) * HTB)
#define PG8_STAGE(bufoff, gbase, voff) do { _Pragma("unroll") for (int _i = 0; _i < 2; ++_i) \
        __builtin_amdgcn_global_load_lds((const unsigned*)((const char*)(gbase) + (voff)[_i]), (PG8_LAS unsigned*)(lds + (bufoff) + ldsw + _i * 8192), 16, 0, 0); } while (0)
#define PG8_LDA(dst, b, h) do { _Pragma("unroll") for (int m = 0; m < 4; ++m) _Pragma("unroll") for (int k = 0; k < 2; ++k) dst[m][k] = *(const PG8_LAS bf16x8*)(lds + PG8_SA(b, h) + aoff + m * 2048 + k * 1024); } while (0)
#define PG8_LDB(dst, b, h) do { _Pragma("unroll") for (int n = 0; n < 2; ++n) _Pragma("unroll") for (int k = 0; k < 2; ++k) dst[n][k] = *(const PG8_LAS bf16x8*)(lds + PG8_SB(b, h) + boff + n * 2048 + k * 1024); } while (0)
#define PG8_MMA(ai, bj, At, Bt) do { __builtin_amdgcn_s_setprio(1); _Pragma("unroll") for (int m = 0; m < 4; ++m) _Pragma("unroll") for (int n = 0; n < 2; ++n) _Pragma("unroll") for (int k = 0; k < 2; ++k) \
        acc[ai][bj][m][n] = __builtin_amdgcn_mfma_f32_16x16x32_bf16(Bt[n][k], At[m][k], acc[ai][bj][m][n], 0, 0, 0); __builtin_amdgcn_s_setprio(0); } while (0)
#define PG8_WAIT_V(n) asm volatile("s_waitcnt vmcnt(" #n ")" ::: "memory")
#define PG8_WAIT_L(n) asm volatile("s_waitcnt lgkmcnt(" #n ")" ::: "memory")
#define PG8_BAR __builtin_amdgcn_s_barrier()
#define PG8_SCHED __builtin_amdgcn_sched_barrier(0)
    Unit cur, nxt; int ui = 0;
    if (!S.next(0, cur)) return;
    f32x4 acc[2][2][4][2];
#pragma unroll
    for (int a = 0; a < 2; ++a)
#pragma unroll
        for (int b = 0; b < 2; ++b)
#pragma unroll
            for (int m = 0; m < 4; ++m)
#pragma unroll
                for (int n = 0; n < 2; ++n) acc[a][b][m][n] = (f32x4){0.f, 0.f, 0.f, 0.f};
    bf16x8 At[4][2], B0[2][2], B1[2][2];
    const char* cA = (const char*)g.A + (size_t)cur.pm * tstep; const char* cB = (const char*)g.Bt + (size_t)cur.pn * tstep;
    S.a_ready(cur);
    if constexpr (SP2) {
        PG8_STAGE(PG8_SB(0, 0), cB, voffB); PG8_STAGE(PG8_SB(0, 1), cB + hstep, voffB); PG8_STAGE(PG8_SA(0, 0), cA, voffA); PG8_STAGE(PG8_SA(0, 1), cA + hstep, voffA);
        if (wr == 1) PG8_BAR;
        PG8_WAIT_V(2); PG8_BAR;
        PG8_STAGE(PG8_SB(1, 0), cB + kstep, voffB); PG8_STAGE(PG8_SA(1, 0), cA + kstep, voffA); PG8_STAGE(PG8_SB(1, 1), cB + hstep + kstep, voffB);
        PG8_WAIT_V(6); PG8_BAR;
    } else {
        PG8_STAGE(PG8_SB(0, 0), cB, voffB); PG8_STAGE(PG8_SA(0, 0), cA, voffA); PG8_STAGE(PG8_SB(0, 1), cB + hstep, voffB); PG8_STAGE(PG8_SA(0, 1), cA + hstep, voffA);
        if (wr == 1) PG8_BAR;
        PG8_WAIT_V(4); PG8_BAR;
        PG8_STAGE(PG8_SB(1, 0), cB + kstep, voffB); PG8_STAGE(PG8_SA(1, 0), cA + kstep, voffA); PG8_STAGE(PG8_SB(1, 1), cB + hstep + kstep, voffB);
        PG8_WAIT_V(6); PG8_BAR;
    }
    for (;;) {
        const bool has_next = S.next(ui + 1, nxt);
        const char* nA = has_next ? (const char*)g.A + (size_t)nxt.pm * tstep : cA; const char* nB = has_next ? (const char*)g.Bt + (size_t)nxt.pn * tstep : cB;
        for (int t = 0; t < nt; t += 2) {
            const bool last = (t == nt - 2);
            const char* a1 = cA + (size_t)(t + 1) * kstep;
            const char* a2 = last ? nA : cA + (size_t)(t + 2) * kstep; const char* b2 = last ? nB : cB + (size_t)(t + 2) * kstep;
            const char* a3 = a2 + kstep; const char* b3 = b2 + kstep;
            if (last && has_next) S.a_ready(nxt);
            if constexpr (SP2) {
            PG8_LDB(B0, 0, 0); PG8_LDB(B1, 0, 1); PG8_SCHED; PG8_LDA(At, 0, 0); PG8_STAGE(PG8_SA(1, 1), a1 + hstep, voffA);
            PG8_WAIT_V(8); PG8_WAIT_L(0); PG8_BAR; PG8_MMA(0, 0, At, B0); PG8_MMA(0, 1, At, B1); PG8_BAR; PG8_SCHED;
            PG8_LDA(At, 0, 1); PG8_STAGE(PG8_SB(0, 0), b2, voffB); PG8_STAGE(PG8_SB(0, 1), b2 + hstep, voffB); PG8_STAGE(PG8_SA(0, 0), a2, voffA);
            PG8_WAIT_V(8); PG8_WAIT_L(0); PG8_BAR; PG8_MMA(1, 0, At, B0); PG8_MMA(1, 1, At, B1); PG8_BAR; PG8_SCHED;
            PG8_LDB(B0, 1, 0); PG8_LDB(B1, 1, 1); PG8_SCHED; PG8_LDA(At, 1, 0); PG8_STAGE(PG8_SA(0, 1), a2 + hstep, voffA);
            PG8_WAIT_V(8); PG8_WAIT_L(0); PG8_BAR; PG8_MMA(0, 0, At, B0); PG8_MMA(0, 1, At, B1); PG8_BAR; PG8_SCHED;
            PG8_LDA(At, 1, 1); PG8_STAGE(PG8_SB(1, 0), b3, voffB); PG8_STAGE(PG8_SB(1, 1), b3 + hstep, voffB); PG8_STAGE(PG8_SA(1, 0), a3, voffA);
            PG8_WAIT_V(8); PG8_WAIT_L(0); PG8_BAR; PG8_MMA(1, 0, At, B0); PG8_MMA(1, 1, At, B1); PG8_BAR; PG8_SCHED;
            } else {
            PG8_LDB(B0, 0, 0); PG8_SCHED; PG8_LDA(At, 0, 0); PG8_STAGE(PG8_SA(1, 1), a1 + hstep, voffA);
            PG8_WAIT_L(8); PG8_BAR; PG8_WAIT_L(0); PG8_MMA(0, 0, At, B0); PG8_BAR; PG8_SCHED;
            PG8_LDB(B1, 0, 1); PG8_STAGE(PG8_SB(0, 0), b2, voffB);
            PG8_BAR; PG8_WAIT_L(0); PG8_MMA(0, 1, At, B1); PG8_BAR;
            PG8_LDA(At, 0, 1); PG8_STAGE(PG8_SA(0, 0), a2, voffA);
            PG8_BAR; PG8_WAIT_L(0); PG8_MMA(1, 0, At, B0); PG8_BAR; PG8_SCHED;
            PG8_STAGE(PG8_SB(0, 1), b2 + hstep, voffB);
            PG8_WAIT_V(6); PG8_BAR; PG8_MMA(1, 1, At, B1); PG8_BAR;
            PG8_LDB(B0, 1, 0); PG8_SCHED; PG8_LDA(At, 1, 0); PG8_STAGE(PG8_SA(0, 1), a2 + hstep, voffA);
            PG8_WAIT_L(8); PG8_BAR; PG8_WAIT_L(0); PG8_MMA(0, 0, At, B0); PG8_BAR; PG8_SCHED;
            PG8_LDB(B1, 1, 1); PG8_STAGE(PG8_SB(1, 0), b3, voffB);
            PG8_BAR; PG8_WAIT_L(0); PG8_MMA(0, 1, At, B1); PG8_BAR;
            PG8_LDA(At, 1, 1); PG8_STAGE(PG8_SA(1, 0), a3, voffA);
            PG8_BAR; PG8_WAIT_L(0); PG8_MMA(1, 0, At, B0); PG8_BAR; PG8_SCHED;
            PG8_STAGE(PG8_SB(1, 1), b3 + hstep, voffB);
            PG8_WAIT_V(6); PG8_BAR; PG8_MMA(1, 1, At, B1); PG8_BAR;
            }
        }
        if constexpr (ALIGN_EPI) { if (wr == 0) PG8_BAR; }
        if constexpr (!Epi::AFTER_DRAIN) { const int le = fresh_lane(); E(acc, cur, wr, wc, le & 15, le >> 4); S.done(cur); }
        if (!has_next) break;
#pragma unroll
        for (int a = 0; a < 2; ++a)
#pragma unroll
            for (int b = 0; b < 2; ++b)
#pragma unroll
                for (int m = 0; m < 4; ++m)
#pragma unroll
                    for (int n = 0; n < 2; ++n) acc[a][b][m][n] = (f32x4){0.f, 0.f, 0.f, 0.f};
        cur = nxt; cA = nA; cB = nB; ++ui;
        if constexpr (ALIGN_EPI) { if (wr == 1) PG8_BAR; }
    }
    PG8_WAIT_V(0);
    if constexpr (!ALIGN_EPI) { if (wr == 0) PG8_BAR; }
    PG8_BAR;
    if constexpr (Epi::AFTER_DRAIN) { E.fused(acc, cur, wr, wc, fr, fq, lds, wid, lane); S.done(cur); }
#undef PG8_SA
#undef PG8_SB
#undef PG8_STAGE
#undef PG8_LDA
#undef PG8_LDB
#undef PG8_MMA
#undef PG8_WAIT_V
#undef PG8_WAIT_L
#undef PG8_BAR
#undef PG8_SCHED
}
}
typedef f32x4 acc_t[2][2][4][2];

__device__ __forceinline__ float rstd_from_parts16(const float* __restrict__ part, int row) {
    const f32x4* p = (const f32x4*)(part + (size_t)row * 16);
    const f32x4 a = p[0], b = p[1], c = p[2], d = p[3];
    const float s = ((a[0] + a[1]) + (a[2] + a[3])) + ((b[0] + b[1]) + (b[2] + b[3])) + ((c[0] + c[1]) + (c[2] + c[3])) + ((d[0] + d[1]) + (d[2] + d[3]));
    return 1.0f / sqrtf(s * (1.0f / 1024.0f) + EPS);
}
constexpr int EPI_TBL_OFF = 131072;
__device__ __forceinline__ void fill_rstd16(LAS float* T, const float* __restrict__ part, int pm, int wr, int lane) {
    const float r0 = rstd_from_parts16(part, pm * 256 + wr * 64 + lane), r1 = rstd_from_parts16(part, pm * 256 + 128 + wr * 64 + lane);
    T[lane] = r0; T[64 + lane] = r1;
}
__device__ __forceinline__ float quad_sum(float s) { s += __shfl_xor(s, 16); s += __shfl_xor(s, 32); return s; }
__device__ __forceinline__ float sumsq16(const f32x4 (&v)[2][2]) {
    float s = 0.f;
#pragma unroll
    for (int bj = 0; bj < 2; ++bj)
#pragma unroll
        for (int n = 0; n < 2; ++n) s += (v[bj][n][0] * v[bj][n][0] + v[bj][n][1] * v[bj][n][1]) + (v[bj][n][2] * v[bj][n][2] + v[bj][n][3] * v[bj][n][3]);
    return s;
}
__device__ __forceinline__ void head_norm_rope(f32x4 (&v)[2][2], bool do_norm, bool use_gain, const f32x4 (&g)[2][2], const float* __restrict__ cs_row, int fq, float scale) {
    if (do_norm) {
        const float ss = quad_sum(sumsq16(v));
        const float rn = 1.0f / sqrtf(ss * (1.0f / 64.0f) + EPS);
#pragma unroll
        for (int bj = 0; bj < 2; ++bj)
#pragma unroll
            for (int n = 0; n < 2; ++n) { v[bj][n] = v[bj][n] * rn; if (use_gain) v[bj][n] = v[bj][n] * g[bj][n]; }
    }
    if (fq == 0) {
        const f32x4* c4 = (const f32x4*)cs_row;
#pragma unroll
        for (int n = 0; n < 2; ++n) {
            const f32x4 c = c4[n], s = c4[2 + n];
            const f32x4 x1 = v[0][n], x2 = v[1][n];
            v[0][n] = x1 * c - x2 * s;
            v[1][n] = x2 * c + x1 * s;
        }
    }
    if (scale != 1.0f) {
#pragma unroll
        for (int bj = 0; bj < 2; ++bj)
#pragma unroll
            for (int n = 0; n < 2; ++n) v[bj][n] = v[bj][n] * scale;
    }
}
__device__ __forceinline__ void store_bf16x16(bf16_t* p, const f32x4 (&v)[2][2]) {
#pragma unroll
    for (int bj = 0; bj < 2; ++bj) {
        u32x4 w; w.x = cvt_pk_bf16(v[bj][0][0], v[bj][0][1]); w.y = cvt_pk_bf16(v[bj][0][2], v[bj][0][3]); w.z = cvt_pk_bf16(v[bj][1][0], v[bj][1][1]); w.w = cvt_pk_bf16(v[bj][1][2], v[bj][1][3]);
        *(u32x4*)(p + 8 * bj) = w;
    }
}
__device__ __forceinline__ void load_gain16(f32x4 (&g)[2][2], const float* __restrict__ gp, int fq) {
#pragma unroll
    for (int bj = 0; bj < 2; ++bj)
#pragma unroll
        for (int n = 0; n < 2; ++n) g[bj][n] = *(const f32x4*)(gp + 16 * fq + 8 * bj + 4 * n);
}

struct EpiQKV0 {
    static constexpr bool PERM = false, AFTER_DRAIN = false;
    const float* part; const float* cs; const float* qg; const float* kg; bf16_t* QKV; size_t stride; float qscale; LAS float* T;
    __device__ __forceinline__ void operator()(const acc_t& acc, const pg8::Unit& u, int wr, int wc, int fr, int fq) const {
        const int kind = u.pn >> 2, head = (u.pn & 3) * 4 + wc;
        bf16_t* dst = QKV + (size_t)kind * stride + head * 64 + 16 * fq;
        f32x4 g[2][2] = {};
        if (kind < 2) load_gain16(g, kind == 0 ? qg : kg, fq);
        fill_rstd16(T, part, u.pm, wr, fr + 16 * fq);
#pragma unroll
        for (int ai = 0; ai < 2; ++ai)
#pragma unroll
            for (int m = 0; m < 4; ++m) {
                const int row = u.pm * 256 + ai * 128 + wr * 64 + m * 16 + fr;
                const float rs = T[ai * 64 + m * 16 + fr];
                f32x4 v[2][2];
#pragma unroll
                for (int bj = 0; bj < 2; ++bj)
#pragma unroll
                    for (int n = 0; n < 2; ++n) v[bj][n] = acc[ai][bj][m][n] * rs;
                if (kind < 2) head_norm_rope(v, true, true, g, cs + (size_t)row * 16, fq, kind == 0 ? qscale : 1.0f);
                store_bf16x16(dst + (size_t)row * DM, v);
            }
    }
};
template <bool RES_BF16, bool OUT_F32> struct EpiResidT {
    static constexpr bool PERM = false, AFTER_DRAIN = false;
    const float* R; const bf16_t* Rb; float* out; bf16_t* xb; float* part;
    __device__ __forceinline__ void operator()(const acc_t& acc, const pg8::Unit& u, int wr, int wc, int fr, int fq) const {
        const int col0 = u.pn * 256 + wc * 64 + 16 * fq;
#pragma unroll
        for (int ai = 0; ai < 2; ++ai)
#pragma unroll
            for (int m = 0; m < 4; ++m) {
                const int row = u.pm * 256 + ai * 128 + wr * 64 + m * 16 + fr;
                const size_t off = (size_t)row * DM + col0;
                f32x4 v[2][2];
                if (RES_BF16) {
#pragma unroll
                    for (int bj = 0; bj < 2; ++bj) {
                        const u32x4 w = *(const u32x4*)(Rb + off + 8 * bj);
                        const unsigned ww[4] = {w.x, w.y, w.z, w.w};
#pragma unroll
                        for (int n = 0; n < 2; ++n) {
                            f32x4 r; r[0] = __builtin_bit_cast(float, ww[2 * n] << 16); r[1] = __builtin_bit_cast(float, ww[2 * n] & 0xffff0000u);
                            r[2] = __builtin_bit_cast(float, ww[2 * n + 1] << 16); r[3] = __builtin_bit_cast(float, ww[2 * n + 1] & 0xffff0000u);
                            v[bj][n] = r + acc[ai][bj][m][n];
                        }
                    }
                } else {
#pragma unroll
                    for (int bj = 0; bj < 2; ++bj)
#pragma unroll
                        for (int n = 0; n < 2; ++n) v[bj][n] = *(const f32x4*)(R + off + 8 * bj + 4 * n) + acc[ai][bj][m][n];
                }
                if (OUT_F32) {
#pragma unroll
                    for (int bj = 0; bj < 2; ++bj)
#pragma unroll
                        for (int n = 0; n < 2; ++n) *(f32x4*)(out + off + 8 * bj + 4 * n) = v[bj][n];
                }
                if (xb) store_bf16x16(xb + off, v);
                if (part) { const float ss = quad_sum(sumsq16(v)); if (fq == 0) part[(size_t)row * 16 + u.pn * 4 + wc] = ss; }
            }
    }
};
struct EpiUp {
    static constexpr bool PERM = false, AFTER_DRAIN = false;
    const float* part; bf16_t* U; LAS float* T;
    __device__ __forceinline__ void operator()(const acc_t& acc, const pg8::Unit& u, int wr, int wc, int fr, int fq) const {
        const int col0 = u.pn * 256 + wc * 64 + 16 * fq;
        fill_rstd16(T, part, u.pm, wr, fr + 16 * fq);
#pragma unroll
        for (int ai = 0; ai < 2; ++ai)
#pragma unroll
            for (int m = 0; m < 4; ++m) {
                const int row = u.pm * 256 + ai * 128 + wr * 64 + m * 16 + fr;
                const float rs = T[ai * 64 + m * 16 + fr];
                f32x4 v[2][2];
#pragma unroll
                for (int bj = 0; bj < 2; ++bj)
#pragma unroll
                    for (int n = 0; n < 2; ++n) {
                        f32x4 t = acc[ai][bj][m][n] * rs;
#pragma unroll
                        for (int j = 0; j < 4; ++j) { const float r = fmaxf(t[j], 0.f); t[j] = r * r; }
                        v[bj][n] = t;
                    }
                store_bf16x16(U + (size_t)row * DFF + col0, v);
            }
    }
};
struct EpiIn1 {
    static constexpr bool PERM = false, AFTER_DRAIN = false;
    const float* part; const float* cs; const float* kg; bf16_t* CQ; float* cqp; bf16_t* K; bf16_t* V; bf16_t* KI; float* widx; float wscale; LAS float* T;
    __device__ __forceinline__ void operator()(const acc_t& acc, const pg8::Unit& u, int wr, int wc, int fr, int fq) const {
        const int pn = u.pn;
        if (pn == 9 && wc >= 2) return;
        f32x4 g[2][2] = {};
        if (pn >= 1 && pn <= 4) load_gain16(g, kg, fq);
        fill_rstd16(T, part, u.pm, wr, fr + 16 * fq);
#pragma unroll
        for (int ai = 0; ai < 2; ++ai)
#pragma unroll
            for (int m = 0; m < 4; ++m) {
                const int row = u.pm * 256 + ai * 128 + wr * 64 + m * 16 + fr;
                const float rs = T[ai * 64 + m * 16 + fr];
                f32x4 v[2][2];
#pragma unroll
                for (int bj = 0; bj < 2; ++bj)
#pragma unroll
                    for (int n = 0; n < 2; ++n) v[bj][n] = acc[ai][bj][m][n] * rs;
                if (pn == 0) {
                    store_bf16x16(CQ + (size_t)row * 256 + wc * 64 + 16 * fq, v);
                    const float ss = quad_sum(sumsq16(v)); if (fq == 0) cqp[(size_t)row * 4 + wc] = ss;
                } else if (pn <= 4) {
                    head_norm_rope(v, true, true, g, cs + (size_t)row * 16, fq, 1.0f);
                    store_bf16x16(K + (size_t)row * DM + ((pn - 1) * 4 + wc) * 64 + 16 * fq, v);
                } else if (pn <= 8) {
                    store_bf16x16(V + (size_t)row * DM + ((pn - 5) * 4 + wc) * 64 + 16 * fq, v);
                } else if (wc == 0) {
                    head_norm_rope(v, true, false, g, cs + (size_t)row * 16, fq, 1.0f);
                    store_bf16x16(KI + (size_t)row * 64 + 16 * fq, v);
                } else if (fq == 0) {
                    *(f32x4*)(widx + (size_t)row * 8) = v[0][0] * wscale; *(f32x4*)(widx + (size_t)row * 8 + 4) = v[0][1] * wscale;
                }
            }
    }
};
struct EpiQup {
    static constexpr bool PERM = false, AFTER_DRAIN = false;
    const float* cqp; const float* cs; const float* qg; const float* widx; bf16_t* Q; bf16_t* QI; float* qin; float qscale; LAS float* T;
    __device__ __forceinline__ void operator()(const acc_t& acc, const pg8::Unit& u, int wr, int wc, int fr, int fq) const {
        const int pn = u.pn;
        f32x4 g[2][2] = {};
        if (pn < 4) load_gain16(g, qg, fq);
        { const int lane = fr + 16 * fq;
          const f32x4 c0 = *(const f32x4*)(cqp + (size_t)(u.pm * 256 + wr * 64 + lane) * 4), c1 = *(const f32x4*)(cqp + (size_t)(u.pm * 256 + 128 + wr * 64 + lane) * 4);
          T[lane] = 1.0f / sqrtf(((c0[0] + c0[1]) + (c0[2] + c0[3])) * (1.0f / 256.0f) + EPS); T[64 + lane] = 1.0f / sqrtf(((c1[0] + c1[1]) + (c1[2] + c1[3])) * (1.0f / 256.0f) + EPS); }
#pragma unroll
        for (int ai = 0; ai < 2; ++ai)
#pragma unroll
            for (int m = 0; m < 4; ++m) {
                const int row = u.pm * 256 + ai * 128 + wr * 64 + m * 16 + fr;
                const float rs = T[ai * 64 + m * 16 + fr];
                f32x4 v[2][2];
#pragma unroll
                for (int bj = 0; bj < 2; ++bj)
#pragma unroll
                    for (int n = 0; n < 2; ++n) v[bj][n] = acc[ai][bj][m][n] * rs;
                if (pn < 4) {
                    head_norm_rope(v, true, true, g, cs + (size_t)row * 16, fq, qscale);
                    store_bf16x16(Q + (size_t)row * DM + (pn * 4 + wc) * 64 + 16 * fq, v);
                } else {
                    const int hh = (pn - 4) * 4 + wc;
                    head_norm_rope(v, false, false, g, cs + (size_t)row * 16, fq, 1.0f);
                    const float nrm = sqrtf(quad_sum(sumsq16(v)));
                    const float inv = nrm > 0.f ? 1.0f / (8.2f * nrm) : 0.f;
#pragma unroll
                    for (int bj = 0; bj < 2; ++bj)
#pragma unroll
                        for (int n = 0; n < 2; ++n) v[bj][n] = v[bj][n] * inv;
                    store_bf16x16(QI + (size_t)row * 512 + hh * 64 + 16 * fq, v);
                    if (fq == 0) qin[(size_t)row * 8 + hh] = widx[(size_t)row * 8 + hh] * (8.2f * nrm);
                }
            }
    }
};
typedef GAS unsigned gu32;
#define RLX_AGENT __ATOMIC_RELAXED, __HIP_MEMORY_SCOPE_AGENT
#define LDS_WAIT() asm volatile("s_waitcnt lgkmcnt(0)" ::: "memory")
#define VM_WAIT() asm volatile("s_waitcnt vmcnt(0)" ::: "memory")

constexpr int RING_BYTES = 143360;
constexpr int MISC_OFF = RING_BYTES + 320;
constexpr int LDS_BYTES = 147456;
constexpr int NWAVES = 8;

#define XB_TMO      128
#define XB_XCNT(j)  (256  + 64 * (j))
#define XB_XSUB(j)  (1280 + 64 * (j))
#define XB_XGEN(j)  (2304 + 64 * (j))
#define XB_TOP      3328
#define XB_TOPGEN   3392
#define XCD_BAR_WORDS 3456
#define XB_SPIN_CAP (1u << 18)
__device__ __forceinline__ unsigned xb_ld(unsigned* p)              { return __hip_atomic_load(p, __ATOMIC_RELAXED, __HIP_MEMORY_SCOPE_AGENT); }
__device__ __forceinline__ unsigned xb_add(unsigned* p, unsigned v) { return __hip_atomic_fetch_add(p, v, __ATOMIC_RELAXED, __HIP_MEMORY_SCOPE_AGENT); }
__device__ __forceinline__ unsigned xb_xcc_id() { return (unsigned)__builtin_amdgcn_s_getreg((3 << 11) | 20) & 0xFu; }
#define XB_SPIN(cond, bar) do { unsigned _sp = 0; while (cond) { __builtin_amdgcn_s_sleep(1); \
    if ((++_sp & 255u) == 0u) { if (xb_ld(&(bar)[XB_TMO])) break; if (_sp > XB_SPIN_CAP) { atomicAdd(&(bar)[XB_TMO], 1u); break; } } } } while (0)
struct XcdBarrier { unsigned* bar; unsigned x; volatile LAS unsigned* st; };
__device__ __forceinline__ XcdBarrier xcd_barrier_post(unsigned* bar, volatile LAS unsigned* st) {
    XcdBarrier b; b.bar = bar; b.x = xb_xcc_id(); b.st = st;
    if (threadIdx.x == 0) (void)xb_add(&bar[XB_XCNT(b.x)], 1u);
    return b;
}
__device__ __forceinline__ void xcd_barrier_complete(unsigned* bar, unsigned x, unsigned& nloc, unsigned& nx) {
    const unsigned G = gridDim.x * gridDim.y * gridDim.z;
    unsigned sum, cnt, mine, sp = 0u;
    for (;;) {
        sum = 0u; cnt = 0u; mine = 0u;
#pragma unroll
        for (unsigned j = 0; j < 16; ++j) { const unsigned c = xb_ld(&bar[XB_XCNT(j)]); sum += c; cnt += (c > 0u) ? 1u : 0u; mine = (j == x) ? c : mine; }
        if (sum == G) break;
        __builtin_amdgcn_s_sleep(1);
        if ((++sp & 255u) == 0u) { if (xb_ld(&bar[XB_TMO])) break; if (sp > XB_SPIN_CAP) { atomicAdd(&bar[XB_TMO], 1u); break; } }
    }
    nloc = mine > 0u ? mine : 1u; nx = cnt > 0u ? cnt : 1u;
}
__device__ __forceinline__ void xcd_barrier(const XcdBarrier& b, const int wave) {
    asm volatile("s_waitcnt vmcnt(0)" ::: "memory");
    __syncthreads();
    if (wave == 0 && fresh_lane() == 0) {
        unsigned* bar = b.bar;
        __builtin_amdgcn_s_waitcnt(0);
        unsigned nloc = b.st[0], nx = b.st[1];
        if (nloc == 0u) { xcd_barrier_complete(bar, b.x, nloc, nx); b.st[0] = nloc; b.st[1] = nx; }
        const unsigned old = xb_add(&bar[XB_XSUB(b.x)], 1u);
        const unsigned gen = old / nloc;
        if (old + 1u == (gen + 1u) * nloc) {
            __builtin_amdgcn_fence(__ATOMIC_RELEASE, "agent");
            asm volatile("s_waitcnt vmcnt(0)" ::: "memory");
            const unsigned og = xb_add(&bar[XB_TOP], 1u);
            const unsigned tg = og / nx;
            if (og + 1u == (tg + 1u) * nx) xb_add(&bar[XB_TOPGEN], 1u);
            else XB_SPIN(xb_ld(&bar[XB_TOPGEN]) == tg, bar);
            __builtin_amdgcn_fence(__ATOMIC_ACQUIRE, "agent");
            xb_add(&bar[XB_XGEN(b.x)], 1u);
            asm volatile("s_waitcnt vmcnt(0)" ::: "memory");
        } else {
            XB_SPIN(xb_ld(&bar[XB_XGEN(b.x)]) == gen, bar);
            __builtin_amdgcn_fence(__ATOMIC_ACQUIRE, "agent");
            asm volatile("s_waitcnt vmcnt(0)" ::: "memory");
        }
    }
    __syncthreads();
}

__device__ __forceinline__ unsigned f2bf(float f) { unsigned u = __builtin_bit_cast(unsigned, f); return (u + 0x7fffu + ((u >> 16) & 1u)) >> 16; }
__device__ __forceinline__ unsigned pk2(float lo, float hi) { return f2bf(lo) | (f2bf(hi) << 16); }
__device__ __forceinline__ void p0_transpose_item(const float* __restrict__ W, int K, int N, const float* __restrict__ gain, bf16_t* WT, int row_off, LAS float* scr, int item, int nblk, int lane) {
    const int kb = item / nblk, nb = item % nblk, k0 = 64 * kb, n0 = 32 * nb;
    const int cc = n0 + (lane & 31);
    float wv[32];
#pragma unroll
    for (int i = 0; i < 32; ++i) { const int kk = 2 * i + (lane >> 5); wv[i] = (cc < N) ? W[(size_t)(k0 + kk) * N + cc] : 0.f; }
    if (gain) {
#pragma unroll
        for (int i = 0; i < 32; ++i) wv[i] *= gain[k0 + 2 * i + (lane >> 5)];
    }
#pragma unroll
    for (int i = 0; i < 32; ++i) scr[(2 * i + (lane >> 5)) * 33 + (lane & 31)] = wv[i];
    LDS_WAIT(); asm volatile("" ::: "memory");
    const int c = lane & 7;
#pragma unroll
    for (int j = 0; j < 4; ++j) { const int n = (lane >> 3) + 8 * j; const LAS float* s = scr + (8 * c) * 33 + n;
        u32x4 o; o.x = pk2(s[0 * 33], s[1 * 33]); o.y = pk2(s[2 * 33], s[3 * 33]); o.z = pk2(s[4 * 33], s[5 * 33]); o.w = pk2(s[6 * 33], s[7 * 33]);
        const int cl = n0 + n; const int drow = row_off + (cl & ~255) + tile_pos(cl & 255);
        *(GAS u32x4*)(WT + (size_t)drow * K + k0 + 8 * c) = o; }
    LDS_WAIT(); asm volatile("" ::: "memory");
}
struct WJob { const float* W; const float* gain; bf16_t* WT; int K, N, Npad, row_off; };
template <int NR> __device__ __forceinline__ void rows_to_bf16(const float* x, bf16_t* xb, float* part, int m, int rstride, int lane) {
    f32x4 v[NR][4];
#pragma unroll
    for (int r = 0; r < NR; ++r) { const GAS f32x4* xr = (const GAS f32x4*)(x + (size_t)(m + r * rstride) * DM) + lane;
#pragma unroll
        for (int j = 0; j < 4; ++j) v[r][j] = xr[64 * j]; }
#pragma unroll
    for (int r = 0; r < NR; ++r) {
        float s = 0.f;
#pragma unroll
        for (int j = 0; j < 4; ++j) s += (v[r][j][0] * v[r][j][0] + v[r][j][1] * v[r][j][1]) + (v[r][j][2] * v[r][j][2] + v[r][j][3] * v[r][j][3]);
        s = wave_sum(s);
        GAS u32x2* o8 = (GAS u32x2*)(xb + (size_t)(m + r * rstride) * DM) + lane;
#pragma unroll
        for (int j = 0; j < 4; ++j) { u32x2 w; w.x = cvt_pk_bf16(v[r][j][0], v[r][j][1]); w.y = cvt_pk_bf16(v[r][j][2], v[r][j][3]); o8[64 * j] = w; }
        if (lane < 16) part[(size_t)(m + r * rstride) * 16 + lane] = (lane == 0) ? s : 0.f;
    }
}
constexpr int ATT_SCR = 131072;
constexpr int ATT_NST = 4;
typedef short v4i16_t __attribute__((ext_vector_type(4)));
typedef short s16x4 __attribute__((ext_vector_type(4)));
__device__ __forceinline__ int crow(int r, int hi) { return (r & 3) + 8 * (r >> 2) + 4 * hi; }
__device__ __forceinline__ s16x4 vtr(const LAS unsigned char* p) { return __builtin_bit_cast(s16x4, __builtin_amdgcn_ds_read_tr16_b64_v4i16((LAS v4i16_t*)p)); }
__device__ __forceinline__ void glds16(const void* gsrc, unsigned lds_dst) { unsigned keep;
    asm volatile("s_mov_b32 %0, m0\n\ts_mov_b32 m0, %2\n\ts_nop 0\n\tglobal_load_lds_dwordx4 %1, off\n\ts_mov_b32 m0, %0" : "=&s"(keep) : "v"(gsrc), "s"(lds_dst) : "memory"); }
__device__ __forceinline__ void glds4(const void* gsrc, unsigned lds_dst) { unsigned keep;
    asm volatile("s_mov_b32 %0, m0\n\ts_mov_b32 m0, %2\n\ts_nop 0\n\tglobal_load_lds_dword %1, off\n\ts_mov_b32 m0, %0" : "=&s"(keep) : "v"(gsrc), "s"(lds_dst) : "memory"); }
#define ATT_WAIT_BAR() do { asm volatile("s_waitcnt vmcnt(0) lgkmcnt(0)" ::: "memory"); __builtin_amdgcn_s_barrier(); asm volatile("" ::: "memory"); } while (0)
#define ATT_WAIT_BAR_N(N) do { asm volatile("s_waitcnt vmcnt(" #N ") lgkmcnt(0)" ::: "memory"); __builtin_amdgcn_s_barrier(); asm volatile("" ::: "memory"); } while (0)

__device__ __forceinline__ int att_k_src_chunk(int row, int slot) { return slot ^ ((row >> 1) & 7); }
__device__ __forceinline__ void att_qkt(f32x16& p0, f32x16& p1, const LAS unsigned char* Kslot, const int (&koff)[4], const bf16x8 (&qr)[4]) {
    p0 = (f32x16){}; p1 = (f32x16){};
#pragma unroll
    for (int d0 = 0; d0 < 4; ++d0) {
        const bf16x8 b0 = *(const LAS bf16x8*)(Kslot + koff[d0]);
        const bf16x8 b1 = *(const LAS bf16x8*)(Kslot + koff[d0] + 4096);
        p0 = __builtin_amdgcn_mfma_f32_32x32x16_bf16(b0, qr[d0], p0, 0, 0, 0);
        p1 = __builtin_amdgcn_mfma_f32_32x32x16_bf16(b1, qr[d0], p1, 0, 0, 0);
    }
}
__device__ __forceinline__ bf16x8 pack8(const f32x16& p, int base) {
    u32x4 w; w.x = cvt_pk_bf16(p[base], p[base + 1]); w.y = cvt_pk_bf16(p[base + 2], p[base + 3]); w.z = cvt_pk_bf16(p[base + 4], p[base + 5]); w.w = cvt_pk_bf16(p[base + 6], p[base + 7]);
    return __builtin_bit_cast(bf16x8, w);
}

template <int NDB, bool MASKED, int VAR = 0> __device__ __forceinline__ void att_step(f32x16 (&o)[NDB], f32x16& ol, bf16x8 (&pa)[4], float& l, const LAS unsigned char* Kslot, const LAS unsigned char* Vslot,
                                                                       const int (&koff)[4], const int (&vboff)[NDB], const bf16x8 (&qr)[4], unsigned mlo, unsigned mhi, const bool live) {
    constexpr int ROWB = NDB * 64;
    bf16x8 vfa[NDB == 2 ? 8 : 1];
    if (NDB == 2) {
#pragma unroll
        for (int i = 0; i < 8; ++i) { const int d = i >> 2, ks = i & 3;
            const s16x4 lo = vtr(Vslot + vboff[d] + ks * 16 * ROWB), hi4 = vtr(Vslot + vboff[d] + ks * 16 * ROWB + 8 * ROWB);
            vfa[i] = (bf16x8){lo[0], lo[1], lo[2], lo[3], hi4[0], hi4[1], hi4[2], hi4[3]}; }
    }
    f32x16 p0, p1;
    if (VAR & 8) { p0 = (f32x16){}; p1 = (f32x16){}; asm volatile("" : "+v"(p0), "+v"(p1)); } else att_qkt(p0, p1, Kslot, koff, qr);
    __builtin_amdgcn_sched_barrier(0);
    bf16x8 pn[4];
#pragma unroll
    for (int sl = 0; sl < 4; ++sl) {
#pragma unroll
        for (int j = 0; j < NDB; ++j) {
            const int d = (NDB == 4) ? sl : (sl >> 1), ks = (NDB == 4) ? j : (2 * (sl & 1) + j);
            bf16x8 vf;
            if (NDB == 2) { vf = vfa[d * 4 + ks]; } else
            if (VAR & 16) { vf = pa[ks]; } else {
                const s16x4 lo = vtr(Vslot + vboff[d] + ks * 16 * ROWB), hi4 = vtr(Vslot + vboff[d] + ks * 16 * ROWB + 8 * ROWB);
                vf = (bf16x8){lo[0], lo[1], lo[2], lo[3], hi4[0], hi4[1], hi4[2], hi4[3]}; }
            if (VAR & 4) { asm volatile("" :: "v"(vf)); } else
            o[d] = __builtin_amdgcn_mfma_f32_32x32x16_bf16(pa[ks], vf, o[d], 0, 0, 0);
        }
        if (NDB == 2) {
            const bf16x8 ones = (bf16x8){0x3F80, 0x3F80, 0x3F80, 0x3F80, 0x3F80, 0x3F80, 0x3F80, 0x3F80};
            ol = __builtin_amdgcn_mfma_f32_32x32x16_bf16(pa[sl], ones, ol, 0, 0, 0);
        }
        f32x16& p = (sl < 2) ? p0 : p1;
        const unsigned mk = (sl < 2) ? mlo : mhi;
        const int rb0 = 8 * (sl & 1);
        float ps = 0.f;
#pragma unroll
        for (int r = rb0; r < rb0 + 8; ++r) {
            float e = (VAR & 2) ? p[r] : __builtin_amdgcn_exp2f(p[r]);
            if (MASKED && !(VAR & 1)) {
                unsigned kk; asm("v_bfe_i32 %0, %1, %2, 1" : "=v"(kk) : "v"(mk), "i"((r & 3) + 8 * (r >> 2)));
                e = __uint_as_float(__float_as_uint(e) & kk);
            }
            p[r] = e; if (NDB != 2) ps += e;
        }
        if (NDB != 2) l += live ? ps : 0.f;
        pn[sl] = pack8(p, rb0);
        __builtin_amdgcn_sched_barrier(0);
    }
#pragma unroll
    for (int ks = 0; ks < 4; ++ks) pa[ks] = pn[ks];
}

constexpr int A0_STAGE = 32768;
template <int VAR = 0> __device__ __forceinline__ void attn0_unit(LAS unsigned char* lds, const int wave, int b, int h, int qb, const bf16_t* Q, const bf16_t* __restrict__ K, const bf16_t* __restrict__ V, bf16_t* O,
                                           float lam, const float* __restrict__ subg, float outscale, bool dry) {
    const int lane = fresh_lane(), r32 = lane & 31, hi = lane >> 5;
    const int cc = wave >> 2, rb = wave & 3;
    const size_t rowbase = (size_t)b * SEQ;
    const int q0 = qb * 128 + rb * 32;
    const int NT = 2 * qb + 2;
    const int mylast = 2 * qb + (rb >> 1);
    const int krow = 8 * wave + (lane >> 3), kch = att_k_src_chunk(krow, lane & 7);
    const bf16_t* ksrc0 = K + (rowbase + krow) * DM + (2 * h + 0) * 64 + kch * 8;
    const bf16_t* ksrc1 = K + (rowbase + krow) * DM + (2 * h + 1) * 64 + kch * 8;
    const int vp0 = wave, vp1 = wave + 8;
    const int vrow0 = 4 * vp0 + (lane >> 4), vrow1 = 4 * vp1 + (lane >> 4), vs = lane & 15;
    const bf16_t* vsrc0 = V + (rowbase + vrow0) * DM + h * 128 + ((((vs >> 2) ^ (vrow0 & 3)) << 2) | (vs & 3)) * 8;
    const bf16_t* vsrc1 = V + (rowbase + vrow1) * DM + h * 128 + ((((vs >> 2) ^ (vrow1 & 3)) << 2) | (vs & 3)) * 8;
    const unsigned ldsb = (unsigned)(unsigned long long)lds;
#define A0_ISSUE(t, st) do { const unsigned sb_ = (unsigned)__builtin_amdgcn_readfirstlane(ldsb + (st) * A0_STAGE); const size_t go_ = (size_t)(t) * 64 * DM; \
        glds16(ksrc0 + go_, sb_ + wave * 1024); glds16(ksrc1 + go_, sb_ + 8192 + wave * 1024); \
        glds16(vsrc0 + go_, sb_ + 16384 + vp0 * 1024); glds16(vsrc1 + go_, sb_ + 16384 + vp1 * 1024); } while (0)
    bf16x8 qr[4];
    { const bf16_t* Qw = Q + (rowbase + q0) * DM + (2 * h + cc) * 64;
#pragma unroll
      for (int d0 = 0; d0 < 4; ++d0) qr[d0] = *(const bf16x8*)(Qw + (size_t)r32 * DM + d0 * 16 + hi * 8); }
    A0_ISSUE(0, 0); A0_ISSUE(1, 1);
    f32x16 o[4]; o[0] = (f32x16){}; o[1] = (f32x16){}; o[2] = (f32x16){}; o[3] = (f32x16){};
    float l = 0.f;
    int koff[4], vboff[4];
    { const int sw = (r32 >> 1) & 7, q4 = (lane & 15) >> 2, vbase = (4 * hi + q4) * 256 + ((lane >> 4) & 1) * 32 + (lane & 3) * 8;
#pragma unroll
      for (int d = 0; d < 4; ++d) { koff[d] = r32 * 128 + (((2 * d + hi) ^ sw) << 4); vboff[d] = vbase + ((d ^ q4) << 6); } }
    if (wave >= 4) __builtin_amdgcn_s_setprio(1);
    bf16x8 pa[4]; pa[0] = (bf16x8){}; pa[1] = (bf16x8){}; pa[2] = (bf16x8){}; pa[3] = (bf16x8){};
    int sk = 0, sv = 3;
    for (int t = 0; t <= NT; ++t) {
        if (t + 1 < NT) ATT_WAIT_BAR_N(4); else ATT_WAIT_BAR();
        if (t + 2 < NT) A0_ISSUE(t + 2, ((sk + 2) & 3));
        if (t <= mylast + 1) {
            const LAS unsigned char* Kslot = lds + sk * A0_STAGE + cc * 8192;
            const LAS unsigned char* Vslot = lds + (t == 0 ? 0 : sv) * A0_STAGE + 16384;
            att_step<4, false, VAR>(o, o[0], pa, l, Kslot, Vslot, koff, vboff, qr, 0u, 0u, t <= mylast);
        }
        sv = sk; sk = (sk + 1) & 3;
    }
#undef A0_ISSUE
    __builtin_amdgcn_s_setprio(0);
    ATT_WAIT_BAR();
    const int lane_e = fresh_lane(), r32e = lane_e & 31, hie = lane_e >> 5;
    l += __shfl_xor(l, 32);
    LAS float* wsf = (LAS float*)(lds + ATT_SCR + wave * 256);
    if (hie == 0) wsf[r32e] = l;
    asm volatile("s_waitcnt lgkmcnt(0)" ::: "memory");
    float rli[16];
#pragma unroll
    for (int r = 0; r < 16; ++r) rli[r] = 1.0f / wsf[crow(r, hie)];
    LAS float* X = (LAS float*)lds;
    if (cc == 1) {
#pragma unroll
        for (int r = 0; r < 16; ++r)
#pragma unroll
            for (int d = 0; d < 4; ++d) X[(rb * 32 + crow(r, hie)) * 128 + d * 32 + r32e] = o[d][r] * rli[r];
    }
    ATT_WAIT_BAR();
    if (cc == 0 && !dry) {
        float gsub[4];
#pragma unroll
        for (int d = 0; d < 4; ++d) gsub[d] = subg[d * 32 + r32e] * outscale;
#pragma unroll
        for (int r = 0; r < 16; ++r) {
            float v[4]; float ss = 0.f;
#pragma unroll
            for (int d = 0; d < 4; ++d) { v[d] = o[d][r] * rli[r] - lam * X[(rb * 32 + crow(r, hie)) * 128 + d * 32 + r32e]; ss += v[d] * v[d]; }
            ss += __shfl_xor(ss, 1); ss += __shfl_xor(ss, 2); ss += __shfl_xor(ss, 4); ss += __shfl_xor(ss, 8); ss += __shfl_xor(ss, 16);
            const float rn = 1.0f / sqrtf(ss * (1.0f / 128.0f) + EPS);
            bf16_t* op = O + (rowbase + q0 + crow(r, hie)) * DM + h * 128 + r32e;
#pragma unroll
            for (int d = 0; d < 4; ++d) op[d * 32] = (bf16_t)(cvt_pk_bf16(v[d] * rn * gsub[d], 0.f) & 0xffffu);
        }
    }
    ATT_WAIT_BAR();
}
__device__ __forceinline__ void attn0_phase(LAS unsigned char* lds, const int wave, unsigned char* ws, const float* subln, bool dry) {
    const int G = gridDim.x, bx = blockIdx.x;
    const bf16_t* Q = (const bf16_t*)(ws + WS_Q); const bf16_t* K = (const bf16_t*)(ws + WS_K); const bf16_t* V = (const bf16_t*)(ws + WS_V);
    const float lam = *(const float*)(ws + WS_MISC);
    for (int vb = bx; vb < 256; vb += G) {
        const int x = vb & 7, j = vb >> 3;
#pragma unroll 1
        for (int i = 0; i < 4; ++i) {
            const int r = i >> 1, jj = (j + 16 * r) & 31, qb = (i & 1) ? 63 - jj : jj, bh = 2 * x + r;
#if defined(PROBE_ATT0_VAR)
            if (dry) attn0_unit<PROBE_ATT0_VAR>(lds, wave, bh >> 3, bh & 7, qb, Q, K, V, (bf16_t*)(ws + WS_Q), lam, subln, 0.8f, dry); else
#endif
            attn0_unit<0>(lds, wave, bh >> 3, bh & 7, qb, Q, K, V, (bf16_t*)(ws + WS_Q), lam, subln, 0.8f, dry);
        }
    }
}

constexpr int A1_STAGE = 16384;
constexpr int A1_MASK = ATT_NST * A1_STAGE;
template <int VAR = 0> __device__ __forceinline__ void attn1_unit(LAS unsigned char* lds, const int wave, int b, int h, int qb, const bf16_t* Q, const bf16_t* __restrict__ K, const bf16_t* __restrict__ V, bf16_t* O,
                                           const unsigned long long* __restrict__ MASK, bool dry) {
    const int lane = fresh_lane(), r32 = lane & 31, hi = lane >> 5;
    const size_t rowbase = (size_t)b * SEQ;
    const int q0 = qb * 256 + wave * 32;
    const int NT = 4 * qb + 4;
    const int mylast = 4 * qb + (wave >> 1);
    const int krow = 8 * wave + (lane >> 3);
    const bf16_t* ksrc = K + (rowbase + krow) * DM + h * 64 + att_k_src_chunk(krow, lane & 7) * 8;
    const bf16_t* vsrc = V + (rowbase + krow) * DM + h * 64 + ((lane & 7) ^ (((krow >> 1) & 1) << 2)) * 8;
    const unsigned ldsb = (unsigned)(unsigned long long)lds;
    const unsigned long long* mrow = MASK + (size_t)b * 128 * SEQ + q0;
#define A1_ISSUE(t, st) do { const unsigned sb_ = (unsigned)__builtin_amdgcn_readfirstlane(ldsb + (st) * A1_STAGE); const size_t go_ = (size_t)(t) * 64 * DM; \
        glds16(ksrc + go_, sb_ + wave * 1024); glds16(vsrc + go_, sb_ + 8192 + wave * 1024); \
        glds4((const unsigned*)(mrow + (size_t)(t) * SEQ) + lane, (unsigned)__builtin_amdgcn_readfirstlane(ldsb + A1_MASK + ((st) * NWAVES + wave) * 256)); } while (0)
    bf16x8 qr[4];
    { const bf16_t* Qw = Q + (rowbase + q0) * DM + h * 64;
#pragma unroll
      for (int d0 = 0; d0 < 4; ++d0) qr[d0] = *(const bf16x8*)(Qw + (size_t)r32 * DM + d0 * 16 + hi * 8); }
    A1_ISSUE(0, 0); A1_ISSUE(1, 1);
    f32x16 o[2]; o[0] = (f32x16){}; o[1] = (f32x16){};
    f32x16 ol = (f32x16){};
    float l = 0.f;
    int koff[4], vboff[2];
    { const int sw = (r32 >> 1) & 7, q4 = (lane & 15) >> 2, vbase = (4 * hi + q4) * 128 + ((lane >> 4) & 1) * 32 + (lane & 3) * 8;
#pragma unroll
      for (int d = 0; d < 4; ++d) koff[d] = r32 * 128 + (((2 * d + hi) ^ sw) << 4);
#pragma unroll
      for (int d = 0; d < 2; ++d) vboff[d] = vbase + ((d ^ ((q4 >> 1) & 1)) << 6); }
    bf16x8 pa[4]; pa[0] = (bf16x8){}; pa[1] = (bf16x8){}; pa[2] = (bf16x8){}; pa[3] = (bf16x8){};
    int sk = 0, sv = 3;
    if (wave >= 4) __builtin_amdgcn_s_setprio(1);
    for (int t = 0; t <= NT; ++t) {
        if (VAR & 32) { asm volatile("s_waitcnt vmcnt(0) lgkmcnt(0)" ::: "memory"); } else
        if (t + 1 < NT) ATT_WAIT_BAR_N(3); else ATT_WAIT_BAR();
        if (!(VAR & 64)) if (t + 2 < NT) A1_ISSUE(t + 2, ((sk + 2) & 3));
        const unsigned long long mw = *(const LAS unsigned long long*)(lds + A1_MASK + (sk * NWAVES + wave) * 256 + r32 * 8);
        const unsigned mlo = (unsigned)mw >> (4 * hi), mhi = (unsigned)(mw >> 32) >> (4 * hi);
        if (t <= mylast + 1) {
            const LAS unsigned char* Kslot = lds + sk * A1_STAGE;
            const LAS unsigned char* Vslot = lds + (t == 0 ? 0 : sv) * A1_STAGE + 8192;
            att_step<2, true, VAR>(o, ol, pa, l, Kslot, Vslot, koff, vboff, qr, mlo, mhi, t <= mylast);
        }
        sv = sk; sk = (sk + 1) & 3;
    }
#undef A1_ISSUE
    __builtin_amdgcn_s_setprio(0);
    if (dry) asm volatile("" :: "v"(o[0]), "v"(o[1]), "v"(ol));
    const int lane_e = fresh_lane(), r32e = lane_e & 31, hie = lane_e >> 5;
    if (!dry)
#pragma unroll
    for (int r = 0; r < 16; ++r) {
        const float rl = 1.0f / ol[r];
        bf16_t* op = O + (rowbase + q0 + crow(r, hie)) * DM + h * 64 + r32e;
        op[0] = (bf16_t)(cvt_pk_bf16(o[0][r] * rl, 0.f) & 0xffffu); op[32] = (bf16_t)(cvt_pk_bf16(o[1][r] * rl, 0.f) & 0xffffu);
    }
    (void)l;
    ATT_WAIT_BAR();
}
__device__ __forceinline__ void attn1_phase(LAS unsigned char* lds, const int wave, unsigned char* ws, bool dry) {
    const int G = gridDim.x, bx = blockIdx.x;
    const bf16_t* Q = (const bf16_t*)(ws + WS_Q); const bf16_t* K = (const bf16_t*)(ws + WS_K); const bf16_t* V = (const bf16_t*)(ws + WS_V);
    for (int vb = bx; vb < 256; vb += G) {
        const int x = vb & 7, j = vb >> 3;
#pragma unroll 1
        for (int i = 0; i < 4; ++i) {
            const int jj = (j + 16 * (i >> 1)) & 31, qb = (i & 1) ? 31 - jj : jj, bh = 4 * x + i;
#if defined(PROBE_ATT1_VAR)
            if (dry) attn1_unit<PROBE_ATT1_VAR>(lds, wave, bh >> 4, bh & 15, qb, Q, K, V, (bf16_t*)(ws + WS_Q), (const unsigned long long*)(ws + WS_MASK), dry); else
#endif
            attn1_unit<0>(lds, wave, bh >> 4, bh & 15, qb, Q, K, V, (bf16_t*)(ws + WS_Q), (const unsigned long long*)(ws + WS_MASK), dry);
        }
    }
}
constexpr int IX_NB = 512, IX_HSTR = 513, IX_CAP = 320, IX_BSTR = 257;
constexpr int IX_HIST = 0, IX_CK = 0, IX_CI = 32 * IX_CAP * 4, IX_BM = 66560, IX_META = IX_BM + 32 * IX_BSTR * 4 + 128;
static_assert(IX_CI + 32 * IX_CAP * 2 <= IX_BM && 32 * IX_HSTR * 4 <= IX_BM && IX_META + 512 <= RING_BYTES, "indexer LDS map");

__device__ __forceinline__ void ix_abs_fma(f32x16& sc, const f32x16& d, float ah) {
#pragma unroll
    for (int r = 0; r < 16; ++r) { float t = sc[r]; asm("v_fma_f32 %0, %1, |%2|, %0" : "+v"(t) : "v"(ah), "v"(d[r])); sc[r] = t; }
}
__device__ __forceinline__ void ix_scores(f32x16& sc, const bf16x8 (&kf)[4], const bf16x8 (&qf)[8][4], const bf16x8 (&qc)[4], const float (&ah)[8]) {
    sc = (f32x16){};
#pragma unroll
    for (int s = 0; s < 4; ++s) sc = __builtin_amdgcn_mfma_f32_32x32x16_bf16(kf[s], qc[s], sc, 0, 0, 0);
    f32x16 d0 = (f32x16){}, d1;
#pragma unroll
    for (int s = 0; s < 4; ++s) d0 = __builtin_amdgcn_mfma_f32_32x32x16_bf16(kf[s], qf[0][s], d0, 0, 0, 0);
    asm volatile("" : "+v"(sc), "+v"(d0));
    __builtin_amdgcn_sched_barrier(0);
#pragma unroll
    for (int h = 0; h < 8; h += 2) {
        d1 = (f32x16){};
#pragma unroll
        for (int s = 0; s < 4; ++s) d1 = __builtin_amdgcn_mfma_f32_32x32x16_bf16(kf[s], qf[h + 1][s], d1, 0, 0, 0);
        asm volatile("" : "+v"(d1), "+v"(d0), "+v"(sc));
        __builtin_amdgcn_sched_barrier(0);
        ix_abs_fma(sc, d0, ah[h]);
        asm volatile("" : "+v"(sc));
        __builtin_amdgcn_sched_barrier(0);
        if (h + 2 < 8) {
            d0 = (f32x16){};
#pragma unroll
            for (int s = 0; s < 4; ++s) d0 = __builtin_amdgcn_mfma_f32_32x32x16_bf16(kf[s], qf[h + 2][s], d0, 0, 0, 0);
            asm volatile("" : "+v"(d0), "+v"(d1), "+v"(sc));
        } else {
            asm volatile("s_nop 15\n\ts_nop 3" : "+v"(d1), "+v"(sc));
        }
        __builtin_amdgcn_sched_barrier(0);
        ix_abs_fma(sc, d1, ah[h + 1]);
        asm volatile("" : "+v"(sc));
        __builtin_amdgcn_sched_barrier(0);
    }
}
__device__ __forceinline__ void ix_combine(bf16x8 (&qc)[4], const bf16x8 (&qf)[8][4], const float (&ah)[8]) {
#pragma unroll
    for (int s = 0; s < 4; ++s) {
        float acc[8];
#pragma unroll
        for (int j = 0; j < 8; ++j) acc[j] = 0.f;
#pragma unroll
        for (int h = 0; h < 8; ++h)
#pragma unroll
            for (int j = 0; j < 8; ++j) acc[j] = __builtin_fmaf(ah[h], __uint_as_float((unsigned)(unsigned short)qf[h][s][j] << 16), acc[j]);
        u32x4 w; w.x = cvt_pk_bf16(acc[0], acc[1]); w.y = cvt_pk_bf16(acc[2], acc[3]); w.z = cvt_pk_bf16(acc[4], acc[5]); w.w = cvt_pk_bf16(acc[6], acc[7]);
        qc[s] = __builtin_bit_cast(bf16x8, w);
    }
}
__device__ __forceinline__ int ix_bin(float sc, float Rs, float scale) {
    const int b = (int)__builtin_fmaf(sc, scale, Rs);
    return b < 0 ? 0 : (b > IX_NB - 1 ? IX_NB - 1 : b);
}
__device__ __forceinline__ void ix_loadk(bf16x8 (&kf)[4], const bf16_t* KIb, int kt, int r32, int hi) {
    const int l_ = fresh_lane();
    const bf16_t* p = KIb + (size_t)(unsigned)((kt * 32 + (l_ & 31)) * 64 + (l_ >> 5) * 8);
#pragma unroll
    for (int s = 0; s < 4; ++s) kf[s] = *(const bf16x8*)(p + s * 16);
}
__device__ __forceinline__ void ix_loadk_async(bf16x8 (&kf)[4], const bf16_t* KIb, int kt) {
    const int l_ = fresh_lane();
    const bf16_t* p = KIb + (size_t)(unsigned)((kt * 32 + (l_ & 31)) * 64 + (l_ >> 5) * 8);
    asm volatile("global_load_dwordx4 %0, %4, off\n\tglobal_load_dwordx4 %1, %4, off offset:32\n\tglobal_load_dwordx4 %2, %4, off offset:64\n\tglobal_load_dwordx4 %3, %4, off offset:96"
                 : "=&v"(kf[0]), "=&v"(kf[1]), "=&v"(kf[2]), "=&v"(kf[3]) : "v"(p) : "memory");
}
__device__ __forceinline__ void ix_waitk(bf16x8 (&kf)[4]) { asm volatile("s_waitcnt vmcnt(0)" : "+v"(kf[0]), "+v"(kf[1]), "+v"(kf[2]), "+v"(kf[3]) :: "memory"); }

__device__ __forceinline__ void idx_unit(LAS unsigned char* lds, const int wave, unsigned char* ws, int b, int qt, const int dry) {
    const int lane = fresh_lane(), r32 = lane & 31, hi = lane >> 5, tid = wave * 64 + lane;
    const int chunk = qt >> 1;
    const size_t tok0 = (size_t)b * SEQ + (size_t)qt * 32;
    unsigned* MASK32 = (unsigned*)(ws + WS_MASK);
    if (chunk < 4) {
        if (!dry) for (int t = wave; t <= chunk; t += 8) MASK32[((size_t)(b * 128 + t) * SEQ + qt * 32 + r32) * 2 + hi] = 0xFFFFFFFFu;
        return;
    }
    const bf16_t* KIb = (const bf16_t*)(ws + WS_KI) + (size_t)b * SEQ * 64;
    LAS unsigned* HIST = (LAS unsigned*)(lds + IX_HIST);
    LAS float* CK = (LAS float*)(lds + IX_CK);
    LAS unsigned short* CI = (LAS unsigned short*)(lds + IX_CI);
    LAS unsigned* BM = (LAS unsigned*)(lds + IX_BM);
    LAS int* META = (LAS int*)(lds + IX_META);
#define IX_LOADQ(qf) do { const int l_ = fresh_lane(); const bf16_t* qp_ = (const bf16_t*)(ws + WS_QI) + tok0 * 512 + (unsigned)((l_ & 31) * 512 + (l_ >> 5) * 8); \
        _Pragma("unroll") for (int h = 0; h < 8; ++h) _Pragma("unroll") for (int s = 0; s < 4; ++s) qf[h][s] = *(const bf16x8*)(qp_ + h * 64 + s * 16); } while (0)
    float a[8]; float R;
    { const float* np = (const float*)(ws + WS_QIN) + (tok0 + r32) * 8;
      const f32x4 n0 = *(const f32x4*)np, n1 = *(const f32x4*)(np + 4);
#pragma unroll
      for (int h = 0; h < 4; ++h) { a[h] = 0.5f * n0[h]; a[4 + h] = 0.5f * n1[h]; }
      R = (((fabsf(n0[0]) + fabsf(n0[1])) + (fabsf(n0[2]) + fabsf(n0[3]))) + ((fabsf(n1[0]) + fabsf(n1[1])) + (fabsf(n1[2]) + fabsf(n1[3])))) * 1.03f;
      R = fmaxf(R, 1e-30f); }
    const float scale = (float)(IX_NB / 2) / R, Rs = (float)(IX_NB / 2);
    const int nkt = 2 * (chunk + 1);
    for (int i = tid; i < 32 * IX_HSTR; i += NWAVES * 64) HIST[i] = 0u;
    for (int i = tid; i < 32 * IX_BSTR; i += NWAVES * 64) BM[i] = 0u;
    if (tid < 128) META[tid] = 0;
    LDS_WAIT(); __builtin_amdgcn_s_barrier(); asm volatile("" ::: "memory");
    {
        bf16x8 qf[8][4]; IX_LOADQ(qf);
        bf16x8 qc[4]; ix_combine(qc, qf, a);
        bf16x8 kf[4], kn[4];
        if (wave < nkt) ix_loadk(kf, KIb, wave, r32, hi);
#pragma unroll 1
        for (int kt = wave; kt < nkt; kt += 8) {
            const bool more = kt + 8 < nkt;
            if (more) ix_loadk_async(kn, KIb, kt + 8);
            f32x16 sc;
            ix_scores(sc, kf, qf, qc, a);
#pragma unroll
            for (int r = 0; r < 16; ++r) {
                const int bin = ix_bin(sc[r], Rs, scale);
                __hip_atomic_fetch_add(HIST + r32 * IX_HSTR + bin, 1u, __ATOMIC_RELAXED, __HIP_MEMORY_SCOPE_WORKGROUP);
            }
            if (more) { ix_waitk(kn);
#pragma unroll
                for (int s = 0; s < 4; ++s) kf[s] = kn[s]; }
        }
    }
    LDS_WAIT(); __builtin_amdgcn_s_barrier(); asm volatile("" ::: "memory");
#pragma unroll 1
    for (int i = 0; i < 4; ++i) {
        const int q = wave * 4 + i;
        int lane8 = 8 * lane; asm volatile("" : "+v"(lane8));
        unsigned wv[8]; unsigned c = 0;
#pragma unroll
        for (int w = 0; w < 8; ++w) { wv[w] = HIST[q * IX_HSTR + lane8 + w]; c += wv[w]; }
        unsigned x = c;
#pragma unroll
        for (int off = 1; off < 64; off <<= 1) { const unsigned y = __shfl_down(x, off); if (lane + off < 64) x += y; }
        const unsigned sx = x - c;
        if (sx < 256u && x >= 256u) {
            unsigned cum = sx; int found = 0, tb = 0, kr = 0, tc = 0;
#pragma unroll
            for (int w = 7; w >= 0; --w) {
                if (!found) { if (cum + wv[w] >= 256u) { found = 1; tb = lane8 + w; kr = 256 - (int)cum; tc = (int)wv[w]; } else cum += wv[w]; }
            }
            META[q] = tb; META[32 + q] = kr; META[64 + q] = tc;
        }
    }
    LDS_WAIT(); __builtin_amdgcn_s_barrier(); asm volatile("" ::: "memory");
    if (dry == 1) return;
    {
        const int tb = META[r32];
        const float fl = (tb <= 0) ? -__builtin_inff() : (float)tb, fh = (tb >= IX_NB - 1) ? __builtin_inff() : (float)(tb + 1);
        bf16x8 qf[8][4]; IX_LOADQ(qf);
        bf16x8 qc[4]; ix_combine(qc, qf, a);
        bf16x8 kf[4], kn[4];
        if (wave < nkt) ix_loadk(kf, KIb, wave, r32, hi);
#pragma unroll 1
        for (int kt = wave; kt < nkt; kt += 8) {
            const bool more = kt + 8 < nkt;
            if (more) ix_loadk_async(kn, KIb, kt + 8);
            f32x16 sc;
            ix_scores(sc, kf, qf, qc, a);
            unsigned sb = 0u, cb = 0u;
#pragma unroll
            for (int r = 15; r >= 1; r -= 2) {
                const float f1 = __builtin_fmaf(sc[r], scale, Rs), f0 = __builtin_fmaf(sc[r - 1], scale, Rs);
                unsigned long long t0, t1, t2, t3;
                asm("v_cmp_ge_f32_e64 %2, %6, %8\n\tv_cmp_ge_f32_e64 %3, %7, %8\n\tv_cmp_ge_f32_e64 %4, %6, %9\n\tv_cmp_ge_f32_e64 %5, %7, %9\n\t"
                    "v_addc_co_u32_e64 %0, vcc, %0, %0, %2\n\tv_addc_co_u32_e64 %0, vcc, %0, %0, %3\n\tv_addc_co_u32_e64 %1, vcc, %1, %1, %4\n\tv_addc_co_u32_e64 %1, vcc, %1, %1, %5"
                    : "+v"(sb), "+v"(cb), "=&s"(t0), "=&s"(t1), "=&s"(t2), "=&s"(t3) : "v"(f1), "v"(f0), "v"(fh), "v"(fl) : "vcc");
            }
            const unsigned cbits = cb & ~sb;
            if (__ballot(cbits != 0u)) {
                int base = 0;
                if (cbits) base = __hip_atomic_fetch_add(META + 96 + r32, __popc(cbits), __ATOMIC_RELAXED, __HIP_MEMORY_SCOPE_WORKGROUP);
#pragma unroll
                for (int r = 0; r < 16; ++r) {
                    const bool c = (cbits >> r) & 1u;
                    if (__ballot(c)) {
                        if (c) { if (base < IX_CAP) { CK[r32 * IX_CAP + base] = sc[r]; CI[r32 * IX_CAP + base] = (unsigned short)(kt * 32 + (r & 3) + 8 * (r >> 2) + 4 * hi); } ++base; }
                    }
                }
            }
            unsigned bits = (sb & 0xFu) | ((sb & 0xF0u) << 4) | ((sb & 0xF00u) << 8) | ((sb & 0xF000u) << 12);
            bits <<= 4 * hi;
            bits |= __shfl_xor(bits, 32);
            if (hi == 0) BM[r32 * IX_BSTR + kt] = bits;
            if (more) { ix_waitk(kn);
#pragma unroll
                for (int s = 0; s < 4; ++s) kf[s] = kn[s]; }
        }
    }
    LDS_WAIT(); __builtin_amdgcn_s_barrier(); asm volatile("" ::: "memory");
    if (dry == 2) return;
    {
        const int q0 = wave * 4;
        unsigned key[4][5]; int kr[4], cq[4]; unsigned prefix[4];
        int maxc = 0; unsigned dmax = 0u;
#pragma unroll
        for (int i = 0; i < 4; ++i) {
            int c = META[96 + q0 + i]; c = c > IX_CAP ? IX_CAP : c; cq[i] = c; maxc = c > maxc ? c : maxc;
            kr[i] = META[32 + q0 + i];
            unsigned orv = 0u, andv = 0xFFFFFFFFu;
#pragma unroll
            for (int sl = 0; sl < 5; ++sl) {
                const int e = lane + 64 * sl; const bool v = e < c;
                const unsigned u = v ? __float_as_uint(CK[(q0 + i) * IX_CAP + e]) : 0u;
                const unsigned k = (u & 0x80000000u) ? ~u : (u | 0x80000000u);
                key[i][sl] = v ? k : 0u; orv |= key[i][sl]; andv &= v ? k : 0xFFFFFFFFu;
            }
#pragma unroll
            for (int o = 1; o < 64; o <<= 1) { orv |= (unsigned)__shfl_xor((int)orv, o); andv &= (unsigned)__shfl_xor((int)andv, o); }
            const unsigned diff = orv ^ andv;
            const unsigned low = diff ? (0xFFFFFFFFu >> __builtin_clz(diff)) : 0u;
            prefix[i] = (c > 0) ? (andv & ~low) : 0u; dmax |= diff;
        }
        maxc = __builtin_amdgcn_readfirstlane(maxc); dmax = __builtin_amdgcn_readfirstlane(dmax);
        const int nsl = (maxc + 63) >> 6;
#pragma unroll 1
        for (int bit = dmax ? 31 - __builtin_clz(dmax) : -1; bit >= 0; --bit) {
            int cnt[4] = {0, 0, 0, 0};
#pragma unroll
            for (int sl = 0; sl < 5; ++sl) if (sl < nsl) {
#pragma unroll
                for (int i = 0; i < 4; ++i) cnt[i] += __popcll(__ballot(key[i][sl] >= (prefix[i] | (1u << bit))));
            }
#pragma unroll
            for (int i = 0; i < 4; ++i) prefix[i] = (cnt[i] >= kr[i]) ? (prefix[i] | (1u << bit)) : prefix[i];
        }
#pragma unroll
        for (int i = 0; i < 4; ++i) {
            const int q = q0 + i;
            int cgt = 0, ceq = 0;
#pragma unroll
            for (int sl = 0; sl < 5; ++sl) if (sl < nsl) { const bool v = lane + 64 * sl < cq[i];
                cgt += __popcll(__ballot(v && key[i][sl] > prefix[i])); ceq += __popcll(__ballot(v && key[i][sl] == prefix[i])); }
            const int need = kr[i] - cgt;
            int idx[5];
#pragma unroll
            for (int sl = 0; sl < 5; ++sl) { const int e = lane + 64 * sl; idx[sl] = (e < cq[i]) ? (int)CI[q * IX_CAP + e] : 0x7fffffff; }
            int ithr = 0x7fffffff;
            if (need < ceq) {
                int pre = 0;
#pragma unroll 1
                for (int bit = 12; bit >= 0; --bit) {
                    const int trial = pre | (1 << bit); int cnt = 0;
#pragma unroll
                    for (int sl = 0; sl < 5; ++sl) cnt += __popcll(__ballot(lane + 64 * sl < cq[i] && key[i][sl] == prefix[i] && idx[sl] < trial));
                    if (cnt < need) pre = trial;
                }
                ithr = pre;
            }
#pragma unroll
            for (int sl = 0; sl < 5; ++sl)
                if (lane + 64 * sl < cq[i] && (key[i][sl] > prefix[i] || (key[i][sl] == prefix[i] && idx[sl] <= ithr)))
                    __hip_atomic_fetch_or(BM + q * IX_BSTR + (idx[sl] >> 5), 1u << (idx[sl] & 31), __ATOMIC_RELAXED, __HIP_MEMORY_SCOPE_WORKGROUP);
        }
    }
    LDS_WAIT(); __builtin_amdgcn_s_barrier(); asm volatile("" ::: "memory");
#undef IX_LOADQ
    if (dry) return;
    for (int t = wave; t <= chunk; t += 8) MASK32[((size_t)(b * 128 + t) * SEQ + qt * 32 + r32) * 2 + hi] = BM[r32 * IX_BSTR + 2 * t + hi];
    LDS_WAIT(); __builtin_amdgcn_s_barrier(); asm volatile("" ::: "memory");
}
__device__ __forceinline__ void idx_phase(LAS unsigned char* lds, const int wave, unsigned char* ws) {
    for (int v = blockIdx.x; v < 256; v += gridDim.x) {
        const int b = v >> 7, j = v & 127;
#if defined(PROBE_IDX_DRY)
#pragma unroll 1
        for (int u = 0; u < 6; ++u) idx_unit(lds, wave, ws, b, (u & 1) ? 255 - j : j, u < 2 ? 0 : PROBE_IDX_DRY);
#else
#pragma unroll 1
        for (int u = 0; u < 2; ++u) idx_unit(lds, wave, ws, b, u ? 255 - j : j, 0);
#endif
    }
}
struct Args { const float* in[22]; float* out; unsigned char* ws; int ph_lo, ph_hi, coop, pad; };
enum Phase { P_PRO = 0, P_IN0, P_ATT0, P_OUT0, P_UP0, P_DN0, P_IN1, P_QUP, P_IDX, P_ATT1, P_OUT1, P_UP1, P_DN1, P_N, P_BRIDGE = 20 };

constexpr int CTL_ROWCNT = 4096;
struct In1Order : pg8::StaticOrder {
    unsigned* cnt; int wave;
    __device__ __forceinline__ bool next(int i, pg8::Unit& u) const { if (!pg8::StaticOrder::next(i, u)) return false; u.pn = (u.pn == 1) ? 9 : (u.pn == 9) ? 1 : u.pn; return true; }
    __device__ __forceinline__ void a_ready(const pg8::Unit&) const {}
    __device__ __forceinline__ void done(const pg8::Unit& u) const {
        if (u.pn == 0 || u.pn == 9) {
            asm volatile("s_waitcnt vmcnt(0)" ::: "memory");
            __builtin_amdgcn_s_barrier();
            if (wave == 0) {
                __builtin_amdgcn_fence(__ATOMIC_RELEASE, "agent");
                asm volatile("s_waitcnt vmcnt(0)" ::: "memory");
                if (fresh_lane() == 0) (void)xb_add(&cnt[u.pm * 16], 8u);
            }
        }
    }
};
__device__ __forceinline__ void qup_wait_rows(const pg8::StaticOrder& S, unsigned* cnt, unsigned* tmo, const unsigned need = 16u) {
#pragma unroll 1
    for (int i = 0; ; ++i) {
        pg8::Unit u; if (!S.next(i, u)) break;
        unsigned sp = 0;
        while (xb_ld(&cnt[u.pm * 16]) < need) { __builtin_amdgcn_s_sleep(1); if ((++sp & 255u) == 0u) { if (xb_ld(tmo)) break; if (sp > XB_SPIN_CAP) { atomicAdd(tmo, 1u); break; } } }
    }
    __builtin_amdgcn_fence(__ATOMIC_ACQUIRE, "agent");
}
template <class Epi> __device__ __forceinline__ void run_gemm(LAS unsigned char* lds, const int wave, const bf16_t* A, const bf16_t* Bt, int N, int K, const Epi& E) {
    pg8::Gemm g{A, Bt, TOK, N, K}; pg8::StaticOrder S; S.init(TOK, N, (int)gridDim.x, (int)blockIdx.x);
    pg8::gemm_phase<Epi, pg8::StaticOrder, true, true>(lds, g, S, E, wave, fresh_lane());
}
__global__ void __launch_bounds__(NWAVES * 64, 2) mk_fwd(Args args) {
    extern __shared__ __attribute__((aligned(16))) unsigned char lds_raw[];
    LAS unsigned char* lds = (LAS unsigned char*)lds_raw;
    const int wave = __builtin_amdgcn_readfirstlane(threadIdx.x >> 6);
    const int G = gridDim.x;
    unsigned char* ws = args.ws;
    const int lo = args.ph_lo, hi = args.ph_hi;
    volatile LAS unsigned* MISC = (volatile LAS unsigned*)(lds + MISC_OFF);
    { const int tid = wave * 64 + fresh_lane(); for (int u = tid; u < (LDS_BYTES - RING_BYTES) / 4; u += NWAVES * 64) ((LAS unsigned*)(lds + RING_BYTES))[u] = 0u; }
    __syncthreads();
    XcdBarrier bar; bar.bar = (unsigned*)(ws + WS_CTL); bar.x = 0; bar.st = nullptr;
    if (args.coop) bar = xcd_barrier_post((unsigned*)(ws + WS_CTL), MISC + 8);
#define IN(k) (lo <= (k) && (k) < hi)
#define NREP(k) ((PROBE_PHASE == (k)) ? 3 : 1)
#define SEAM(k) do { if (args.coop && IN(k) && IN((k) + 1)) xcd_barrier(bar, wave); } while (0)
    LAS float* ETBL = (LAS float*)(lds + EPI_TBL_OFF + wave * 512);
    bf16_t* XB = (bf16_t*)(ws + WS_XB); bf16_t* QB = (bf16_t*)(ws + WS_Q); bf16_t* KB = (bf16_t*)(ws + WS_K); bf16_t* VB = (bf16_t*)(ws + WS_V); bf16_t* UB = (bf16_t*)(ws + WS_U);
    float* PART = (float*)(ws + WS_PART); float* CS = (float*)(ws + WS_CS); float* LAM = (float*)(ws + WS_MISC);

    if (IN(P_PRO)) for (int rep_ = 0; rep_ < NREP(P_PRO); ++rep_) {
        const int lane = fresh_lane(), tid = wave * 64 + lane;
        LAS float* scr = (LAS float*)(lds + wave * 16384);
        const int gw = blockIdx.x * NWAVES + wave, NGW = G * NWAVES;
        const float* nmix = args.in[2]; const float* nmlp = args.in[3];
        int base = 0;
#define DOJOB(W_, gain_, WT_, K_, N_, Npad_, roff_) do { const int nblk = (Npad_) / 32, nitems = ((K_) / 64) * nblk; \
            for (int it = (gw - base % NGW + NGW) % NGW; it < nitems; it += NGW) p0_transpose_item((W_), (K_), (N_), (gain_), (bf16_t*)(ws + (WT_)), (roff_), scr, it, nblk, lane); \
            base += nitems; } while (0)
        DOJOB(args.in[6], nmix, WS_WIN0, DM, 3072, 3072, 0);
        DOJOB(args.in[14], (const float*)nullptr, WS_WOUT0, DM, DM, DM, 0);
        DOJOB(args.in[4], nmlp, WS_W1_0, DM, DFF, DFF, 0);
        DOJOB(args.in[5], (const float*)nullptr, WS_W2_0, DFF, DM, DM, 0);
        DOJOB(args.in[15], nmix + DM, WS_WIN1, DM, NIN1, NIN1P, 0);
        DOJOB(args.in[17], args.in[16], WS_WUQ, 256, DM, DM, 0);
        DOJOB(args.in[18], args.in[16], WS_WUQ, 256, 512, 512, 1024);
        DOJOB(args.in[21], (const float*)nullptr, WS_WOUT1, DM, DM, DM, 0);
        DOJOB(args.in[4] + (size_t)DM * DFF, nmlp + DM, WS_W1_1, DM, DFF, DFF, 0);
        DOJOB(args.in[5] + (size_t)DM * DFF, (const float*)nullptr, WS_W2_1, DFF, DM, DM, 0);
#undef DOJOB
        if (TOK % (4 * NGW) == 0) { for (int m = gw; m < TOK; m += 4 * NGW) rows_to_bf16<4>(args.in[0], XB, PART, m, NGW, lane); }
        else { for (int m = gw; m < TOK; m += NGW) rows_to_bf16<1>(args.in[0], XB, PART, m, NGW, lane); }
        const int* pos = (const int*)args.in[1];
        for (int t = blockIdx.x * (NWAVES * 64) + tid; t < TOK * 8; t += G * NWAVES * 64) {
            const int tok = t >> 3, i = t & 7;
            const float inv = (float)pow(500000.0, -(double)i / 8.0);
            const float ang = (float)pos[tok] * inv;
            CS[tok * 16 + i] = (float)cos((double)ang); CS[tok * 16 + 8 + i] = (float)sin((double)ang);
        }
        if (blockIdx.x == 0 && tid == 0) {
            float s1 = 0.f, s2 = 0.f;
            for (int i = 0; i < 64; ++i) { s1 += args.in[9][i] * args.in[10][i]; s2 += args.in[11][i] * args.in[12][i]; }
            LAM[0] = expf(s1) - expf(s2) + 0.2f;
        }
    }
    SEAM(P_PRO);
    if (IN(P_BRIDGE)) {
        const int lane = fresh_lane();
        const int gw = blockIdx.x * NWAVES + wave, NGW = G * NWAVES;
        for (int m = gw; m < TOK; m += NGW) rows_to_bf16<1>(args.out, XB, PART, m, NGW, lane);
    }
    if (IN(P_IN0)) { for (int rep_ = 0; rep_ < NREP(P_IN0); ++rep_) { EpiQKV0 E{PART, CS, args.in[7], args.in[8], QB, (size_t)(WS_K - WS_Q) / 2, 0.125f * LOG2E, ETBL}; run_gemm(lds, wave, XB, (const bf16_t*)(ws + WS_WIN0), 3072, DM, E); } }
    SEAM(P_IN0);
    if (IN(P_ATT0)) { for (int rep_ = NREP(P_ATT0) - 1; rep_ >= 0; --rep_) attn0_phase(lds, wave, ws, args.in[13], rep_ != 0); }
    SEAM(P_ATT0);
    if (IN(P_OUT0)) { for (int rep_ = 0; rep_ < NREP(P_OUT0); ++rep_) { EpiResidT<true, false> E{nullptr, XB, nullptr, XB, PART}; run_gemm(lds, wave, QB, (const bf16_t*)(ws + WS_WOUT0), DM, DM, E); } }
    SEAM(P_OUT0);
    if (IN(P_UP0)) { for (int rep_ = 0; rep_ < NREP(P_UP0); ++rep_) { EpiUp E{PART, UB, ETBL}; run_gemm(lds, wave, XB, (const bf16_t*)(ws + WS_W1_0), DFF, DM, E); } }
    SEAM(P_UP0);
    if (IN(P_DN0)) { EpiResidT<true, false> E{nullptr, XB, nullptr, XB, PART}; run_gemm(lds, wave, UB, (const bf16_t*)(ws + WS_W2_0), DM, DFF, E); }
    SEAM(P_DN0);
    if (IN(P_IN1)) { for (int rep_ = 0; rep_ < NREP(P_IN1); ++rep_) { EpiIn1 E{PART, CS, args.in[20], (bf16_t*)(ws + WS_CQ), (float*)(ws + WS_CQP), KB, VB, (bf16_t*)(ws + WS_KI), (float*)(ws + WS_WIDX), 0.35355339059327373f * 0.125f, ETBL};
        pg8::Gemm g{XB, (const bf16_t*)(ws + WS_WIN1), TOK, NIN1P, DM}; In1Order S; S.init(TOK, NIN1P, G, (int)blockIdx.x); S.cnt = (unsigned*)(ws + WS_CTL) + CTL_ROWCNT; S.wave = wave;
        pg8::gemm_phase<EpiIn1, In1Order, true, true>(lds, g, S, E, wave, fresh_lane()); } }
    if (IN(P_QUP)) { for (int rep_ = 0; rep_ < NREP(P_QUP); ++rep_) { EpiQup E{(const float*)(ws + WS_CQP), CS, args.in[19], (const float*)(ws + WS_WIDX), QB, (bf16_t*)(ws + WS_QI), (float*)(ws + WS_QIN), 0.125f * LOG2E, ETBL};
        const int c = (int)blockIdx.x, cm = (G % 8 == 0) ? ((c & 7) | ((G / 8 - 1 - (c >> 3)) << 3)) : c;
        pg8::Gemm g{(const bf16_t*)(ws + WS_CQ), (const bf16_t*)(ws + WS_WUQ), TOK, 1536, 256}; pg8::StaticOrder S; S.init(TOK, 1536, G, cm);
        qup_wait_rows(S, (unsigned*)(ws + WS_CTL) + CTL_ROWCNT, (unsigned*)(ws + WS_CTL) + XB_TMO);
        pg8::gemm_phase<EpiQup, pg8::StaticOrder, true, true>(lds, g, S, E, wave, fresh_lane()); } }
    SEAM(P_QUP);
    if (IN(P_IDX)) { for (int rep_ = 0; rep_ < NREP(P_IDX); ++rep_) { idx_phase(lds, wave, ws); } }
    SEAM(P_IDX);
    if (IN(P_ATT1)) { for (int rep_ = NREP(P_ATT1) - 1; rep_ >= 0; --rep_) attn1_phase(lds, wave, ws, rep_ != 0); }
    SEAM(P_ATT1);
    if (IN(P_OUT1)) { EpiResidT<true, false> E{nullptr, XB, nullptr, XB, PART}; run_gemm(lds, wave, QB, (const bf16_t*)(ws + WS_WOUT1), DM, DM, E); }
    SEAM(P_OUT1);
    if (IN(P_UP1)) { for (int rep_ = 0; rep_ < NREP(P_UP1); ++rep_) { EpiUp E{PART, UB, ETBL}; run_gemm(lds, wave, XB, (const bf16_t*)(ws + WS_W1_1), DFF, DM, E); } }
    SEAM(P_UP1);
    if (IN(P_DN1)) { EpiResidT<true, true> E{nullptr, XB, args.out, nullptr, nullptr}; run_gemm(lds, wave, UB, (const bf16_t*)(ws + WS_W2_1), DM, DFF, E); }
#undef IN
#undef SEAM
}

static int g_mk_ready = 0;
static void mk_launch(hipStream_t st, void* const* d_in, void* d_out, void* d_ws, int lo, int hi, int coop) {
    if (!g_mk_ready) { (void)hipFuncSetAttribute((const void*)mk_fwd, hipFuncAttributeMaxDynamicSharedMemorySize, LDS_BYTES); g_mk_ready = 1; }
    Args a{};
    for (int i = 0; i < 22; ++i) a.in[i] = (const float*)d_in[i];
    a.out = (float*)d_out; a.ws = (unsigned char*)d_ws; a.ph_lo = lo; a.ph_hi = hi; a.coop = coop; a.pad = 0;
    hipLaunchKernelGGL(mk_fwd, dim3(256), dim3(NWAVES * 64), LDS_BYTES, st, a);
}

extern "C" void kernel_launch(void* const* d_in, const int* in_sizes, int n_in, void* d_out, int out_size, void* d_ws, size_t ws_size, hipStream_t stream) {
    static int grid = 0;
    if (grid == 0) {
        int dev = 0, cus = 0, per_cu = 0;
        (void)hipGetDevice(&dev);
        (void)hipDeviceGetAttribute(&cus, hipDeviceAttributeMultiprocessorCount, dev);
        (void)hipFuncSetAttribute((const void*)mk_fwd, hipFuncAttributeMaxDynamicSharedMemorySize, LDS_BYTES);
        (void)hipOccupancyMaxActiveBlocksPerMultiprocessor(&per_cu, (const void*)mk_fwd, NWAVES * 64, LDS_BYTES);
        if (per_cu < 1) per_cu = 1;
        if (per_cu > 1) per_cu = 1;
        grid = cus * per_cu; if (grid > 256) grid = 256; if (grid < 1) grid = 1;
        if (ws_size < WS_END) { fprintf(stderr, "kernel_launch: workspace too small (%zu)\n", ws_size); }
    }
    (void)hipMemsetAsync((char*)d_ws + WS_CTL, 0, CTL_BYTES, stream);
    Args a{};
    for (int i = 0; i < 22; ++i) a.in[i] = (const float*)d_in[i];
    a.out = (float*)d_out; a.ws = (unsigned char*)d_ws; a.ph_lo = 0; a.ph_hi = P_N; a.coop = 1; a.pad = 0;
    void* kargs[] = {&a};
    hipError_t e = hipLaunchCooperativeKernel((const void*)mk_fwd, dim3(grid), dim3(NWAVES * 64), kargs, LDS_BYTES, stream);
    if (e != hipSuccess) fprintf(stderr, "cooperative launch failed: %s (grid %d)\n", hipGetErrorString(e), grid);
}
```

```cpp
#include <hip/hip_runtime.h>
#include <stdint.h>
#include <math.h>
#include <stdio.h>
#ifndef PROBE_PHASE
#define PROBE_PHASE (-1)
#endif
#define LAS __attribute__((address_space(3)))
#define GAS __attribute__((address_space(1)))
typedef unsigned short bf16_t;
typedef short bf16x8 __attribute__((ext_vector_type(8)));
typedef float f32x4 __attribute__((ext_vector_type(4)));
typedef float f32x16 __attribute__((ext_vector_type(16)));
typedef unsigned u32x4 __attribute__((ext_vector_type(4)));
typedef unsigned u32x2 __attribute__((ext_vector_type(2)));

constexpr int BATCH = 2, SEQ = 8192, DM = 1024, DFF = 4096, TOK = BATCH * SEQ;
constexpr float EPS = 1e-6f;
constexpr float LOG2E = 1.4426950408889634f;
constexpr int NIN1 = 2376, NIN1P = 2560;
constexpr size_t MiB = 1u << 20;
constexpr size_t WS_XB = 0, WS_Q = 32 * MiB, WS_K = 64 * MiB, WS_V = 96 * MiB, WS_U = 32 * MiB;
constexpr size_t WS_CQ = 160 * MiB, WS_QI = 168 * MiB, WS_KI = 184 * MiB, WS_MASK = 186 * MiB;
constexpr size_t WS_CS = 204 * MiB, WS_MISC = 205 * MiB, WS_PART = 206 * MiB, WS_CQP = 207 * MiB, WS_WIDX = 207 * MiB + 256 * 1024;
constexpr size_t WS_QIN = WS_MISC + 512 * 1024;
constexpr size_t WS_CTL = WS_MISC + 4096;
constexpr size_t CTL_BYTES = 64 * 1024;
constexpr size_t WS_WIN0 = 208 * MiB, WS_WOUT0 = 214 * MiB, WS_W1_0 = 216 * MiB, WS_W2_0 = 224 * MiB, WS_WIN1 = 232 * MiB, WS_WUQ = 237 * MiB,
                 WS_WOUT1 = 238 * MiB, WS_W1_1 = 240 * MiB, WS_W2_1 = 248 * MiB, WS_END = 256 * MiB;

__device__ __forceinline__ unsigned cvt_pk_bf16(float lo, float hi) {
    typedef float f32x2_t __attribute__((ext_vector_type(2))); typedef __bf16 bf16x2_t __attribute__((ext_vector_type(2)));
    f32x2_t v = {lo, hi}; bf16x2_t b = __builtin_convertvector(v, bf16x2_t); return __builtin_bit_cast(unsigned, b);
}
__host__ __device__ __forceinline__ int tile_pos(int cl) { const int wc = cl >> 6, fq = (cl >> 4) & 3, bj = (cl >> 3) & 1, n = (cl >> 2) & 1, j = cl & 3; return 128 * bj + 32 * wc + 16 * n + 4 * fq + j; }
__device__ __forceinline__ int fresh_lane() { int l; asm volatile("v_mbcnt_lo_u32_b32 %0, -1, 0\n\tv_mbcnt_hi_u32_b32 %0, -1, %0" : "=v"(l)); return l; }
__device__ __forceinline__ float wave_sum(float v) {
#pragma unroll
    for (int o = 1; o < 64; o <<= 1) v += __shfl_xor(v, o);
    return v;
}
namespace pg8 {
#define PG8_LAS __attribute__((address_space(3)))
typedef unsigned short bf16_t;
typedef short bf16x8 __attribute__((ext_vector_type(8)));
typedef float f32x4 __attribute__((ext_vector_type(4)));
typedef unsigned u32x4 __attribute__((ext_vector_type(4)));
constexpr int BM = 256, BK = 64, HALF = 128, HTB = HALF * BK * 2  , STAGE_BYTES = 8 * HTB, NXCD = 8, WGM = 8;

__host__ __device__ __forceinline__ int lds_byte(int r, int c) { const int st = (r >> 4) * 2 + (c >> 5), rr = r & 15, cc = c & 31, ob = rr * 64 + cc * 2; return st * 1024 + (ob ^ (((ob >> 9) & 1) << 5)); }
__host__ __device__ __forceinline__ void stage_rc(int b, int& R, int& C) { const int st = b / 1024, sb = b % 1024, swz = sb ^ (((sb >> 9) & 1) << 5); R = (st >> 1) * 16 + swz / 64; C = (st & 1) * 32 + (swz % 64) / 2; }
__host__ __device__ __forceinline__ int perm32(int rho) { const int n = rho >> 4, i = rho & 15; return 8 * (i >> 2) + 4 * n + (i & 3); }

struct Unit { int pm, pn; };
struct Gemm { const bf16_t* A; const bf16_t* Bt; int M, N, K; };

struct StaticOrder {
    int nM, nN, nwg, G, c;
    __host__ __device__ void init(int M, int N, int G_, int c_) { nM = M / BM; nN = N / BM; nwg = nM * nN; G = G_; c = c_; }
    __host__ __device__ bool next(int i, Unit& u) const {
        const long L = (long)i * G + c; if (L >= nwg) return false;
        int wgid = (int)L; { const int q = nwg / NXCD, r = nwg % NXCD, xcd = wgid % NXCD, off = wgid / NXCD; wgid = (xcd < r ? xcd * (q + 1) : r * (q + 1) + (xcd - r) * q) + off; }
        const int nig = WGM * nN, gid = wgid / nig, fm = gid * WGM, gsz = (nM - fm) < WGM ? (nM - fm) : WGM;
        u.pm = fm + ((wgid % nig) % gsz); u.pn = (wgid % nig) / gsz; return true;
    }
    __device__ __forceinline__ void a_ready(const Unit&) const {}
    __device__ __forceinline__ void done(const Unit&) const {}
};

__device__ __forceinline__ unsigned cvt_pk_bf16(float lo, float hi) { unsigned r; asm volatile("v_cvt_pk_bf16_f32 %0, %1, %2" : "=v"(r) : "v"(lo), "v"(hi)); return r; }
typedef float f32x2 __attribute__((ext_vector_type(2)));
template <class Epi, class Sched, bool ALIGN_EPI = false, bool SP2 = false>
__device__ __forceinline__ void gemm_phase(PG8_LAS unsigned char* lds, const Gemm g, const Sched& S, const Epi& E, const int wid, const int lane) {
    const int tid = wid * 64 + lane, wr = wid >> 2, wc = wid & 3, fr = lane & 15, fq = lane >> 4;
    const int K = g.K, nt = K / BK;
    unsigned voffA[2], voffB[2];
#pragma unroll
    for (int i = 0; i < 2; ++i) { int R, C; stage_rc(tid * 16 + i * 8192, R, C); const int Rb = Epi::PERM ? ((R & ~31) + perm32(R & 31)) : R;
        voffA[i] = (unsigned)(R * K + C) * 2u; voffB[i] = (unsigned)(Rb * K + C) * 2u; }
    const size_t kstep = (size_t)(BK * 2);
    const size_t hstep = (size_t)HALF * K * 2;
    const size_t tstep = 2 * hstep;
    const unsigned ldsw = (unsigned)wid * 1024u;
    const int aoff = lds_byte(wr * 64 + fr, fq * 8), boff = lds_byte(wc * 32 + fr, fq * 8);
#define PG8_SA(b, h) (((b) * 2 + (h)) * HTB)
#define PG8_SB(b, h) ((4 + (b) * 2 + (h)) * HTB)
#define PG8_STAGE(bufoff, gbase, voff) do { _Pragma("unroll") for (int _i = 0; _i < 2; ++_i) \
        __builtin_amdgcn_global_load_lds((const unsigned*)((const char*)(gbase) + (voff)[_i]), (PG8_LAS unsigned*)(lds + (bufoff) + ldsw + _i * 8192), 16, 0, 0); } while (0)
#define PG8_LDA(dst, b, h) do { _Pragma("unroll") for (int m = 0; m < 4; ++m) _Pragma("unroll") for (int k = 0; k < 2; ++k) dst[m][k] = *(const PG8_LAS bf16x8*)(lds + PG8_SA(b, h) + aoff + m * 2048 + k * 1024); } while (0)
#define PG8_LDB(dst, b, h) do { _Pragma("unroll") for (int n = 0; n < 2; ++n) _Pragma("unroll") for (int k = 0; k < 2; ++k) dst[n][k] = *(const PG8_LAS bf16x8*)(lds + PG8_SB(b, h) + boff + n * 2048 + k * 1024); } while (0)
#define PG8_MMA(ai, bj, At, Bt) do { __builtin_amdgcn_s_setprio(1); _Pragma("unroll") for (int m = 0; m < 4; ++m) _Pragma("unroll") for (int n = 0; n < 2; ++n) _Pragma("unroll") for (int k = 0; k < 2; ++k) \
        acc[ai][bj][m][n] = __builtin_amdgcn_mfma_f32_16x16x32_bf16(Bt[n][k], At[m][k], acc[ai][bj][m][n], 0, 0, 0); __builtin_amdgcn_s_setprio(0); } while (0)
#define PG8_WAIT_V(n) asm volatile("s_waitcnt vmcnt(" #n ")" ::: "memory")
#define PG8_WAIT_L(n) asm volatile("s_waitcnt lgkmcnt(" #n ")" ::: "memory")
#define PG8_BAR __builtin_amdgcn_s_barrier()
#define PG8_SCHED __builtin_amdgcn_sched_barrier(0)
    Unit cur, nxt; int ui = 0;
    if (!S.next(0, cur)) return;
    f32x4 acc[2][2][4][2];
#pragma unroll
    for (int a = 0; a < 2; ++a)
#pragma unroll
        for (int b = 0; b < 2; ++b)
#pragma unroll
            for (int m = 0; m < 4; ++m)
#pragma unroll
                for (int n = 0; n < 2; ++n) acc[a][b][m][n] = (f32x4){0.f, 0.f, 0.f, 0.f};
    bf16x8 At[4][2], B0[2][2], B1[2][2];
    const char* cA = (const char*)g.A + (size_t)cur.pm * tstep; const char* cB = (const char*)g.Bt + (size_t)cur.pn * tstep;
    S.a_ready(cur);
    if constexpr (SP2) {
        PG8_STAGE(PG8_SB(0, 0), cB, voffB); PG8_STAGE(PG8_SB(0, 1), cB + hstep, voffB); PG8_STAGE(PG8_SA(0, 0), cA, voffA); PG8_STAGE(PG8_SA(0, 1), cA + hstep, voffA);
        if (wr == 1) PG8_BAR;
        PG8_WAIT_V(2); PG8_BAR;
        PG8_STAGE(PG8_SB(1, 0), cB + kstep, voffB); PG8_STAGE(PG8_SA(1, 0), cA + kstep, voffA); PG8_STAGE(PG8_SB(1, 1), cB + hstep + kstep, voffB);
        PG8_WAIT_V(6); PG8_BAR;
    } else {
        PG8_STAGE(PG8_SB(0, 0), cB, voffB); PG8_STAGE(PG8_SA(0, 0), cA, voffA); PG8_STAGE(PG8_SB(0, 1), cB + hstep, voffB); PG8_STAGE(PG8_SA(0, 1), cA + hstep, voffA);
        if (wr == 1) PG8_BAR;
        PG8_WAIT_V(4); PG8_BAR;
        PG8_STAGE(PG8_SB(1, 0), cB + kstep, voffB); PG8_STAGE(PG8_SA(1, 0), cA + kstep, voffA); PG8_STAGE(PG8_SB(1, 1), cB + hstep + kstep, voffB);
        PG8_WAIT_V(6); PG8_BAR;
    }
    for (;;) {
        const bool has_next = S.next(ui + 1, nxt);
        const char* nA = has_next ? (const char*)g.A + (size_t)nxt.pm * tstep : cA; const char* nB = has_next ? (const char*)g.Bt + (size_t)nxt.pn * tstep : cB;
        for (int t = 0; t < nt; t += 2) {
            const bool last = (t == nt - 2);
            const char* a1 = cA + (size_t)(t + 1) * kstep;
            const char* a2 = last ? nA : cA + (size_t)(t + 2) * kstep; const char* b2 = last ? nB : cB + (size_t)(t + 2) * kstep;
            const char* a3 = a2 + kstep; const char* b3 = b2 + kstep;
            if (last && has_next) S.a_ready(nxt);
            if constexpr (SP2) {
            PG8_LDB(B0, 0, 0); PG8_LDB(B1, 0, 1); PG8_SCHED; PG8_LDA(At, 0, 0); PG8_STAGE(PG8_SA(1, 1), a1 + hstep, voffA);
            PG8_WAIT_V(8); PG8_WAIT_L(0); PG8_BAR; PG8_MMA(0, 0, At, B0); PG8_MMA(0, 1, At, B1); PG8_BAR; PG8_SCHED;
            PG8_LDA(At, 0, 1); PG8_STAGE(PG8_SB(0, 0), b2, voffB); PG8_STAGE(PG8_SB(0, 1), b2 + hstep, voffB); PG8_STAGE(PG8_SA(0, 0), a2, voffA);
            PG8_WAIT_V(8); PG8_WAIT_L(0); PG8_BAR; PG8_MMA(1, 0, At, B0); PG8_MMA(1, 1, At, B1); PG8_BAR; PG8_SCHED;
            PG8_LDB(B0, 1, 0); PG8_LDB(B1, 1, 1); PG8_SCHED; PG8_LDA(At, 1, 0); PG8_STAGE(PG8_SA(0, 1), a2 + hstep, voffA);
            PG8_WAIT_V(8); PG8_WAIT_L(0); PG8_BAR; PG8_MMA(0, 0, At, B0); PG8_MMA(0, 1, At, B1); PG8_BAR; PG8_SCHED;
            PG8_LDA(At, 1, 1); PG8_STAGE(PG8_SB(1, 0), b3, voffB); PG8_STAGE(PG8_SB(1, 1), b3 + hstep, voffB); PG8_STAGE(PG8_SA(1, 0), a3, voffA);
            PG8_WAIT_V(8); PG8_WAIT_L(0); PG8_BAR; PG8_MMA(1, 0, At, B0); PG8_MMA(1, 1, At, B1); PG8_BAR; PG8_SCHED;
            } else {
            PG8_LDB(B0, 0, 0); PG8_SCHED; PG8_LDA(At, 0, 0); PG8_STAGE(PG8_SA(1, 1), a1 + hstep, voffA);
            PG8_WAIT_L(8); PG8_BAR; PG8_WAIT_L(0); PG8_MMA(0, 0, At, B0); PG8_BAR; PG8_SCHED;
            PG8_LDB(B1, 0, 1); PG8_STAGE(PG8_SB(0, 0), b2, voffB);
            PG8_BAR; PG8_WAIT_L(0); PG8_MMA(0, 1, At, B1); PG8_BAR;
            PG8_LDA(At, 0, 1); PG8_STAGE(PG8_SA(0, 0), a2, voffA);
            PG8_BAR; PG8_WAIT_L(0); PG8_MMA(1, 0, At, B0); PG8_BAR; PG8_SCHED;
            PG8_STAGE(PG8_SB(0, 1), b2 + hstep, voffB);
            PG8_WAIT_V(6); PG8_BAR; PG8_MMA(1, 1, At, B1); PG8_BAR;
            PG8_LDB(B0, 1, 0); PG8_SCHED; PG8_LDA(At, 1, 0); PG8_STAGE(PG8_SA(0, 1), a2 + hstep, voffA);
            PG8_WAIT_L(8); PG8_BAR; PG8_WAIT_L(0); PG8_MMA(0, 0, At, B0); PG8_BAR; PG8_SCHED;
            PG8_LDB(B1, 1, 1); PG8_STAGE(PG8_SB(1, 0), b3, voffB);
            PG8_BAR; PG8_WAIT_L(0); PG8_MMA(0, 1, At, B1); PG8_BAR;
            PG8_LDA(At, 1, 1); PG8_STAGE(PG8_SA(1, 0), a3, voffA);
            PG8_BAR; PG8_WAIT_L(0); PG8_MMA(1, 0, At, B0); PG8_BAR; PG8_SCHED;
            PG8_STAGE(PG8_SB(1, 1), b3 + hstep, voffB);
            PG8_WAIT_V(6); PG8_BAR; PG8_MMA(1, 1, At, B1); PG8_BAR;
            }
        }
        if constexpr (ALIGN_EPI) { if (wr == 0) PG8_BAR; }
        if constexpr (!Epi::AFTER_DRAIN) { const int le = fresh_lane(); E(acc, cur, wr, wc, le & 15, le >> 4); S.done(cur); }
        if (!has_next) break;
#pragma unroll
        for (int a = 0; a < 2; ++a)
#pragma unroll
            for (int b = 0; b < 2; ++b)
#pragma unroll
                for (int m = 0; m < 4; ++m)
#pragma unroll
                    for (int n = 0; n < 2; ++n) acc[a][b][m][n] = (f32x4){0.f, 0.f, 0.f, 0.f};
        cur = nxt; cA = nA; cB = nB; ++ui;
        if constexpr (ALIGN_EPI) { if (wr == 1) PG8_BAR; }
    }
    PG8_WAIT_V(0);
    if constexpr (!ALIGN_EPI) { if (wr == 0) PG8_BAR; }
    PG8_BAR;
    if constexpr (Epi::AFTER_DRAIN) { E.fused(acc, cur, wr, wc, fr, fq, lds, wid, lane); S.done(cur); }
#undef PG8_SA
#undef PG8_SB
#undef PG8_STAGE
#undef PG8_LDA
#undef PG8_LDB
#undef PG8_MMA
#undef PG8_WAIT_V
#undef PG8_WAIT_L
#undef PG8_BAR
#undef PG8_SCHED
}
}
typedef f32x4 acc_t[2][2][4][2];

__device__ __forceinline__ float rstd_from_parts16(const float* __restrict__ part, int row) {
    const f32x4* p = (const f32x4*)(part + (size_t)row * 16);
    const f32x4 a = p[0], b = p[1], c = p[2], d = p[3];
    const float s = ((a[0] + a[1]) + (a[2] + a[3])) + ((b[0] + b[1]) + (b[2] + b[3])) + ((c[0] + c[1]) + (c[2] + c[3])) + ((d[0] + d[1]) + (d[2] + d[3]));
    return 1.0f / sqrtf(s * (1.0f / 1024.0f) + EPS);
}
constexpr int EPI_TBL_OFF = 131072;
__device__ __forceinline__ void fill_rstd16(LAS float* T, const float* __restrict__ part, int pm, int wr, int lane) {
    const float r0 = rstd_from_parts16(part, pm * 256 + wr * 64 + lane), r1 = rstd_from_parts16(part, pm * 256 + 128 + wr * 64 + lane);
    T[lane] = r0; T[64 + lane] = r1;
}
__device__ __forceinline__ float quad_sum(float s) { s += __shfl_xor(s, 16); s += __shfl_xor(s, 32); return s; }
__device__ __forceinline__ float sumsq16(const f32x4 (&v)[2][2]) {
    float s = 0.f;
#pragma unroll
    for (int bj = 0; bj < 2; ++bj)
#pragma unroll
        for (int n = 0; n < 2; ++n) s += (v[bj][n][0] * v[bj][n][0] + v[bj][n][1] * v[bj][n][1]) + (v[bj][n][2] * v[bj][n][2] + v[bj][n][3] * v[bj][n][3]);
    return s;
}
__device__ __forceinline__ void head_norm_rope(f32x4 (&v)[2][2], bool do_norm, bool use_gain, const f32x4 (&g)[2][2], const float* __restrict__ cs_row, int fq, float scale) {
    if (do_norm) {
        const float ss = quad_sum(sumsq16(v));
        const float rn = 1.0f / sqrtf(ss * (1.0f / 64.0f) + EPS);
#pragma unroll
        for (int bj = 0; bj < 2; ++bj)
#pragma unroll
            for (int n = 0; n < 2; ++n) { v[bj][n] = v[bj][n] * rn; if (use_gain) v[bj][n] = v[bj][n] * g[bj][n]; }
    }
    if (fq == 0) {
        const f32x4* c4 = (const f32x4*)cs_row;
#pragma unroll
        for (int n = 0; n < 2; ++n) {
            const f32x4 c = c4[n], s = c4[2 + n];
            const f32x4 x1 = v[0][n], x2 = v[1][n];
            v[0][n] = x1 * c - x2 * s;
            v[1][n] = x2 * c + x1 * s;
        }
    }
    if (scale != 1.0f) {
#pragma unroll
        for (int bj = 0; bj < 2; ++bj)
#pragma unroll
            for (int n = 0; n < 2; ++n) v[bj][n] = v[bj][n] * scale;
    }
}
__device__ __forceinline__ void store_bf16x16(bf16_t* p, const f32x4 (&v)[2][2]) {
#pragma unroll
    for (int bj = 0; bj < 2; ++bj) {
        u32x4 w; w.x = cvt_pk_bf16(v[bj][0][0], v[bj][0][1]); w.y = cvt_pk_bf16(v[bj][0][2], v[bj][0][3]); w.z = cvt_pk_bf16(v[bj][1][0], v[bj][1][1]); w.w = cvt_pk_bf16(v[bj][1][2], v[bj][1][3]);
        *(u32x4*)(p + 8 * bj) = w;
    }
}
__device__ __forceinline__ void load_gain16(f32x4 (&g)[2][2], const float* __restrict__ gp, int fq) {
#pragma unroll
    for (int bj = 0; bj < 2; ++bj)
#pragma unroll
        for (int n = 0; n < 2; ++n) g[bj][n] = *(const f32x4*)(gp + 16 * fq + 8 * bj + 4 * n);
}

struct EpiQKV0 {
    static constexpr bool PERM = false, AFTER_DRAIN = false;
    const float* part; const float* cs; const float* qg; const float* kg; bf16_t* QKV; size_t stride; float qscale; LAS float* T;
    __device__ __forceinline__ void operator()(const acc_t& acc, const pg8::Unit& u, int wr, int wc, int fr, int fq) const {
        const int kind = u.pn >> 2, head = (u.pn & 3) * 4 + wc;
        bf16_t* dst = QKV + (size_t)kind * stride + head * 64 + 16 * fq;
        f32x4 g[2][2] = {};
        if (kind < 2) load_gain16(g, kind == 0 ? qg : kg, fq);
        fill_rstd16(T, part, u.pm, wr, fr + 16 * fq);
#pragma unroll
        for (int ai = 0; ai < 2; ++ai)
#pragma unroll
            for (int m = 0; m < 4; ++m) {
                const int row = u.pm * 256 + ai * 128 + wr * 64 + m * 16 + fr;
                const float rs = T[ai * 64 + m * 16 + fr];
                f32x4 v[2][2];
#pragma unroll
                for (int bj = 0; bj < 2; ++bj)
#pragma unroll
                    for (int n = 0; n < 2; ++n) v[bj][n] = acc[ai][bj][m][n] * rs;
                if (kind < 2) head_norm_rope(v, true, true, g, cs + (size_t)row * 16, fq, kind == 0 ? qscale : 1.0f);
                store_bf16x16(dst + (size_t)row * DM, v);
            }
    }
};
template <bool RES_BF16, bool OUT_F32> struct EpiResidT {
    static constexpr bool PERM = false, AFTER_DRAIN = false;
    const float* R; const bf16_t* Rb; float* out; bf16_t* xb; float* part;
    __device__ __forceinline__ void operator()(const acc_t& acc, const pg8::Unit& u, int wr, int wc, int fr, int fq) const {
        const int col0 = u.pn * 256 + wc * 64 + 16 * fq;
#pragma unroll
        for (int ai = 0; ai < 2; ++ai)
#pragma unroll
            for (int m = 0; m < 4; ++m) {
                const int row = u.pm * 256 + ai * 128 + wr * 64 + m * 16 + fr;
                const size_t off = (size_t)row * DM + col0;
                f32x4 v[2][2];
                if (RES_BF16) {
#pragma unroll
                    for (int bj = 0; bj < 2; ++bj) {
                        const u32x4 w = *(const u32x4*)(Rb + off + 8 * bj);
                        const unsigned ww[4] = {w.x, w.y, w.z, w.w};
#pragma unroll
                        for (int n = 0; n < 2; ++n) {
                            f32x4 r; r[0] = __builtin_bit_cast(float, ww[2 * n] << 16); r[1] = __builtin_bit_cast(float, ww[2 * n] & 0xffff0000u);
                            r[2] = __builtin_bit_cast(float, ww[2 * n + 1] << 16); r[3] = __builtin_bit_cast(float, ww[2 * n + 1] & 0xffff0000u);
                            v[bj][n] = r + acc[ai][bj][m][n];
                        }
                    }
                } else {
#pragma unroll
                    for (int bj = 0; bj < 2; ++bj)
#pragma unroll
                        for (int n = 0; n < 2; ++n) v[bj][n] = *(const f32x4*)(R + off + 8 * bj + 4 * n) + acc[ai][bj][m][n];
                }
                if (OUT_F32) {
#pragma unroll
                    for (int bj = 0; bj < 2; ++bj)
#pragma unroll
                        for (int n = 0; n < 2; ++n) *(f32x4*)(out + off + 8 * bj + 4 * n) = v[bj][n];
                }
                if (xb) store_bf16x16(xb + off, v);
                if (part) { const float ss = quad_sum(sumsq16(v)); if (fq == 0) part[(size_t)row * 16 + u.pn * 4 + wc] = ss; }
            }
    }
};
struct EpiUp {
    static constexpr bool PERM = false, AFTER_DRAIN = false;
    const float* part; bf16_t* U; LAS float* T;
    __device__ __forceinline__ void operator()(const acc_t& acc, const pg8::Unit& u, int wr, int wc, int fr, int fq) const {
        const int col0 = u.pn * 256 + wc * 64 + 16 * fq;
        fill_rstd16(T, part, u.pm, wr, fr + 16 * fq);
#pragma unroll
        for (int ai = 0; ai < 2; ++ai)
#pragma unroll
            for (int m = 0; m < 4; ++m) {
                const int row = u.pm * 256 + ai * 128 + wr * 64 + m * 16 + fr;
                const float rs = T[ai * 64 + m * 16 + fr];
                f32x4 v[2][2];
#pragma unroll
                for (int bj = 0; bj < 2; ++bj)
#pragma unroll
                    for (int n = 0; n < 2; ++n) {
                        f32x4 t = acc[ai][bj][m][n] * rs;
#pragma unroll
                        for (int j = 0; j < 4; ++j) { const float r = fmaxf(t[j], 0.f); t[j] = r * r; }
                        v[bj][n] = t;
                    }
                store_bf16x16(U + (size_t)row * DFF + col0, v);
            }
    }
};
struct EpiIn1 {
    static constexpr bool PERM = false, AFTER_DRAIN = false;
    const float* part; const float* cs; const float* kg; bf16_t* CQ; float* cqp; bf16_t* K; bf16_t* V; bf16_t* KI; float* widx; float wscale; LAS float* T;
    __device__ __forceinline__ void operator()(const acc_t& acc, const pg8::Unit& u, int wr, int wc, int fr, int fq) const {
        const int pn = u.pn;
        if (pn == 9 && wc >= 2) return;
        f32x4 g[2][2] = {};
        if (pn >= 1 && pn <= 4) load_gain16(g, kg, fq);
        fill_rstd16(T, part, u.pm, wr, fr + 16 * fq);
#pragma unroll
        for (int ai = 0; ai < 2; ++ai)
#pragma unroll
            for (int m = 0; m < 4; ++m) {
                const int row = u.pm * 256 + ai * 128 + wr * 64 + m * 16 + fr;
                const float rs = T[ai * 64 + m * 16 + fr];
                f32x4 v[2][2];
#pragma unroll
                for (int bj = 0; bj < 2; ++bj)
#pragma unroll
                    for (int n = 0; n < 2; ++n) v[bj][n] = acc[ai][bj][m][n] * rs;
                if (pn == 0) {
                    store_bf16x16(CQ + (size_t)row * 256 + wc * 64 + 16 * fq, v);
                    const float ss = quad_sum(sumsq16(v)); if (fq == 0) cqp[(size_t)row * 4 + wc] = ss;
                } else if (pn <= 4) {
                    head_norm_rope(v, true, true, g, cs + (size_t)row * 16, fq, 1.0f);
                    store_bf16x16(K + (size_t)row * DM + ((pn - 1) * 4 + wc) * 64 + 16 * fq, v);
                } else if (pn <= 8) {
                    store_bf16x16(V + (size_t)row * DM + ((pn - 5) * 4 + wc) * 64 + 16 * fq, v);
                } else if (wc == 0) {
                    head_norm_rope(v, true, false, g, cs + (size_t)row * 16, fq, 1.0f);
                    store_bf16x16(KI + (size_t)row * 64 + 16 * fq, v);
                } else if (fq == 0) {
                    *(f32x4*)(widx + (size_t)row * 8) = v[0][0] * wscale; *(f32x4*)(widx + (size_t)row * 8 + 4) = v[0][1] * wscale;
                }
            }
    }
};
struct EpiQup {
    static constexpr bool PERM = false, AFTER_DRAIN = false;
    const float* cqp; const float* cs; const float* qg; const float* widx; bf16_t* Q; bf16_t* QI; float* qin; float qscale; LAS float* T;
    __device__ __forceinline__ void operator()(const acc_t& acc, const pg8::Unit& u, int wr, int wc, int fr, int fq) const {
        const int pn = u.pn;
        f32x4 g[2][2] = {};
        if (pn < 4) load_gain16(g, qg, fq);
        { const int lane = fr + 16 * fq;
          const f32x4 c0 = *(const f32x4*)(cqp + (size_t)(u.pm * 256 + wr * 64 + lane) * 4), c1 = *(const f32x4*)(cqp + (size_t)(u.pm * 256 + 128 + wr * 64 + lane) * 4);
          T[lane] = 1.0f / sqrtf(((c0[0] + c0[1]) + (c0[2] + c0[3])) * (1.0f / 256.0f) + EPS); T[64 + lane] = 1.0f / sqrtf(((c1[0] + c1[1]) + (c1[2] + c1[3])) * (1.0f / 256.0f) + EPS); }
#pragma unroll
        for (int ai = 0; ai < 2; ++ai)
#pragma unroll
            for (int m = 0; m < 4; ++m) {
                const int row = u.pm * 256 + ai * 128 + wr * 64 + m * 16 + fr;
                const float rs = T[ai * 64 + m * 16 + fr];
                f32x4 v[2][2];
#pragma unroll
                for (int bj = 0; bj < 2; ++bj)
#pragma unroll
                    for (int n = 0; n < 2; ++n) v[bj][n] = acc[ai][bj][m][n] * rs;
                if (pn < 4) {
                    head_norm_rope(v, true, true, g, cs + (size_t)row * 16, fq, qscale);
                    store_bf16x16(Q + (size_t)row * DM + (pn * 4 + wc) * 64 + 16 * fq, v);
                } else {
                    const int hh = (pn - 4) * 4 + wc;
                    head_norm_rope(v, false, false, g, cs + (size_t)row * 16, fq, 1.0f);
                    const float nrm = sqrtf(quad_sum(sumsq16(v)));
                    const float inv = nrm > 0.f ? 1.0f / (8.2f * nrm) : 0.f;
#pragma unroll
                    for (int bj = 0; bj < 2; ++bj)
#pragma unroll
                        for (int n = 0; n < 2; ++n) v[bj][n] = v[bj][n] * inv;
                    store_bf16x16(QI + (size_t)row * 512 + hh * 64 + 16 * fq, v);
                    if (fq == 0) qin[(size_t)row * 8 + hh] = widx[(size_t)row * 8 + hh] * (8.2f * nrm);
                }
            }
    }
};
typedef GAS unsigned gu32;
#define RLX_AGENT __ATOMIC_RELAXED, __HIP_MEMORY_SCOPE_AGENT
#define LDS_WAIT() asm volatile("s_waitcnt lgkmcnt(0)" ::: "memory")
#define VM_WAIT() asm volatile("s_waitcnt vmcnt(0)" ::: "memory")

constexpr int RING_BYTES = 143360;
constexpr int MISC_OFF = RING_BYTES + 320;
constexpr int LDS_BYTES = 147456;
constexpr int NWAVES = 8;

#define XB_TMO      128
#define XB_XCNT(j)  (256  + 64 * (j))
#define XB_XSUB(j)  (1280 + 64 * (j))
#define XB_XGEN(j)  (2304 + 64 * (j))
#define XB_TOP      3328
#define XB_TOPGEN   3392
#define XCD_BAR_WORDS 3456
#define XB_SPIN_CAP (1u << 18)
__device__ __forceinline__ unsigned xb_ld(unsigned* p)              { return __hip_atomic_load(p, __ATOMIC_RELAXED, __HIP_MEMORY_SCOPE_AGENT); }
__device__ __forceinline__ unsigned xb_add(unsigned* p, unsigned v) { return __hip_atomic_fetch_add(p, v, __ATOMIC_RELAXED, __HIP_MEMORY_SCOPE_AGENT); }
__device__ __forceinline__ unsigned xb_xcc_id() { return (unsigned)__builtin_amdgcn_s_getreg((3 << 11) | 20) & 0xFu; }
#define XB_SPIN(cond, bar) do { unsigned _sp = 0; while (cond) { __builtin_amdgcn_s_sleep(1); \
    if ((++_sp & 255u) == 0u) { if (xb_ld(&(bar)[XB_TMO])) break; if (_sp > XB_SPIN_CAP) { atomicAdd(&(bar)[XB_TMO], 1u); break; } } } } while (0)
struct XcdBarrier { unsigned* bar; unsigned x; volatile LAS unsigned* st; };
__device__ __forceinline__ XcdBarrier xcd_barrier_post(unsigned* bar, volatile LAS unsigned* st) {
    XcdBarrier b; b.bar = bar; b.x = xb_xcc_id(); b.st = st;
    if (threadIdx.x == 0) (void)xb_add(&bar[XB_XCNT(b.x)], 1u);
    return b;
}
__device__ __forceinline__ void xcd_barrier_complete(unsigned* bar, unsigned x, unsigned& nloc, unsigned& nx) {
    const unsigned G = gridDim.x * gridDim.y * gridDim.z;
    unsigned sum, cnt, mine, sp = 0u;
    for (;;) {
        sum = 0u; cnt = 0u; mine = 0u;
#pragma unroll
        for (unsigned j = 0; j < 16; ++j) { const unsigned c = xb_ld(&bar[XB_XCNT(j)]); sum += c; cnt += (c > 0u) ? 1u : 0u; mine = (j == x) ? c : mine; }
        if (sum == G) break;
        __builtin_amdgcn_s_sleep(1);
        if ((++sp & 255u) == 0u) { if (xb_ld(&bar[XB_TMO])) break; if (sp > XB_SPIN_CAP) { atomicAdd(&bar[XB_TMO], 1u); break; } }
    }
    nloc = mine > 0u ? mine : 1u; nx = cnt > 0u ? cnt : 1u;
}
__device__ __forceinline__ void xcd_barrier(const XcdBarrier& b, const int wave) {
    asm volatile("s_waitcnt vmcnt(0)" ::: "memory");
    __syncthreads();
    if (wave == 0 && fresh_lane() == 0) {
        unsigned* bar = b.bar;
        __builtin_amdgcn_s_waitcnt(0);
        unsigned nloc = b.st[0], nx = b.st[1];
        if (nloc == 0u) { xcd_barrier_complete(bar, b.x, nloc, nx); b.st[0] = nloc; b.st[1] = nx; }
        const unsigned old = xb_add(&bar[XB_XSUB(b.x)], 1u);
        const unsigned gen = old / nloc;
        if (old + 1u == (gen + 1u) * nloc) {
            __builtin_amdgcn_fence(__ATOMIC_RELEASE, "agent");
            asm volatile("s_waitcnt vmcnt(0)" ::: "memory");
            const unsigned og = xb_add(&bar[XB_TOP], 1u);
            const unsigned tg = og / nx;
            if (og + 1u == (tg + 1u) * nx) xb_add(&bar[XB_TOPGEN], 1u);
            else XB_SPIN(xb_ld(&bar[XB_TOPGEN]) == tg, bar);
            __builtin_amdgcn_fence(__ATOMIC_ACQUIRE, "agent");
            xb_add(&bar[XB_XGEN(b.x)], 1u);
            asm volatile("s_waitcnt vmcnt(0)" ::: "memory");
        } else {
            XB_SPIN(xb_ld(&bar[XB_XGEN(b.x)]) == gen, bar);
            __builtin_amdgcn_fence(__ATOMIC_ACQUIRE, "agent");
            asm volatile("s_waitcnt vmcnt(0)" ::: "memory");
        }
    }
    __syncthreads();
}

__device__ __forceinline__ unsigned f2bf(float f) { unsigned u = __builtin_bit_cast(unsigned, f); return (u + 0x7fffu + ((u >> 16) & 1u)) >> 16; }
__device__ __forceinline__ unsigned pk2(float lo, float hi) { return f2bf(lo) | (f2bf(hi) << 16); }
__device__ __forceinline__ void p0_transpose_item(const float* __restrict__ W, int K, int N, const float* __restrict__ gain, bf16_t* WT, int row_off, LAS float* scr, int item, int nblk, int lane) {
    const int kb = item / nblk, nb = item % nblk, k0 = 64 * kb, n0 = 32 * nb;
    const int cc = n0 + (lane & 31);
    float wv[32];
#pragma unroll
    for (int i = 0; i < 32; ++i) { const int kk = 2 * i + (lane >> 5); wv[i] = (cc < N) ? W[(size_t)(k0 + kk) * N + cc] : 0.f; }
    if (gain) {
#pragma unroll
        for (int i = 0; i < 32; ++i) wv[i] *= gain[k0 + 2 * i + (lane >> 5)];
    }
#pragma unroll
    for (int i = 0; i < 32; ++i) scr[(2 * i + (lane >> 5)) * 33 + (lane & 31)] = wv[i];
    LDS_WAIT(); asm volatile("" ::: "memory");
    const int c = lane & 7;
#pragma unroll
    for (int j = 0; j < 4; ++j) { const int n = (lane >> 3) + 8 * j; const LAS float* s = scr + (8 * c) * 33 + n;
        u32x4 o; o.x = pk2(s[0 * 33], s[1 * 33]); o.y = pk2(s[2 * 33], s[3 * 33]); o.z = pk2(s[4 * 33], s[5 * 33]); o.w = pk2(s[6 * 33], s[7 * 33]);
        const int cl = n0 + n; const int drow = row_off + (cl & ~255) + tile_pos(cl & 255);
        *(GAS u32x4*)(WT + (size_t)drow * K + k0 + 8 * c) = o; }
    LDS_WAIT(); asm volatile("" ::: "memory");
}
struct WJob { const float* W; const float* gain; bf16_t* WT; int K, N, Npad, row_off; };
template <int NR> __device__ __forceinline__ void rows_to_bf16(const float* x, bf16_t* xb, float* part, int m, int rstride, int lane) {
    f32x4 v[NR][4];
#pragma unroll
    for (int r = 0; r < NR; ++r) { const GAS f32x4* xr = (const GAS f32x4*)(x + (size_t)(m + r * rstride) * DM) + lane;
#pragma unroll
        for (int j = 0; j < 4; ++j) v[r][j] = xr[64 * j]; }
#pragma unroll
    for (int r = 0; r < NR; ++r) {
        float s = 0.f;
#pragma unroll
        for (int j = 0; j < 4; ++j) s += (v[r][j][0] * v[r][j][0] + v[r][j][1] * v[r][j][1]) + (v[r][j][2] * v[r][j][2] + v[r][j][3] * v[r][j][3]);
        s = wave_sum(s);
        GAS u32x2* o8 = (GAS u32x2*)(xb + (size_t)(m + r * rstride) * DM) + lane;
#pragma unroll
        for (int j = 0; j < 4; ++j) { u32x2 w; w.x = cvt_pk_bf16(v[r][j][0], v[r][j][1]); w.y = cvt_pk_bf16(v[r][j][2], v[r][j][3]); o8[64 * j] = w; }
        if (lane < 16) part[(size_t)(m + r * rstride) * 16 + lane] = (lane == 0) ? s : 0.f;
    }
}
constexpr int ATT_SCR = 131072;
constexpr int ATT_NST = 4;
typedef short v4i16_t __attribute__((ext_vector_type(4)));
typedef short s16x4 __attribute__((ext_vector_type(4)));
__device__ __forceinline__ int crow(int r, int hi) { return (r & 3) + 8 * (r >> 2) + 4 * hi; }
__device__ __forceinline__ s16x4 vtr(const LAS unsigned char* p) { return __builtin_bit_cast(s16x4, __builtin_amdgcn_ds_read_tr16_b64_v4i16((LAS v4i16_t*)p)); }
__device__ __forceinline__ void glds16(const void* gsrc, unsigned lds_dst) { unsigned keep;
    asm volatile("s_mov_b32 %0, m0\n\ts_mov_b32 m0, %2\n\ts_nop 0\n\tglobal_load_lds_dwordx4 %1, off\n\ts_mov_b32 m0, %0" : "=&s"(keep) : "v"(gsrc), "s"(lds_dst) : "memory"); }
__device__ __forceinline__ void glds4(const void* gsrc, unsigned lds_dst) { unsigned keep;
    asm volatile("s_mov_b32 %0, m0\n\ts_mov_b32 m0, %2\n\ts_nop 0\n\tglobal_load_lds_dword %1, off\n\ts_mov_b32 m0, %0" : "=&s"(keep) : "v"(gsrc), "s"(lds_dst) : "memory"); }
#define ATT_WAIT_BAR() do { asm volatile("s_waitcnt vmcnt(0) lgkmcnt(0)" ::: "memory"); __builtin_amdgcn_s_barrier(); asm volatile("" ::: "memory"); } while (0)
#define ATT_WAIT_BAR_N(N) do { asm volatile("s_waitcnt vmcnt(" #N ") lgkmcnt(0)" ::: "memory"); __builtin_amdgcn_s_barrier(); asm volatile("" ::: "memory"); } while (0)

__device__ __forceinline__ int att_k_src_chunk(int row, int slot) { return slot ^ ((row >> 1) & 7); }
__device__ __forceinline__ void att_qkt(f32x16& p0, f32x16& p1, const LAS unsigned char* Kslot, const int (&koff)[4], const bf16x8 (&qr)[4]) {
    p0 = (f32x16){}; p1 = (f32x16){};
#pragma unroll
    for (int d0 = 0; d0 < 4; ++d0) {
        const bf16x8 b0 = *(const LAS bf16x8*)(Kslot + koff[d0]);
        const bf16x8 b1 = *(const LAS bf16x8*)(Kslot + koff[d0] + 4096);
        p0 = __builtin_amdgcn_mfma_f32_32x32x16_bf16(b0, qr[d0], p0, 0, 0, 0);
        p1 = __builtin_amdgcn_mfma_f32_32x32x16_bf16(b1, qr[d0], p1, 0, 0, 0);
    }
}
__device__ __forceinline__ bf16x8 pack8(const f32x16& p, int base) {
    u32x4 w; w.x = cvt_pk_bf16(p[base], p[base + 1]); w.y = cvt_pk_bf16(p[base + 2], p[base + 3]); w.z = cvt_pk_bf16(p[base + 4], p[base + 5]); w.w = cvt_pk_bf16(p[base + 6], p[base + 7]);
    return __builtin_bit_cast(bf16x8, w);
}

template <int NDB, bool MASKED, int VAR = 0> __device__ __forceinline__ void att_step(f32x16 (&o)[NDB], f32x16& ol, bf16x8 (&pa)[4], float& l, const LAS unsigned char* Kslot, const LAS unsigned char* Vslot,
                                                                       const int (&koff)[4], const int (&vboff)[NDB], const bf16x8 (&qr)[4], unsigned mlo, unsigned mhi, const bool live) {
    constexpr int ROWB = NDB * 64;
    bf16x8 vfa[NDB == 2 ? 8 : 1];
    if (NDB == 2) {
#pragma unroll
        for (int i = 0; i < 8; ++i) { const int d = i >> 2, ks = i & 3;
            const s16x4 lo = vtr(Vslot + vboff[d] + ks * 16 * ROWB), hi4 = vtr(Vslot + vboff[d] + ks * 16 * ROWB + 8 * ROWB);
            vfa[i] = (bf16x8){lo[0], lo[1], lo[2], lo[3], hi4[0], hi4[1], hi4[2], hi4[3]}; }
    }
    f32x16 p0, p1;
    if (VAR & 8) { p0 = (f32x16){}; p1 = (f32x16){}; asm volatile("" : "+v"(p0), "+v"(p1)); } else att_qkt(p0, p1, Kslot, koff, qr);
    __builtin_amdgcn_sched_barrier(0);
    bf16x8 pn[4];
#pragma unroll
    for (int sl = 0; sl < 4; ++sl) {
#pragma unroll
        for (int j = 0; j < NDB; ++j) {
            const int d = (NDB == 4) ? sl : (sl >> 1), ks = (NDB == 4) ? j : (2 * (sl & 1) + j);
            bf16x8 vf;
            if (NDB == 2) { vf = vfa[d * 4 + ks]; } else
            if (VAR & 16) { vf = pa[ks]; } else {
                const s16x4 lo = vtr(Vslot + vboff[d] + ks * 16 * ROWB), hi4 = vtr(Vslot + vboff[d] + ks * 16 * ROWB + 8 * ROWB);
                vf = (bf16x8){lo[0], lo[1], lo[2], lo[3], hi4[0], hi4[1], hi4[2], hi4[3]}; }
            if (VAR & 4) { asm volatile("" :: "v"(vf)); } else
            o[d] = __builtin_amdgcn_mfma_f32_32x32x16_bf16(pa[ks], vf, o[d], 0, 0, 0);
        }
        if (NDB == 2) {
            const bf16x8 ones = (bf16x8){0x3F80, 0x3F80, 0x3F80, 0x3F80, 0x3F80, 0x3F80, 0x3F80, 0x3F80};
            ol = __builtin_amdgcn_mfma_f32_32x32x16_bf16(pa[sl], ones, ol, 0, 0, 0);
        }
        f32x16& p = (sl < 2) ? p0 : p1;
        const unsigned mk = (sl < 2) ? mlo : mhi;
        const int rb0 = 8 * (sl & 1);
        float ps = 0.f;
#pragma unroll
        for (int r = rb0; r < rb0 + 8; ++r) {
            float e = (VAR & 2) ? p[r] : __builtin_amdgcn_exp2f(p[r]);
            if (MASKED && !(VAR & 1)) {
                unsigned kk; asm("v_bfe_i32 %0, %1, %2, 1" : "=v"(kk) : "v"(mk), "i"((r & 3) + 8 * (r >> 2)));
                e = __uint_as_float(__float_as_uint(e) & kk);
            }
            p[r] = e; if (NDB != 2) ps += e;
        }
        if (NDB != 2) l += live ? ps : 0.f;
        pn[sl] = pack8(p, rb0);
        __builtin_amdgcn_sched_barrier(0);
    }
#pragma unroll
    for (int ks = 0; ks < 4; ++ks) pa[ks] = pn[ks];
}

constexpr int A0_STAGE = 32768;
template <int VAR = 0> __device__ __forceinline__ void attn0_unit(LAS unsigned char* lds, const int wave, int b, int h, int qb, const bf16_t* Q, const bf16_t* __restrict__ K, const bf16_t* __restrict__ V, bf16_t* O,
                                           float lam, const float* __restrict__ subg, float outscale, bool dry) {
    const int lane = fresh_lane(), r32 = lane & 31, hi = lane >> 5;
    const int cc = wave >> 2, rb = wave & 3;
    const size_t rowbase = (size_t)b * SEQ;
    const int q0 = qb * 128 + rb * 32;
    const int NT = 2 * qb + 2;
    const int mylast = 2 * qb + (rb >> 1);
    const int krow = 8 * wave + (lane >> 3), kch = att_k_src_chunk(krow, lane & 7);
    const bf16_t* ksrc0 = K + (rowbase + krow) * DM + (2 * h + 0) * 64 + kch * 8;
    const bf16_t* ksrc1 = K + (rowbase + krow) * DM + (2 * h + 1) * 64 + kch * 8;
    const int vp0 = wave, vp1 = wave + 8;
    const int vrow0 = 4 * vp0 + (lane >> 4), vrow1 = 4 * vp1 + (lane >> 4), vs = lane & 15;
    const bf16_t* vsrc0 = V + (rowbase + vrow0) * DM + h * 128 + ((((vs >> 2) ^ (vrow0 & 3)) << 2) | (vs & 3)) * 8;
    const bf16_t* vsrc1 = V + (rowbase + vrow1) * DM + h * 128 + ((((vs >> 2) ^ (vrow1 & 3)) << 2) | (vs & 3)) * 8;
    const unsigned ldsb = (unsigned)(unsigned long long)lds;
#define A0_ISSUE(t, st) do { const unsigned sb_ = (unsigned)__builtin_amdgcn_readfirstlane(ldsb + (st) * A0_STAGE); const size_t go_ = (size_t)(t) * 64 * DM; \
        glds16(ksrc0 + go_, sb_ + wave * 1024); glds16(ksrc1 + go_, sb_ + 8192 + wave * 1024); \
        glds16(vsrc0 + go_, sb_ + 16384 + vp0 * 1024); glds16(vsrc1 + go_, sb_ + 16384 + vp1 * 1024); } while (0)
    bf16x8 qr[4];
    { const bf16_t* Qw = Q + (rowbase + q0) * DM + (2 * h + cc) * 64;
#pragma unroll
      for (int d0 = 0; d0 < 4; ++d0) qr[d0] = *(const bf16x8*)(Qw + (size_t)r32 * DM + d0 * 16 + hi * 8); }
    A0_ISSUE(0, 0); A0_ISSUE(1, 1);
    f32x16 o[4]; o[0] = (f32x16){}; o[1] = (f32x16){}; o[2] = (f32x16){}; o[3] = (f32x16){};
    float l = 0.f;
    int koff[4], vboff[4];
    { const int sw = (r32 >> 1) & 7, q4 = (lane & 15) >> 2, vbase = (4 * hi + q4) * 256 + ((lane >> 4) & 1) * 32 + (lane & 3) * 8;
#pragma unroll
      for (int d = 0; d < 4; ++d) { koff[d] = r32 * 128 + (((2 * d + hi) ^ sw) << 4); vboff[d] = vbase + ((d ^ q4) << 6); } }
    if (wave >= 4) __builtin_amdgcn_s_setprio(1);
    bf16x8 pa[4]; pa[0] = (bf16x8){}; pa[1] = (bf16x8){}; pa[2] = (bf16x8){}; pa[3] = (bf16x8){};
    int sk = 0, sv = 3;
    for (int t = 0; t <= NT; ++t) {
        if (t + 1 < NT) ATT_WAIT_BAR_N(4); else ATT_WAIT_BAR();
        if (t + 2 < NT) A0_ISSUE(t + 2, ((sk + 2) & 3));
        if (t <= mylast + 1) {
            const LAS unsigned char* Kslot = lds + sk * A0_STAGE + cc * 8192;
            const LAS unsigned char* Vslot = lds + (t == 0 ? 0 : sv) * A0_STAGE + 16384;
            att_step<4, false, VAR>(o, o[0], pa, l, Kslot, Vslot, koff, vboff, qr, 0u, 0u, t <= mylast);
        }
        sv = sk; sk = (sk + 1) & 3;
    }
#undef A0_ISSUE
    __builtin_amdgcn_s_setprio(0);
    ATT_WAIT_BAR();
    const int lane_e = fresh_lane(), r32e = lane_e & 31, hie = lane_e >> 5;
    l += __shfl_xor(l, 32);
    LAS float* wsf = (LAS float*)(lds + ATT_SCR + wave * 256);
    if (hie == 0) wsf[r32e] = l;
    asm volatile("s_waitcnt lgkmcnt(0)" ::: "memory");
    float rli[16];
#pragma unroll
    for (int r = 0; r < 16; ++r) rli[r] = 1.0f / wsf[crow(r, hie)];
    LAS float* X = (LAS float*)lds;
    if (cc == 1) {
#pragma unroll
        for (int r = 0; r < 16; ++r)
#pragma unroll
            for (int d = 0; d < 4; ++d) X[(rb * 32 + crow(r, hie)) * 128 + d * 32 + r32e] = o[d][r] * rli[r];
    }
    ATT_WAIT_BAR();
    if (cc == 0 && !dry) {
        float gsub[4];
#pragma unroll
        for (int d = 0; d < 4; ++d) gsub[d] = subg[d * 32 + r32e] * outscale;
#pragma unroll
        for (int r = 0; r < 16; ++r) {
            float v[4]; float ss = 0.f;
#pragma unroll
            for (int d = 0; d < 4; ++d) { v[d] = o[d][r] * rli[r] - lam * X[(rb * 32 + crow(r, hie)) * 128 + d * 32 + r32e]; ss += v[d] * v[d]; }
            ss += __shfl_xor(ss, 1); ss += __shfl_xor(ss, 2); ss += __shfl_xor(ss, 4); ss += __shfl_xor(ss, 8); ss += __shfl_xor(ss, 16);
            const float rn = 1.0f / sqrtf(ss * (1.0f / 128.0f) + EPS);
            bf16_t* op = O + (rowbase + q0 + crow(r, hie)) * DM + h * 128 + r32e;
#pragma unroll
            for (int d = 0; d < 4; ++d) op[d * 32] = (bf16_t)(cvt_pk_bf16(v[d] * rn * gsub[d], 0.f) & 0xffffu);
        }
    }
    ATT_WAIT_BAR();
}
__device__ __forceinline__ void attn0_phase(LAS unsigned char* lds, const int wave, unsigned char* ws, const float* subln, bool dry) {
    const int G = gridDim.x, bx = blockIdx.x;
    const bf16_t* Q = (const bf16_t*)(ws + WS_Q); const bf16_t* K = (const bf16_t*)(ws + WS_K); const bf16_t* V = (const bf16_t*)(ws + WS_V);
    const float lam = *(const float*)(ws + WS_MISC);
    for (int vb = bx; vb < 256; vb += G) {
        const int x = vb & 7, j = vb >> 3;
#pragma unroll 1
        for (int i = 0; i < 4; ++i) {
            const int r = i >> 1, jj = (j + 16 * r) & 31, qb = (i & 1) ? 63 - jj : jj, bh = 2 * x + r;
#if defined(PROBE_ATT0_VAR)
            if (dry) attn0_unit<PROBE_ATT0_VAR>(lds, wave, bh >> 3, bh & 7, qb, Q, K, V, (bf16_t*)(ws + WS_Q), lam, subln, 0.8f, dry); else
#endif
            attn0_unit<0>(lds, wave, bh >> 3, bh & 7, qb, Q, K, V, (bf16_t*)(ws + WS_Q), lam, subln, 0.8f, dry);
        }
    }
}

constexpr int A1_STAGE = 16384;
constexpr int A1_MASK = ATT_NST * A1_STAGE;
template <int VAR = 0> __device__ __forceinline__ void attn1_unit(LAS unsigned char* lds, const int wave, int b, int h, int qb, const bf16_t* Q, const bf16_t* __restrict__ K, const bf16_t* __restrict__ V, bf16_t* O,
                                           const unsigned long long* __restrict__ MASK, bool dry) {
    const int lane = fresh_lane(), r32 = lane & 31, hi = lane >> 5;
    const size_t rowbase = (size_t)b * SEQ;
    const int q0 = qb * 256 + wave * 32;
    const int NT = 4 * qb + 4;
    const int mylast = 4 * qb + (wave >> 1);
    const int krow = 8 * wave + (lane >> 3);
    const bf16_t* ksrc = K + (rowbase + krow) * DM + h * 64 + att_k_src_chunk(krow, lane & 7) * 8;
    const bf16_t* vsrc = V + (rowbase + krow) * DM + h * 64 + ((lane & 7) ^ (((krow >> 1) & 1) << 2)) * 8;
    const unsigned ldsb = (unsigned)(unsigned long long)lds;
    const unsigned long long* mrow = MASK + (size_t)b * 128 * SEQ + q0;
#define A1_ISSUE(t, st) do { const unsigned sb_ = (unsigned)__builtin_amdgcn_readfirstlane(ldsb + (st) * A1_STAGE); const size_t go_ = (size_t)(t) * 64 * DM; \
        glds16(ksrc + go_, sb_ + wave * 1024); glds16(vsrc + go_, sb_ + 8192 + wave * 1024); \
        glds4((const unsigned*)(mrow + (size_t)(t) * SEQ) + lane, (unsigned)__builtin_amdgcn_readfirstlane(ldsb + A1_MASK + ((st) * NWAVES + wave) * 256)); } while (0)
    bf16x8 qr[4];
    { const bf16_t* Qw = Q + (rowbase + q0) * DM + h * 64;
#pragma unroll
      for (int d0 = 0; d0 < 4; ++d0) qr[d0] = *(const bf16x8*)(Qw + (size_t)r32 * DM + d0 * 16 + hi * 8); }
    A1_ISSUE(0, 0); A1_ISSUE(1, 1);
    f32x16 o[2]; o[0] = (f32x16){}; o[1] = (f32x16){};
    f32x16 ol = (f32x16){};
    float l = 0.f;
    int koff[4], vboff[2];
    { const int sw = (r32 >> 1) & 7, q4 = (lane & 15) >> 2, vbase = (4 * hi + q4) * 128 + ((lane >> 4) & 1) * 32 + (lane & 3) * 8;
#pragma unroll
      for (int d = 0; d < 4; ++d) koff[d] = r32 * 128 + (((2 * d + hi) ^ sw) << 4);
#pragma unroll
      for (int d = 0; d < 2; ++d) vboff[d] = vbase + ((d ^ ((q4 >> 1) & 1)) << 6); }
    bf16x8 pa[4]; pa[0] = (bf16x8){}; pa[1] = (bf16x8){}; pa[2] = (bf16x8){}; pa[3] = (bf16x8){};
    int sk = 0, sv = 3;
    if (wave >= 4) __builtin_amdgcn_s_setprio(1);
    for (int t = 0; t <= NT; ++t) {
        if (VAR & 32) { asm volatile("s_waitcnt vmcnt(0) lgkmcnt(0)" ::: "memory"); } else
        if (t + 1 < NT) ATT_WAIT_BAR_N(3); else ATT_WAIT_BAR();
        if (!(VAR & 64)) if (t + 2 < NT) A1_ISSUE(t + 2, ((sk + 2) & 3));
        const unsigned long long mw = *(const LAS unsigned long long*)(lds + A1_MASK + (sk * NWAVES + wave) * 256 + r32 * 8);
        const unsigned mlo = (unsigned)mw >> (4 * hi), mhi = (unsigned)(mw >> 32) >> (4 * hi);
        if (t <= mylast + 1) {
            const LAS unsigned char* Kslot = lds + sk * A1_STAGE;
            const LAS unsigned char* Vslot = lds + (t == 0 ? 0 : sv) * A1_STAGE + 8192;
            att_step<2, true, VAR>(o, ol, pa, l, Kslot, Vslot, koff, vboff, qr, mlo, mhi, t <= mylast);
        }
        sv = sk; sk = (sk + 1) & 3;
    }
#undef A1_ISSUE
    __builtin_amdgcn_s_setprio(0);
    if (dry) asm volatile("" :: "v"(o[0]), "v"(o[1]), "v"(ol));
    const int lane_e = fresh_lane(), r32e = lane_e & 31, hie = lane_e >> 5;
    if (!dry)
#pragma unroll
    for (int r = 0; r < 16; ++r) {
        const float rl = 1.0f / ol[r];
        bf16_t* op = O + (rowbase + q0 + crow(r, hie)) * DM + h * 64 + r32e;
        op[0] = (bf16_t)(cvt_pk_bf16(o[0][r] * rl, 0.f) & 0xffffu); op[32] = (bf16_t)(cvt_pk_bf16(o[1][r] * rl, 0.f) & 0xffffu);
    }
    (void)l;
    ATT_WAIT_BAR();
}
__device__ __forceinline__ void attn1_phase(LAS unsigned char* lds, const int wave, unsigned char* ws, bool dry) {
    const int G = gridDim.x, bx = blockIdx.x;
    const bf16_t* Q = (const bf16_t*)(ws + WS_Q); const bf16_t* K = (const bf16_t*)(ws + WS_K); const bf16_t* V = (const bf16_t*)(ws + WS_V);
    for (int vb = bx; vb < 256; vb += G) {
        const int x = vb & 7, j = vb >> 3;
#pragma unroll 1
        for (int i = 0; i < 4; ++i) {
            const int jj = (j + 16 * (i >> 1)) & 31, qb = (i & 1) ? 31 - jj : jj, bh = 4 * x + i;
#if defined(PROBE_ATT1_VAR)
            if (dry) attn1_unit<PROBE_ATT1_VAR>(lds, wave, bh >> 4, bh & 15, qb, Q, K, V, (bf16_t*)(ws + WS_Q), (const unsigned long long*)(ws + WS_MASK), dry); else
#endif
            attn1_unit<0>(lds, wave, bh >> 4, bh & 15, qb, Q, K, V, (bf16_t*)(ws + WS_Q), (const unsigned long long*)(ws + WS_MASK), dry);
        }
    }
}
constexpr int IX_NB = 512, IX_HSTR = 513, IX_CAP = 320, IX_BSTR = 257;
constexpr int IX_HIST = 0, IX_CK = 0, IX_CI = 32 * IX_CAP * 4, IX_BM = 66560, IX_META = IX_BM + 32 * IX_BSTR * 4 + 128;
static_assert(IX_CI + 32 * IX_CAP * 2 <= IX_BM && 32 * IX_HSTR * 4 <= IX_BM && IX_META + 512 <= RING_BYTES, "indexer LDS map");

__device__ __forceinline__ void ix_abs_fma(f32x16& sc, const f32x16& d, float ah) {
#pragma unroll
    for (int r = 0; r < 16; ++r) { float t = sc[r]; asm("v_fma_f32 %0, %1, |%2|, %0" : "+v"(t) : "v"(ah), "v"(d[r])); sc[r] = t; }
}
__device__ __forceinline__ void ix_scores(f32x16& sc, const bf16x8 (&kf)[4], const bf16x8 (&qf)[8][4], const bf16x8 (&qc)[4], const float (&ah)[8]) {
    sc = (f32x16){};
#pragma unroll
    for (int s = 0; s < 4; ++s) sc = __builtin_amdgcn_mfma_f32_32x32x16_bf16(kf[s], qc[s], sc, 0, 0, 0);
    f32x16 d0 = (f32x16){}, d1;
#pragma unroll
    for (int s = 0; s < 4; ++s) d0 = __builtin_amdgcn_mfma_f32_32x32x16_bf16(kf[s], qf[0][s], d0, 0, 0, 0);
    asm volatile("" : "+v"(sc), "+v"(d0));
    __builtin_amdgcn_sched_barrier(0);
#pragma unroll
    for (int h = 0; h < 8; h += 2) {
        d1 = (f32x16){};
#pragma unroll
        for (int s = 0; s < 4; ++s) d1 = __builtin_amdgcn_mfma_f32_32x32x16_bf16(kf[s], qf[h + 1][s], d1, 0, 0, 0);
        asm volatile("" : "+v"(d1), "+v"(d0), "+v"(sc));
        __builtin_amdgcn_sched_barrier(0);
        ix_abs_fma(sc, d0, ah[h]);
        asm volatile("" : "+v"(sc));
        __builtin_amdgcn_sched_barrier(0);
        if (h + 2 < 8) {
            d0 = (f32x16){};
#pragma unroll
            for (int s = 0; s < 4; ++s) d0 = __builtin_amdgcn_mfma_f32_32x32x16_bf16(kf[s], qf[h + 2][s], d0, 0, 0, 0);
            asm volatile("" : "+v"(d0), "+v"(d1), "+v"(sc));
        } else {
            asm volatile("s_nop 15\n\ts_nop 3" : "+v"(d1), "+v"(sc));
        }
        __builtin_amdgcn_sched_barrier(0);
        ix_abs_fma(sc, d1, ah[h + 1]);
        asm volatile("" : "+v"(sc));
        __builtin_amdgcn_sched_barrier(0);
    }
}
__device__ __forceinline__ void ix_combine(bf16x8 (&qc)[4], const bf16x8 (&qf)[8][4], const float (&ah)[8]) {
#pragma unroll
    for (int s = 0; s < 4; ++s) {
        float acc[8];
#pragma unroll
        for (int j = 0; j < 8; ++j) acc[j] = 0.f;
#pragma unroll
        for (int h = 0; h < 8; ++h)
#pragma unroll
            for (int j = 0; j < 8; ++j) acc[j] = __builtin_fmaf(ah[h], __uint_as_float((unsigned)(unsigned short)qf[h][s][j] << 16), acc[j]);
        u32x4 w; w.x = cvt_pk_bf16(acc[0], acc[1]); w.y = cvt_pk_bf16(acc[2], acc[3]); w.z = cvt_pk_bf16(acc[4], acc[5]); w.w = cvt_pk_bf16(acc[6], acc[7]);
        qc[s] = __builtin_bit_cast(bf16x8, w);
    }
}
__device__ __forceinline__ int ix_bin(float sc, float Rs, float scale) {
    const int b = (int)__builtin_fmaf(sc, scale, Rs);
    return b < 0 ? 0 : (b > IX_NB - 1 ? IX_NB - 1 : b);
}
__device__ __forceinline__ void ix_loadk(bf16x8 (&kf)[4], const bf16_t* KIb, int kt, int r32, int hi) {
    const int l_ = fresh_lane();
    const bf16_t* p = KIb + (size_t)(unsigned)((kt * 32 + (l_ & 31)) * 64 + (l_ >> 5) * 8);
#pragma unroll
    for (int s = 0; s < 4; ++s) kf[s] = *(const bf16x8*)(p + s * 16);
}

__device__ __forceinline__ void idx_unit(LAS unsigned char* lds, const int wave, unsigned char* ws, int b, int qt, const int dry) {
    const int lane = fresh_lane(), r32 = lane & 31, hi = lane >> 5, tid = wave * 64 + lane;
    const int chunk = qt >> 1;
    const size_t tok0 = (size_t)b * SEQ + (size_t)qt * 32;
    unsigned* MASK32 = (unsigned*)(ws + WS_MASK);
    if (chunk < 4) {
        if (!dry) for (int t = wave; t <= chunk; t += 8) MASK32[((size_t)(b * 128 + t) * SEQ + qt * 32 + r32) * 2 + hi] = 0xFFFFFFFFu;
        return;
    }
    const bf16_t* KIb = (const bf16_t*)(ws + WS_KI) + (size_t)b * SEQ * 64;
    LAS unsigned* HIST = (LAS unsigned*)(lds + IX_HIST);
    LAS float* CK = (LAS float*)(lds + IX_CK);
    LAS unsigned short* CI = (LAS unsigned short*)(lds + IX_CI);
    LAS unsigned* BM = (LAS unsigned*)(lds + IX_BM);
    LAS int* META = (LAS int*)(lds + IX_META);
#define IX_LOADQ(qf) do { const int l_ = fresh_lane(); const bf16_t* qp_ = (const bf16_t*)(ws + WS_QI) + tok0 * 512 + (unsigned)((l_ & 31) * 512 + (l_ >> 5) * 8); \
        _Pragma("unroll") for (int h = 0; h < 8; ++h) _Pragma("unroll") for (int s = 0; s < 4; ++s) qf[h][s] = *(const bf16x8*)(qp_ + h * 64 + s * 16); } while (0)
    float a[8]; float R;
    { const float* np = (const float*)(ws + WS_QIN) + (tok0 + r32) * 8;
      const f32x4 n0 = *(const f32x4*)np, n1 = *(const f32x4*)(np + 4);
#pragma unroll
      for (int h = 0; h < 4; ++h) { a[h] = 0.5f * n0[h]; a[4 + h] = 0.5f * n1[h]; }
      R = (((fabsf(n0[0]) + fabsf(n0[1])) + (fabsf(n0[2]) + fabsf(n0[3]))) + ((fabsf(n1[0]) + fabsf(n1[1])) + (fabsf(n1[2]) + fabsf(n1[3])))) * 1.03f;
      R = fmaxf(R, 1e-30f); }
    const float scale = (float)(IX_NB / 2) / R, Rs = (float)(IX_NB / 2);
    const int nkt = 2 * (chunk + 1);
    for (int i = tid; i < 32 * IX_HSTR; i += NWAVES * 64) HIST[i] = 0u;
    for (int i = tid; i < 32 * IX_BSTR; i += NWAVES * 64) BM[i] = 0u;
    if (tid < 128) META[tid] = 0;
    LDS_WAIT(); __builtin_amdgcn_s_barrier(); asm volatile("" ::: "memory");
    {
        bf16x8 qf[8][4]; IX_LOADQ(qf);
        bf16x8 qc[4]; ix_combine(qc, qf, a);
        bf16x8 kf[4], kn[4];
        if (wave < nkt) ix_loadk(kf, KIb, wave, r32, hi);
#pragma unroll 1
        for (int kt = wave; kt < nkt; kt += 8) {
            if (kt + 8 < nkt) ix_loadk(kn, KIb, kt + 8, r32, hi);
            f32x16 sc;
            ix_scores(sc, kf, qf, qc, a);
#pragma unroll
            for (int r = 0; r < 16; ++r) {
                const int bin = ix_bin(sc[r], Rs, scale);
                __hip_atomic_fetch_add(HIST + r32 * IX_HSTR + bin, 1u, __ATOMIC_RELAXED, __HIP_MEMORY_SCOPE_WORKGROUP);
            }
#pragma unroll
            for (int s = 0; s < 4; ++s) kf[s] = kn[s];
        }
    }
    LDS_WAIT(); __builtin_amdgcn_s_barrier(); asm volatile("" ::: "memory");
#pragma unroll 1
    for (int i = 0; i < 4; ++i) {
        const int q = wave * 4 + i;
        int lane8 = 8 * lane; asm volatile("" : "+v"(lane8));
        unsigned wv[8]; unsigned c = 0;
#pragma unroll
        for (int w = 0; w < 8; ++w) { wv[w] = HIST[q * IX_HSTR + lane8 + w]; c += wv[w]; }
        unsigned x = c;
#pragma unroll
        for (int off = 1; off < 64; off <<= 1) { const unsigned y = __shfl_down(x, off); if (lane + off < 64) x += y; }
        const unsigned sx = x - c;
        if (sx < 256u && x >= 256u) {
            unsigned cum = sx; int found = 0, tb = 0, kr = 0, tc = 0;
#pragma unroll
            for (int w = 7; w >= 0; --w) {
                if (!found) { if (cum + wv[w] >= 256u) { found = 1; tb = lane8 + w; kr = 256 - (int)cum; tc = (int)wv[w]; } else cum += wv[w]; }
            }
            META[q] = tb; META[32 + q] = kr; META[64 + q] = tc;
        }
    }
    LDS_WAIT(); __builtin_amdgcn_s_barrier(); asm volatile("" ::: "memory");
    if (dry == 1) return;
    {
        const int tb = META[r32];
        const float fl = (tb <= 0) ? -__builtin_inff() : (float)tb, fh = (tb >= IX_NB - 1) ? __builtin_inff() : (float)(tb + 1);
        bf16x8 qf[8][4]; IX_LOADQ(qf);
        bf16x8 qc[4]; ix_combine(qc, qf, a);
        bf16x8 kf[4], kn[4];
        if (wave < nkt) ix_loadk(kf, KIb, wave, r32, hi);
#pragma unroll 1
        for (int kt = wave; kt < nkt; kt += 8) {
            if (kt + 8 < nkt) ix_loadk(kn, KIb, kt + 8, r32, hi);
            f32x16 sc;
            ix_scores(sc, kf, qf, qc, a);
            unsigned sb = 0u, cb = 0u;
#pragma unroll
            for (int r = 15; r >= 1; r -= 2) {
                const float f1 = __builtin_fmaf(sc[r], scale, Rs), f0 = __builtin_fmaf(sc[r - 1], scale, Rs);
                unsigned long long t0, t1, t2, t3;
                asm("v_cmp_ge_f32_e64 %2, %6, %8\n\tv_cmp_ge_f32_e64 %3, %7, %8\n\tv_cmp_ge_f32_e64 %4, %6, %9\n\tv_cmp_ge_f32_e64 %5, %7, %9\n\t"
                    "v_addc_co_u32_e64 %0, vcc, %0, %0, %2\n\tv_addc_co_u32_e64 %0, vcc, %0, %0, %3\n\tv_addc_co_u32_e64 %1, vcc, %1, %1, %4\n\tv_addc_co_u32_e64 %1, vcc, %1, %1, %5"
                    : "+v"(sb), "+v"(cb), "=&s"(t0), "=&s"(t1), "=&s"(t2), "=&s"(t3) : "v"(f1), "v"(f0), "v"(fh), "v"(fl) : "vcc");
            }
            const unsigned cbits = cb & ~sb;
            if (__ballot(cbits != 0u)) {
                int base = 0;
                if (cbits) base = __hip_atomic_fetch_add(META + 96 + r32, __popc(cbits), __ATOMIC_RELAXED, __HIP_MEMORY_SCOPE_WORKGROUP);
#pragma unroll
                for (int r = 0; r < 16; ++r) {
                    const bool c = (cbits >> r) & 1u;
                    if (__ballot(c)) {
                        if (c) { if (base < IX_CAP) { CK[r32 * IX_CAP + base] = sc[r]; CI[r32 * IX_CAP + base] = (unsigned short)(kt * 32 + (r & 3) + 8 * (r >> 2) + 4 * hi); } ++base; }
                    }
                }
            }
            unsigned bits = (sb & 0xFu) | ((sb & 0xF0u) << 4) | ((sb & 0xF00u) << 8) | ((sb & 0xF000u) << 12);
            bits <<= 4 * hi;
            bits |= __shfl_xor(bits, 32);
            if (hi == 0) BM[r32 * IX_BSTR + kt] = bits;
#pragma unroll
            for (int s = 0; s < 4; ++s) kf[s] = kn[s];
        }
    }
    LDS_WAIT(); __builtin_amdgcn_s_barrier(); asm volatile("" ::: "memory");
    if (dry == 2) return;
    {
        const int q0 = wave * 4;
        unsigned key[4][5]; int kr[4], cq[4]; unsigned prefix[4];
        int maxc = 0; unsigned dmax = 0u;
#pragma unroll
        for (int i = 0; i < 4; ++i) {
            int c = META[96 + q0 + i]; c = c > IX_CAP ? IX_CAP : c; cq[i] = c; maxc = c > maxc ? c : maxc;
            kr[i] = META[32 + q0 + i];
            unsigned orv = 0u, andv = 0xFFFFFFFFu;
#pragma unroll
            for (int sl = 0; sl < 5; ++sl) {
                const int e = lane + 64 * sl; const bool v = e < c;
                const unsigned u = v ? __float_as_uint(CK[(q0 + i) * IX_CAP + e]) : 0u;
                const unsigned k = (u & 0x80000000u) ? ~u : (u | 0x80000000u);
                key[i][sl] = v ? k : 0u; orv |= key[i][sl]; andv &= v ? k : 0xFFFFFFFFu;
            }
#pragma unroll
            for (int o = 1; o < 64; o <<= 1) { orv |= (unsigned)__shfl_xor((int)orv, o); andv &= (unsigned)__shfl_xor((int)andv, o); }
            const unsigned diff = orv ^ andv;
            const unsigned low = diff ? (0xFFFFFFFFu >> __builtin_clz(diff)) : 0u;
            prefix[i] = (c > 0) ? (andv & ~low) : 0u; dmax |= diff;
        }
        maxc = __builtin_amdgcn_readfirstlane(maxc); dmax = __builtin_amdgcn_readfirstlane(dmax);
        const int nsl = (maxc + 63) >> 6;
#pragma unroll 1
        for (int bit = dmax ? 31 - __builtin_clz(dmax) : -1; bit >= 0; --bit) {
            int cnt[4] = {0, 0, 0, 0};
#pragma unroll
            for (int sl = 0; sl < 5; ++sl) if (sl < nsl) {
#pragma unroll
                for (int i = 0; i < 4; ++i) cnt[i] += __popcll(__ballot(key[i][sl] >= (prefix[i] | (1u << bit))));
            }
#pragma unroll
            for (int i = 0; i < 4; ++i) prefix[i] = (cnt[i] >= kr[i]) ? (prefix[i] | (1u << bit)) : prefix[i];
        }
#pragma unroll
        for (int i = 0; i < 4; ++i) {
            const int q = q0 + i;
            int cgt = 0, ceq = 0;
#pragma unroll
            for (int sl = 0; sl < 5; ++sl) if (sl < nsl) { const bool v = lane + 64 * sl < cq[i];
                cgt += __popcll(__ballot(v && key[i][sl] > prefix[i])); ceq += __popcll(__ballot(v && key[i][sl] == prefix[i])); }
            const int need = kr[i] - cgt;
            int idx[5];
#pragma unroll
            for (int sl = 0; sl < 5; ++sl) { const int e = lane + 64 * sl; idx[sl] = (e < cq[i]) ? (int)CI[q * IX_CAP + e] : 0x7fffffff; }
            int ithr = 0x7fffffff;
            if (need < ceq) {
                int pre = 0;
#pragma unroll 1
                for (int bit = 12; bit >= 0; --bit) {
                    const int trial = pre | (1 << bit); int cnt = 0;
#pragma unroll
                    for (int sl = 0; sl < 5; ++sl) cnt += __popcll(__ballot(lane + 64 * sl < cq[i] && key[i][sl] == prefix[i] && idx[sl] < trial));
                    if (cnt < need) pre = trial;
                }
                ithr = pre;
            }
#pragma unroll
            for (int sl = 0; sl < 5; ++sl)
                if (lane + 64 * sl < cq[i] && (key[i][sl] > prefix[i] || (key[i][sl] == prefix[i] && idx[sl] <= ithr)))
                    __hip_atomic_fetch_or(BM + q * IX_BSTR + (idx[sl] >> 5), 1u << (idx[sl] & 31), __ATOMIC_RELAXED, __HIP_MEMORY_SCOPE_WORKGROUP);
        }
    }
    LDS_WAIT(); __builtin_amdgcn_s_barrier(); asm volatile("" ::: "memory");
#undef IX_LOADQ
    if (dry) return;
    for (int t = wave; t <= chunk; t += 8) MASK32[((size_t)(b * 128 + t) * SEQ + qt * 32 + r32) * 2 + hi] = BM[r32 * IX_BSTR + 2 * t + hi];
    LDS_WAIT(); __builtin_amdgcn_s_barrier(); asm volatile("" ::: "memory");
}
__device__ __forceinline__ void idx_phase(LAS unsigned char* lds, const int wave, unsigned char* ws) {
    for (int v = blockIdx.x; v < 256; v += gridDim.x) {
        const int b = v >> 7, j = v & 127;
#if defined(PROBE_IDX_DRY)
#pragma unroll 1
        for (int u = 0; u < 6; ++u) idx_unit(lds, wave, ws, b, (u & 1) ? 255 - j : j, u < 2 ? 0 : PROBE_IDX_DRY);
#else
#pragma unroll 1
        for (int u = 0; u < 2; ++u) idx_unit(lds, wave, ws, b, u ? 255 - j : j, 0);
#endif
    }
}
struct Args { const float* in[22]; float* out; unsigned char* ws; int ph_lo, ph_hi, coop, pad; };
enum Phase { P_PRO = 0, P_IN0, P_ATT0, P_OUT0, P_UP0, P_DN0, P_IN1, P_QUP, P_IDX, P_ATT1, P_OUT1, P_UP1, P_DN1, P_N, P_BRIDGE = 20 };

constexpr int CTL_ZERO_WORDS = 6144, CTL_FLAG = 8192; constexpr unsigned CTL_READY = 0x600DF1A6u;
constexpr int CTL_ROWCNT = 4096;
struct In1Order : pg8::StaticOrder {
    unsigned* cnt; int wave;
    __device__ __forceinline__ bool next(int i, pg8::Unit& u) const { if (!pg8::StaticOrder::next(i, u)) return false; u.pn = (u.pn == 1) ? 9 : (u.pn == 9) ? 1 : u.pn; return true; }
    __device__ __forceinline__ void a_ready(const pg8::Unit&) const {}
    __device__ __forceinline__ void done(const pg8::Unit& u) const {
        if (u.pn == 0 || u.pn == 9) {
            asm volatile("s_waitcnt vmcnt(0)" ::: "memory");
            __builtin_amdgcn_s_barrier();
            if (wave == 0) {
                __builtin_amdgcn_fence(__ATOMIC_RELEASE, "agent");
                asm volatile("s_waitcnt vmcnt(0)" ::: "memory");
                if (fresh_lane() == 0) (void)xb_add(&cnt[u.pm * 16], 8u);
            }
        }
    }
};
__device__ __forceinline__ void qup_wait_rows(const pg8::StaticOrder& S, unsigned* cnt, unsigned* tmo, const unsigned need = 16u) {
#pragma unroll 1
    for (int i = 0; ; ++i) {
        pg8::Unit u; if (!S.next(i, u)) break;
        unsigned sp = 0;
        while (xb_ld(&cnt[u.pm * 16]) < need) { __builtin_amdgcn_s_sleep(1); if ((++sp & 255u) == 0u) { if (xb_ld(tmo)) break; if (sp > XB_SPIN_CAP) { atomicAdd(tmo, 1u); break; } } }
    }
    __builtin_amdgcn_fence(__ATOMIC_ACQUIRE, "agent");
}
template <class Epi> __device__ __forceinline__ void run_gemm(LAS unsigned char* lds, const int wave, const bf16_t* A, const bf16_t* Bt, int N, int K, const Epi& E) {
    pg8::Gemm g{A, Bt, TOK, N, K}; pg8::StaticOrder S; S.init(TOK, N, (int)gridDim.x, (int)blockIdx.x);
    pg8::gemm_phase<Epi, pg8::StaticOrder, true, true>(lds, g, S, E, wave, fresh_lane());
}
__global__ void __launch_bounds__(NWAVES * 64, 2) mk_fwd(Args args) {
    extern __shared__ __attribute__((aligned(16))) unsigned char lds_raw[];
    LAS unsigned char* lds = (LAS unsigned char*)lds_raw;
    const int wave = __builtin_amdgcn_readfirstlane(threadIdx.x >> 6);
    const int G = gridDim.x;
    unsigned char* ws = args.ws;
    const int lo = args.ph_lo, hi = args.ph_hi;
    volatile LAS unsigned* MISC = (volatile LAS unsigned*)(lds + MISC_OFF);
    { const int tid = wave * 64 + fresh_lane(); for (int u = tid; u < (LDS_BYTES - RING_BYTES) / 4; u += NWAVES * 64) ((LAS unsigned*)(lds + RING_BYTES))[u] = 0u; }
    __syncthreads();
    XcdBarrier bar; bar.bar = (unsigned*)(ws + WS_CTL); bar.x = 0; bar.st = nullptr;
    if (args.coop) {
        unsigned* CTL = (unsigned*)(ws + WS_CTL);
        if (blockIdx.x == 0) {
            for (int i = wave * 64 + fresh_lane(); i < CTL_ZERO_WORDS; i += NWAVES * 64) CTL[i] = 0u;
            asm volatile("s_waitcnt vmcnt(0)" ::: "memory");
            __syncthreads();
            if (threadIdx.x == 0) { __builtin_amdgcn_fence(__ATOMIC_RELEASE, "agent"); __hip_atomic_store(&CTL[CTL_FLAG], CTL_READY, __ATOMIC_RELAXED, __HIP_MEMORY_SCOPE_AGENT); }
        }
        if (threadIdx.x == 0) {
            unsigned sp = 0u;
            while (xb_ld(&CTL[CTL_FLAG]) != CTL_READY && ++sp < (1u << 22)) __builtin_amdgcn_s_sleep(1);
            __builtin_amdgcn_fence(__ATOMIC_ACQUIRE, "agent");
        }
        bar = xcd_barrier_post(CTL, MISC + 8);
    }
#define IN(k) (lo <= (k) && (k) < hi)
#define NREP(k) ((PROBE_PHASE == (k)) ? 3 : 1)
#define SEAM(k) do { if (args.coop && IN(k) && IN((k) + 1)) xcd_barrier(bar, wave); } while (0)
    LAS float* ETBL = (LAS float*)(lds + EPI_TBL_OFF + wave * 512);
    bf16_t* XB = (bf16_t*)(ws + WS_XB); bf16_t* QB = (bf16_t*)(ws + WS_Q); bf16_t* KB = (bf16_t*)(ws + WS_K); bf16_t* VB = (bf16_t*)(ws + WS_V); bf16_t* UB = (bf16_t*)(ws + WS_U);
    float* PART = (float*)(ws + WS_PART); float* CS = (float*)(ws + WS_CS); float* LAM = (float*)(ws + WS_MISC);

    if (IN(P_PRO)) for (int rep_ = 0; rep_ < NREP(P_PRO); ++rep_) {
        const int lane = fresh_lane(), tid = wave * 64 + lane;
        LAS float* scr = (LAS float*)(lds + wave * 16384);
        const int gw = blockIdx.x * NWAVES + wave, NGW = G * NWAVES;
        const float* nmix = args.in[2]; const float* nmlp = args.in[3];
        int base = 0;
#define DOJOB(W_, gain_, WT_, K_, N_, Npad_, roff_) do { const int nblk = (Npad_) / 32, nitems = ((K_) / 64) * nblk; \
            for (int it = (gw - base % NGW + NGW) % NGW; it < nitems; it += NGW) p0_transpose_item((W_), (K_), (N_), (gain_), (bf16_t*)(ws + (WT_)), (roff_), scr, it, nblk, lane); \
            base += nitems; } while (0)
        DOJOB(args.in[6], nmix, WS_WIN0, DM, 3072, 3072, 0);
        DOJOB(args.in[14], (const float*)nullptr, WS_WOUT0, DM, DM, DM, 0);
        DOJOB(args.in[4], nmlp, WS_W1_0, DM, DFF, DFF, 0);
        DOJOB(args.in[5], (const float*)nullptr, WS_W2_0, DFF, DM, DM, 0);
        DOJOB(args.in[15], nmix + DM, WS_WIN1, DM, NIN1, NIN1P, 0);
        DOJOB(args.in[17], args.in[16], WS_WUQ, 256, DM, DM, 0);
        DOJOB(args.in[18], args.in[16], WS_WUQ, 256, 512, 512, 1024);
        DOJOB(args.in[21], (const float*)nullptr, WS_WOUT1, DM, DM, DM, 0);
        DOJOB(args.in[4] + (size_t)DM * DFF, nmlp + DM, WS_W1_1, DM, DFF, DFF, 0);
        DOJOB(args.in[5] + (size_t)DM * DFF, (const float*)nullptr, WS_W2_1, DFF, DM, DM, 0);
#undef DOJOB
        if (TOK % (4 * NGW) == 0) { for (int m = gw; m < TOK; m += 4 * NGW) rows_to_bf16<4>(args.in[0], XB, PART, m, NGW, lane); }
        else { for (int m = gw; m < TOK; m += NGW) rows_to_bf16<1>(args.in[0], XB, PART, m, NGW, lane); }
        const int* pos = (const int*)args.in[1];
        for (int t = blockIdx.x * (NWAVES * 64) + tid; t < TOK * 8; t += G * NWAVES * 64) {
            const int tok = t >> 3, i = t & 7;
            const float inv = (float)pow(500000.0, -(double)i / 8.0);
            const float ang = (float)pos[tok] * inv;
            CS[tok * 16 + i] = (float)cos((double)ang); CS[tok * 16 + 8 + i] = (float)sin((double)ang);
        }
        if (blockIdx.x == 0 && tid == 0) {
            float s1 = 0.f, s2 = 0.f;
            for (int i = 0; i < 64; ++i) { s1 += args.in[9][i] * args.in[10][i]; s2 += args.in[11][i] * args.in[12][i]; }
            LAM[0] = expf(s1) - expf(s2) + 0.2f;
        }
    }
    SEAM(P_PRO);
    if (IN(P_BRIDGE)) {
        const int lane = fresh_lane();
        const int gw = blockIdx.x * NWAVES + wave, NGW = G * NWAVES;
        for (int m = gw; m < TOK; m += NGW) rows_to_bf16<1>(args.out, XB, PART, m, NGW, lane);
    }
    if (IN(P_IN0)) { for (int rep_ = 0; rep_ < NREP(P_IN0); ++rep_) { EpiQKV0 E{PART, CS, args.in[7], args.in[8], QB, (size_t)(WS_K - WS_Q) / 2, 0.125f * LOG2E, ETBL}; run_gemm(lds, wave, XB, (const bf16_t*)(ws + WS_WIN0), 3072, DM, E); } }
    SEAM(P_IN0);
    if (IN(P_ATT0)) { for (int rep_ = NREP(P_ATT0) - 1; rep_ >= 0; --rep_) attn0_phase(lds, wave, ws, args.in[13], rep_ != 0); }
    SEAM(P_ATT0);
    if (IN(P_OUT0)) { for (int rep_ = 0; rep_ < NREP(P_OUT0); ++rep_) { EpiResidT<true, false> E{nullptr, XB, nullptr, XB, PART}; run_gemm(lds, wave, QB, (const bf16_t*)(ws + WS_WOUT0), DM, DM, E); } }
    SEAM(P_OUT0);
    if (IN(P_UP0)) { for (int rep_ = 0; rep_ < NREP(P_UP0); ++rep_) { EpiUp E{PART, UB, ETBL}; run_gemm(lds, wave, XB, (const bf16_t*)(ws + WS_W1_0), DFF, DM, E); } }
    SEAM(P_UP0);
    if (IN(P_DN0)) { EpiResidT<true, false> E{nullptr, XB, nullptr, XB, PART}; run_gemm(lds, wave, UB, (const bf16_t*)(ws + WS_W2_0), DM, DFF, E); }
    SEAM(P_DN0);
    if (IN(P_IN1)) { for (int rep_ = 0; rep_ < NREP(P_IN1); ++rep_) { EpiIn1 E{PART, CS, args.in[20], (bf16_t*)(ws + WS_CQ), (float*)(ws + WS_CQP), KB, VB, (bf16_t*)(ws + WS_KI), (float*)(ws + WS_WIDX), 0.35355339059327373f * 0.125f, ETBL};
        pg8::Gemm g{XB, (const bf16_t*)(ws + WS_WIN1), TOK, NIN1P, DM}; In1Order S; S.init(TOK, NIN1P, G, (int)blockIdx.x); S.cnt = (unsigned*)(ws + WS_CTL) + CTL_ROWCNT; S.wave = wave;
        pg8::gemm_phase<EpiIn1, In1Order, true, true>(lds, g, S, E, wave, fresh_lane()); } }
    if (IN(P_QUP)) { for (int rep_ = 0; rep_ < NREP(P_QUP); ++rep_) { EpiQup E{(const float*)(ws + WS_CQP), CS, args.in[19], (const float*)(ws + WS_WIDX), QB, (bf16_t*)(ws + WS_QI), (float*)(ws + WS_QIN), 0.125f * LOG2E, ETBL};
        const int c = (int)blockIdx.x, cm = (G % 8 == 0) ? ((c & 7) | ((G / 8 - 1 - (c >> 3)) << 3)) : c;
        pg8::Gemm g{(const bf16_t*)(ws + WS_CQ), (const bf16_t*)(ws + WS_WUQ), TOK, 1536, 256}; pg8::StaticOrder S; S.init(TOK, 1536, G, cm);
        qup_wait_rows(S, (unsigned*)(ws + WS_CTL) + CTL_ROWCNT, (unsigned*)(ws + WS_CTL) + XB_TMO);
        pg8::gemm_phase<EpiQup, pg8::StaticOrder, true, true>(lds, g, S, E, wave, fresh_lane()); } }
    SEAM(P_QUP);
    if (IN(P_IDX)) { for (int rep_ = 0; rep_ < NREP(P_IDX); ++rep_) { idx_phase(lds, wave, ws); } }
    SEAM(P_IDX);
    if (IN(P_ATT1)) { for (int rep_ = NREP(P_ATT1) - 1; rep_ >= 0; --rep_) attn1_phase(lds, wave, ws, rep_ != 0); }
    SEAM(P_ATT1);
    if (IN(P_OUT1)) { EpiResidT<true, false> E{nullptr, XB, nullptr, XB, PART}; run_gemm(lds, wave, QB, (const bf16_t*)(ws + WS_WOUT1), DM, DM, E); }
    SEAM(P_OUT1);
    if (IN(P_UP1)) { for (int rep_ = 0; rep_ < NREP(P_UP1); ++rep_) { EpiUp E{PART, UB, ETBL}; run_gemm(lds, wave, XB, (const bf16_t*)(ws + WS_W1_1), DFF, DM, E); } }
    SEAM(P_UP1);
    if (IN(P_DN1)) { EpiResidT<true, true> E{nullptr, XB, args.out, nullptr, nullptr}; run_gemm(lds, wave, UB, (const bf16_t*)(ws + WS_W2_1), DM, DFF, E); }
    if (args.coop && blockIdx.x == 0 && wave == 0 && fresh_lane() == 0) __hip_atomic_store((unsigned*)(ws + WS_CTL) + CTL_FLAG, 0u, __ATOMIC_RELAXED, __HIP_MEMORY_SCOPE_AGENT);
#undef IN
#undef SEAM
}

static int g_mk_ready = 0;
static void mk_launch(hipStream_t st, void* const* d_in, void* d_out, void* d_ws, int lo, int hi, int coop) {
    if (!g_mk_ready) { (void)hipFuncSetAttribute((const void*)mk_fwd, hipFuncAttributeMaxDynamicSharedMemorySize, LDS_BYTES); g_mk_ready = 1; }
    Args a{};
    for (int i = 0; i < 22; ++i) a.in[i] = (const float*)d_in[i];
    a.out = (float*)d_out; a.ws = (unsigned char*)d_ws; a.ph_lo = lo; a.ph_hi = hi; a.coop = coop; a.pad = 0;
    hipLaunchKernelGGL(mk_fwd, dim3(256), dim3(NWAVES * 64), LDS_BYTES, st, a);
}

extern "C" void kernel_launch(void* const* d_in, const int* in_sizes, int n_in, void* d_out, int out_size, void* d_ws, size_t ws_size, hipStream_t stream) {
    static int grid = 0;
    if (grid == 0) {
        int dev = 0, cus = 0, per_cu = 0;
        (void)hipGetDevice(&dev);
        (void)hipDeviceGetAttribute(&cus, hipDeviceAttributeMultiprocessorCount, dev);
        (void)hipFuncSetAttribute((const void*)mk_fwd, hipFuncAttributeMaxDynamicSharedMemorySize, LDS_BYTES);
        (void)hipOccupancyMaxActiveBlocksPerMultiprocessor(&per_cu, (const void*)mk_fwd, NWAVES * 64, LDS_BYTES);
        if (per_cu < 1) per_cu = 1;
        if (per_cu > 1) per_cu = 1;
        grid = cus * per_cu; if (grid > 256) grid = 256; if (grid < 1) grid = 1;
        if (ws_size < WS_END) { fprintf(stderr, "kernel_launch: workspace too small (%zu)\n", ws_size); }
    }
    Args a{};
    for (int i = 0; i < 22; ++i) a.in[i] = (const float*)d_in[i];
    a.out = (float*)d_out; a.ws = (unsigned char*)d_ws; a.ph_lo = 0; a.ph_hi = P_N; a.coop = 1; a.pad = 0;
    void* kargs[] = {&a};
    hipError_t e = hipLaunchCooperativeKernel((const void*)mk_fwd, dim3(grid), dim3(NWAVES * 64), kargs, LDS_BYTES, stream);
    if (e != hipSuccess) fprintf(stderr, "cooperative launch failed: %s (grid %d)\n", hipGetErrorString(e), grid);
}
```

```cpp
#include <hip/hip_runtime.h>
#include <stdint.h>
#include <math.h>
#include <stdio.h>
#ifndef PROBE_PHASE
#define PROBE_PHASE (-1)
#endif
#define LAS __attribute__((address_space(3)))
#define GAS __attribute__((address_space(1)))
typedef unsigned short bf16_t;
typedef short bf16x8 __attribute__((ext_vector_type(8)));
typedef float f32x4 __attribute__((ext_vector_type(4)));
typedef float f32x16 __attribute__((ext_vector_type(16)));
typedef unsigned u32x4 __attribute__((ext_vector_type(4)));
typedef unsigned u32x2 __attribute__((ext_vector_type(2)));

constexpr int BATCH = 2, SEQ = 8192, DM = 1024, DFF = 4096, TOK = BATCH * SEQ;
constexpr float EPS = 1e-6f;
constexpr float LOG2E = 1.4426950408889634f;
constexpr int NIN1 = 2376, NIN1P = 2560;
constexpr size_t MiB = 1u << 20;
constexpr size_t WS_XB = 0, WS_Q = 32 * MiB, WS_K = 64 * MiB, WS_V = 96 * MiB, WS_U = 32 * MiB;
constexpr size_t WS_CQ = 160 * MiB, WS_QI = 168 * MiB, WS_KI = 184 * MiB, WS_MASK = 186 * MiB;
constexpr size_t WS_CS = 204 * MiB, WS_MISC = 205 * MiB, WS_PART = 206 * MiB, WS_CQP = 207 * MiB, WS_WIDX = 207 * MiB + 256 * 1024;
constexpr size_t WS_QIN = WS_MISC + 512 * 1024;
constexpr size_t WS_CTL = WS_MISC + 4096;
constexpr size_t CTL_BYTES = 64 * 1024;
constexpr size_t WS_WIN0 = 208 * MiB, WS_WOUT0 = 214 * MiB, WS_W1_0 = 216 * MiB, WS_W2_0 = 224 * MiB, WS_WIN1 = 232 * MiB, WS_WUQ = 237 * MiB,
                 WS_WOUT1 = 238 * MiB, WS_W1_1 = 240 * MiB, WS_W2_1 = 248 * MiB, WS_END = 256 * MiB;

__device__ __forceinline__ unsigned cvt_pk_bf16(float lo, float hi) {
    typedef float f32x2_t __attribute__((ext_vector_type(2))); typedef __bf16 bf16x2_t __attribute__((ext_vector_type(2)));
    f32x2_t v = {lo, hi}; bf16x2_t b = __builtin_convertvector(v, bf16x2_t); return __builtin_bit_cast(unsigned, b);
}
__host__ __device__ __forceinline__ int tile_pos(int cl) { const int wc = cl >> 6, fq = (cl >> 4) & 3, bj = (cl >> 3) & 1, n = (cl >> 2) & 1, j = cl & 3; return 128 * bj + 32 * wc + 16 * n + 4 * fq + j; }
__device__ __forceinline__ int fresh_lane() { int l; asm volatile("v_mbcnt_lo_u32_b32 %0, -1, 0\n\tv_mbcnt_hi_u32_b32 %0, -1, %0" : "=v"(l)); return l; }
__device__ __forceinline__ float wave_sum(float v) {
#pragma unroll
    for (int o = 1; o < 64; o <<= 1) v += __shfl_xor(v, o);
    return v;
}
namespace pg8 {
#define PG8_LAS __attribute__((address_space(3)))
typedef unsigned short bf16_t;
typedef short bf16x8 __attribute__((ext_vector_type(8)));
typedef float f32x4 __attribute__((ext_vector_type(4)));
typedef unsigned u32x4 __attribute__((ext_vector_type(4)));
constexpr int BM = 256, BK = 64, HALF = 128, HTB = HALF * BK * 2  , STAGE_BYTES = 8 * HTB, NXCD = 8, WGM = 8;

__host__ __device__ __forceinline__ int lds_byte(int r, int c) { const int st = (r >> 4) * 2 + (c >> 5), rr = r & 15, cc = c & 31, ob = rr * 64 + cc * 2; return st * 1024 + (ob ^ (((ob >> 9) & 1) << 5)); }
__host__ __device__ __forceinline__ void stage_rc(int b, int& R, int& C) { const int st = b / 1024, sb = b % 1024, swz = sb ^ (((sb >> 9) & 1) << 5); R = (st >> 1) * 16 + swz / 64; C = (st & 1) * 32 + (swz % 64) / 2; }
__host__ __device__ __forceinline__ int perm32(int rho) { const int n = rho >> 4, i = rho & 15; return 8 * (i >> 2) + 4 * n + (i & 3); }

struct Unit { int pm, pn; };
struct Gemm { const bf16_t* A; const bf16_t* Bt; int M, N, K; };

struct StaticOrder {
    int nM, nN, nwg, G, c;
    __host__ __device__ void init(int M, int N, int G_, int c_) { nM = M / BM; nN = N / BM; nwg = nM * nN; G = G_; c = c_; }
    __host__ __device__ bool next(int i, Unit& u) const {
        const long L = (long)i * G + c; if (L >= nwg) return false;
        int wgid = (int)L; { const int q = nwg / NXCD, r = nwg % NXCD, xcd = wgid % NXCD, off = wgid / NXCD; wgid = (xcd < r ? xcd * (q + 1) : r * (q + 1) + (xcd - r) * q) + off; }
        const int nig = WGM * nN, gid = wgid / nig, fm = gid * WGM, gsz = (nM - fm) < WGM ? (nM - fm) : WGM;
        u.pm = fm + ((wgid % nig) % gsz); u.pn = (wgid % nig) / gsz; return true;
    }
    __device__ __forceinline__ void a_ready(const Unit&) const {}
    __device__ __forceinline__ void done(const Unit&) const {}
};

__device__ __forceinline__ unsigned cvt_pk_bf16(float lo, float hi) { unsigned r; asm volatile("v_cvt_pk_bf16_f32 %0, %1, %2" : "=v"(r) : "v"(lo), "v"(hi)); return r; }
typedef float f32x2 __attribute__((ext_vector_type(2)));
template <class Epi, class Sched, bool ALIGN_EPI = false, bool SP2 = false>
__device__ __forceinline__ void gemm_phase(PG8_LAS unsigned char* lds, const Gemm g, const Sched& S, const Epi& E, const int wid, const int lane) {
    const int tid = wid * 64 + lane, wr = wid >> 2, wc = wid & 3, fr = lane & 15, fq = lane >> 4;
    const int K = g.K, nt = K / BK;
    unsigned voffA[2], voffB[2];
#pragma unroll
    for (int i = 0; i < 2; ++i) { int R, C; stage_rc(tid * 16 + i * 8192, R, C); const int Rb = Epi::PERM ? ((R & ~31) + perm32(R & 31)) : R;
        voffA[i] = (unsigned)(R * K + C) * 2u; voffB[i] = (unsigned)(Rb * K + C) * 2u; }
    const size_t kstep = (size_t)(BK * 2);
    const size_t hstep = (size_t)HALF * K * 2;
    const size_t tstep = 2 * hstep;
    const unsigned ldsw = (unsigned)wid * 1024u;
    const int aoff = lds_byte(wr * 64 + fr, fq * 8), boff = lds_byte(wc * 32 + fr, fq * 8);
#define PG8_SA(b, h) (((b) * 2 + (h)) * HTB)
#define PG8_SB(b, h) ((4 + (b) * 2 + (h)) * HTB)
#define PG8_STAGE(bufoff, gbase, voff) do { _Pragma("unroll") for (int _i = 0; _i < 2; ++_i) \
        __builtin_amdgcn_global_load_lds((const unsigned*)((const char*)(gbase) + (voff)[_i]), (PG8_LAS unsigned*)(lds + (bufoff) + ldsw + _i * 8192), 16, 0, 0); } while (0)
#define PG8_LDA(dst, b, h) do { _Pragma("unroll") for (int m = 0; m < 4; ++m) _Pragma("unroll") for (int k = 0; k < 2; ++k) dst[m][k] = *(const PG8_LAS bf16x8*)(lds + PG8_SA(b, h) + aoff + m * 2048 + k * 1024); } while (0)
#define PG8_LDB(dst, b, h) do { _Pragma("unroll") for (int n = 0; n < 2; ++n) _Pragma("unroll") for (int k = 0; k < 2; ++k) dst[n][k] = *(const PG8_LAS bf16x8*)(lds + PG8_SB(b, h) + boff + n * 2048 + k * 1024); } while (0)
#define PG8_MMA(ai, bj, At, Bt) do { __builtin_amdgcn_s_setprio(1); _Pragma("unroll") for (int m = 0; m < 4; ++m) _Pragma("unroll") for (int n = 0; n < 2; ++n) _Pragma("unroll") for (int k = 0; k < 2; ++k) \
        acc[ai][bj][m][n] = __builtin_amdgcn_mfma_f32_16x16x32_bf16(Bt[n][k], At[m][k], acc[ai][bj][m][n], 0, 0, 0); __builtin_amdgcn_s_setprio(0); } while (0)
#define PG8_WAIT_V(n) asm volatile("s_waitcnt vmcnt(" #n ")" ::: "memory")
#define PG8_WAIT_L(n) asm volatile("s_waitcnt lgkmcnt(" #n ")" ::: "memory")
#define PG8_BAR __builtin_amdgcn_s_barrier()
#define PG8_SCHED __builtin_amdgcn_sched_barrier(0)
    Unit cur, nxt; int ui = 0;
    if (!S.next(0, cur)) return;
    f32x4 acc[2][2][4][2];
#pragma unroll
    for (int a = 0; a < 2; ++a)
#pragma unroll
        for (int b = 0; b < 2; ++b)
#pragma unroll
            for (int m = 0; m < 4; ++m)
#pragma unroll
                for (int n = 0; n < 2; ++n) acc[a][b][m][n] = (f32x4){0.f, 0.f, 0.f, 0.f};
    bf16x8 At[4][2], B0[2][2], B1[2][2];
    const char* cA = (const char*)g.A + (size_t)cur.pm * tstep; const char* cB = (const char*)g.Bt + (size_t)cur.pn * tstep;
    S.a_ready(cur);
    if constexpr (SP2) {
        PG8_STAGE(PG8_SB(0, 0), cB, voffB); PG8_STAGE(PG8_SB(0, 1), cB + hstep, voffB); PG8_STAGE(PG8_SA(0, 0), cA, voffA); PG8_STAGE(PG8_SA(0, 1), cA + hstep, voffA);
        if (wr == 1) PG8_BAR;
        PG8_WAIT_V(2); PG8_BAR;
        PG8_STAGE(PG8_SB(1, 0), cB + kstep, voffB); PG8_STAGE(PG8_SA(1, 0), cA + kstep, voffA); PG8_STAGE(PG8_SB(1, 1), cB + hstep + kstep, voffB);
        PG8_WAIT_V(6); PG8_BAR;
    } else {
        PG8_STAGE(PG8_SB(0, 0), cB, voffB); PG8_STAGE(PG8_SA(0, 0), cA, voffA); PG8_STAGE(PG8_SB(0, 1), cB + hstep, voffB); PG8_STAGE(PG8_SA(0, 1), cA + hstep, voffA);
        if (wr == 1) PG8_BAR;
        PG8_WAIT_V(4); PG8_BAR;
        PG8_STAGE(PG8_SB(1, 0), cB + kstep, voffB); PG8_STAGE(PG8_SA(1, 0), cA + kstep, voffA); PG8_STAGE(PG8_SB(1, 1), cB + hstep + kstep, voffB);
        PG8_WAIT_V(6); PG8_BAR;
    }
    for (;;) {
        const bool has_next = S.next(ui + 1, nxt);
        const char* nA = has_next ? (const char*)g.A + (size_t)nxt.pm * tstep : cA; const char* nB = has_next ? (const char*)g.Bt + (size_t)nxt.pn * tstep : cB;
        for (int t = 0; t < nt; t += 2) {
            const bool last = (t == nt - 2);
            const char* a1 = cA + (size_t)(t + 1) * kstep;
            const char* a2 = last ? nA : cA + (size_t)(t + 2) * kstep; const char* b2 = last ? nB : cB + (size_t)(t + 2) * kstep;
            const char* a3 = a2 + kstep; const char* b3 = b2 + kstep;
            if (last && has_next) S.a_ready(nxt);
            if constexpr (SP2) {
            PG8_LDB(B0, 0, 0); PG8_LDB(B1, 0, 1); PG8_SCHED; PG8_LDA(At, 0, 0); PG8_STAGE(PG8_SA(1, 1), a1 + hstep, voffA);
            PG8_WAIT_V(8); PG8_WAIT_L(0); PG8_BAR; PG8_MMA(0, 0, At, B0); PG8_MMA(0, 1, At, B1); PG8_BAR; PG8_SCHED;
            PG8_LDA(At, 0, 1); PG8_STAGE(PG8_SB(0, 0), b2, voffB); PG8_STAGE(PG8_SB(0, 1), b2 + hstep, voffB); PG8_STAGE(PG8_SA(0, 0), a2, voffA);
            PG8_WAIT_V(8); PG8_WAIT_L(0); PG8_BAR; PG8_MMA(1, 0, At, B0); PG8_MMA(1, 1, At, B1); PG8_BAR; PG8_SCHED;
            PG8_LDB(B0, 1, 0); PG8_LDB(B1, 1, 1); PG8_SCHED; PG8_LDA(At, 1, 0); PG8_STAGE(PG8_SA(0, 1), a2 + hstep, voffA);
            PG8_WAIT_V(8); PG8_WAIT_L(0); PG8_BAR; PG8_MMA(0, 0, At, B0); PG8_MMA(0, 1, At, B1); PG8_BAR; PG8_SCHED;
            PG8_LDA(At, 1, 1); PG8_STAGE(PG8_SB(1, 0), b3, voffB); PG8_STAGE(PG8_SB(1, 1), b3 + hstep, voffB); PG8_STAGE(PG8_SA(1, 0), a3, voffA);
            PG8_WAIT_V(8); PG8_WAIT_L(0); PG8_BAR; PG8_MMA(1, 0, At, B0); PG8_MMA(1, 1, At, B1); PG8_BAR; PG8_SCHED;
            } else {
            PG8_LDB(B0, 0, 0); PG8_SCHED; PG8_LDA(At, 0, 0); PG8_STAGE(PG8_SA(1, 1), a1 + hstep, voffA);
            PG8_WAIT_L(8); PG8_BAR; PG8_WAIT_L(0); PG8_MMA(0, 0, At, B0); PG8_BAR; PG8_SCHED;
            PG8_LDB(B1, 0, 1); PG8_STAGE(PG8_SB(0, 0), b2, voffB);
            PG8_BAR; PG8_WAIT_L(0); PG8_MMA(0, 1, At, B1); PG8_BAR;
            PG8_LDA(At, 0, 1); PG8_STAGE(PG8_SA(0, 0), a2, voffA);
            PG8_BAR; PG8_WAIT_L(0); PG8_MMA(1, 0, At, B0); PG8_BAR; PG8_SCHED;
            PG8_STAGE(PG8_SB(0, 1), b2 + hstep, voffB);
            PG8_WAIT_V(6); PG8_BAR; PG8_MMA(1, 1, At, B1); PG8_BAR;
            PG8_LDB(B0, 1, 0); PG8_SCHED; PG8_LDA(At, 1, 0); PG8_STAGE(PG8_SA(0, 1), a2 + hstep, voffA);
            PG8_WAIT_L(8); PG8_BAR; PG8_WAIT_L(0); PG8_MMA(0, 0, At, B0); PG8_BAR; PG8_SCHED;
            PG8_LDB(B1, 1, 1); PG8_STAGE(PG8_SB(1, 0), b3, voffB);
            PG8_BAR; PG8_WAIT_L(0); PG8_MMA(0, 1, At, B1); PG8_BAR;
            PG8_LDA(At, 1, 1); PG8_STAGE(PG8_SA(1, 0), a3, voffA);
            PG8_BAR; PG8_WAIT_L(0); PG8_MMA(1, 0, At, B0); PG8_BAR; PG8_SCHED;
            PG8_STAGE(PG8_SB(1, 1), b3 + hstep, voffB);
            PG8_WAIT_V(6); PG8_BAR; PG8_MMA(1, 1, At, B1); PG8_BAR;
            }
        }
        if constexpr (ALIGN_EPI) { if (wr == 0) PG8_BAR; }
        if constexpr (!Epi::AFTER_DRAIN) { const int le = fresh_lane(); E(acc, cur, wr, wc, le & 15, le >> 4); S.done(cur); }
        if (!has_next) break;
#pragma unroll
        for (int a = 0; a < 2; ++a)
#pragma unroll
            for (int b = 0; b < 2; ++b)
#pragma unroll
                for (int m = 0; m < 4; ++m)
#pragma unroll
                    for (int n = 0; n < 2; ++n) acc[a][b][m][n] = (f32x4){0.f, 0.f, 0.f, 0.f};
        cur = nxt; cA = nA; cB = nB; ++ui;
        if constexpr (ALIGN_EPI) { if (wr == 1) PG8_BAR; }
    }
    PG8_WAIT_V(0);
    if constexpr (!ALIGN_EPI) { if (wr == 0) PG8_BAR; }
    PG8_BAR;
    if constexpr (Epi::AFTER_DRAIN) { E.fused(acc, cur, wr, wc, fr, fq, lds, wid, lane); S.done(cur); }
#undef PG8_SA
#undef PG8_SB
#undef PG8_STAGE
#undef PG8_LDA
#undef PG8_LDB
#undef PG8_MMA
#undef PG8_WAIT_V
#undef PG8_WAIT_L
#undef PG8_BAR
#undef PG8_SCHED
}
}
typedef f32x4 acc_t[2][2][4][2];

__device__ __forceinline__ float rstd_from_parts16(const float* __restrict__ part, int row) {
    const f32x4* p = (const f32x4*)(part + (size_t)row * 16);
    const f32x4 a = p[0], b = p[1], c = p[2], d = p[3];
    const float s = ((a[0] + a[1]) + (a[2] + a[3])) + ((b[0] + b[1]) + (b[2] + b[3])) + ((c[0] + c[1]) + (c[2] + c[3])) + ((d[0] + d[1]) + (d[2] + d[3]));
    return 1.0f / sqrtf(s * (1.0f / 1024.0f) + EPS);
}
constexpr int EPI_TBL_OFF = 131072;
__device__ __forceinline__ void fill_rstd16(LAS float* T, const float* __restrict__ part, int pm, int wr, int lane) {
    const float r0 = rstd_from_parts16(part, pm * 256 + wr * 64 + lane), r1 = rstd_from_parts16(part, pm * 256 + 128 + wr * 64 + lane);
    T[lane] = r0; T[64 + lane] = r1;
}
__device__ __forceinline__ float quad_sum(float s) { s += __shfl_xor(s, 16); s += __shfl_xor(s, 32); return s; }
__device__ __forceinline__ float sumsq16(const f32x4 (&v)[2][2]) {
    float s = 0.f;
#pragma unroll
    for (int bj = 0; bj < 2; ++bj)
#pragma unroll
        for (int n = 0; n < 2; ++n) s += (v[bj][n][0] * v[bj][n][0] + v[bj][n][1] * v[bj][n][1]) + (v[bj][n][2] * v[bj][n][2] + v[bj][n][3] * v[bj][n][3]);
    return s;
}
__device__ __forceinline__ void head_norm_rope(f32x4 (&v)[2][2], bool do_norm, bool use_gain, const f32x4 (&g)[2][2], const float* __restrict__ cs_row, int fq, float scale) {
    if (do_norm) {
        const float ss = quad_sum(sumsq16(v));
        const float rn = 1.0f / sqrtf(ss * (1.0f / 64.0f) + EPS);
#pragma unroll
        for (int bj = 0; bj < 2; ++bj)
#pragma unroll
            for (int n = 0; n < 2; ++n) { v[bj][n] = v[bj][n] * rn; if (use_gain) v[bj][n] = v[bj][n] * g[bj][n]; }
    }
    if (fq == 0) {
        const f32x4* c4 = (const f32x4*)cs_row;
#pragma unroll
        for (int n = 0; n < 2; ++n) {
            const f32x4 c = c4[n], s = c4[2 + n];
            const f32x4 x1 = v[0][n], x2 = v[1][n];
            v[0][n] = x1 * c - x2 * s;
            v[1][n] = x2 * c + x1 * s;
        }
    }
    if (scale != 1.0f) {
#pragma unroll
        for (int bj = 0; bj < 2; ++bj)
#pragma unroll
            for (int n = 0; n < 2; ++n) v[bj][n] = v[bj][n] * scale;
    }
}
__device__ __forceinline__ void store_bf16x16(bf16_t* p, const f32x4 (&v)[2][2]) {
#pragma unroll
    for (int bj = 0; bj < 2; ++bj) {
        u32x4 w; w.x = cvt_pk_bf16(v[bj][0][0], v[bj][0][1]); w.y = cvt_pk_bf16(v[bj][0][2], v[bj][0][3]); w.z = cvt_pk_bf16(v[bj][1][0], v[bj][1][1]); w.w = cvt_pk_bf16(v[bj][1][2], v[bj][1][3]);
        *(u32x4*)(p + 8 * bj) = w;
    }
}
__device__ __forceinline__ void load_gain16(f32x4 (&g)[2][2], const float* __restrict__ gp, int fq) {
#pragma unroll
    for (int bj = 0; bj < 2; ++bj)
#pragma unroll
        for (int n = 0; n < 2; ++n) g[bj][n] = *(const f32x4*)(gp + 16 * fq + 8 * bj + 4 * n);
}

struct EpiQKV0 {
    static constexpr bool PERM = false, AFTER_DRAIN = false;
    const float* part; const float* cs; const float* qg; const float* kg; bf16_t* QKV; size_t stride; float qscale; LAS float* T;
    mutable int last_pm = -1;
    __device__ __forceinline__ void operator()(const acc_t& acc, const pg8::Unit& u, int wr, int wc, int fr, int fq) const {
        const int kind = u.pn >> 2, head = (u.pn & 3) * 4 + wc;
        bf16_t* dst = QKV + (size_t)kind * stride + head * 64 + 16 * fq;
        f32x4 g[2][2] = {};
        if (kind < 2) load_gain16(g, kind == 0 ? qg : kg, fq);
        if (u.pm != last_pm) { fill_rstd16(T, part, u.pm, wr, fr + 16 * fq); last_pm = u.pm; }
#pragma unroll
        for (int ai = 0; ai < 2; ++ai)
#pragma unroll
            for (int m = 0; m < 4; ++m) {
                const int row = u.pm * 256 + ai * 128 + wr * 64 + m * 16 + fr;
                const float rs = T[ai * 64 + m * 16 + fr];
                f32x4 v[2][2];
#pragma unroll
                for (int bj = 0; bj < 2; ++bj)
#pragma unroll
                    for (int n = 0; n < 2; ++n) v[bj][n] = acc[ai][bj][m][n] * rs;
                if (kind < 2) head_norm_rope(v, true, true, g, cs + (size_t)row * 16, fq, kind == 0 ? qscale : 1.0f);
                store_bf16x16(dst + (size_t)row * DM, v);
            }
    }
};
template <bool RES_BF16, bool OUT_F32> struct EpiResidT {
    static constexpr bool PERM = false, AFTER_DRAIN = false;
    const float* R; const bf16_t* Rb; float* out; bf16_t* xb; float* part;
    __device__ __forceinline__ void operator()(const acc_t& acc, const pg8::Unit& u, int wr, int wc, int fr, int fq) const {
        const int col0 = u.pn * 256 + wc * 64 + 16 * fq;
#pragma unroll
        for (int ai = 0; ai < 2; ++ai)
#pragma unroll
            for (int m = 0; m < 4; ++m) {
                const int row = u.pm * 256 + ai * 128 + wr * 64 + m * 16 + fr;
                const size_t off = (size_t)row * DM + col0;
                f32x4 v[2][2];
                if (RES_BF16) {
#pragma unroll
                    for (int bj = 0; bj < 2; ++bj) {
                        const u32x4 w = *(const u32x4*)(Rb + off + 8 * bj);
                        const unsigned ww[4] = {w.x, w.y, w.z, w.w};
#pragma unroll
                        for (int n = 0; n < 2; ++n) {
                            f32x4 r; r[0] = __builtin_bit_cast(float, ww[2 * n] << 16); r[1] = __builtin_bit_cast(float, ww[2 * n] & 0xffff0000u);
                            r[2] = __builtin_bit_cast(float, ww[2 * n + 1] << 16); r[3] = __builtin_bit_cast(float, ww[2 * n + 1] & 0xffff0000u);
                            v[bj][n] = r + acc[ai][bj][m][n];
                        }
                    }
                } else {
#pragma unroll
                    for (int bj = 0; bj < 2; ++bj)
#pragma unroll
                        for (int n = 0; n < 2; ++n) v[bj][n] = *(const f32x4*)(R + off + 8 * bj + 4 * n) + acc[ai][bj][m][n];
                }
                if (OUT_F32) {
#pragma unroll
                    for (int bj = 0; bj < 2; ++bj)
#pragma unroll
                        for (int n = 0; n < 2; ++n) *(f32x4*)(out + off + 8 * bj + 4 * n) = v[bj][n];
                }
                if (xb) store_bf16x16(xb + off, v);
                if (part) { const float ss = quad_sum(sumsq16(v)); if (fq == 0) part[(size_t)row * 16 + u.pn * 4 + wc] = ss; }
            }
    }
};
struct EpiUp {
    static constexpr bool PERM = false, AFTER_DRAIN = false;
    const float* part; bf16_t* U; LAS float* T;
    mutable int last_pm = -1;
    __device__ __forceinline__ void operator()(const acc_t& acc, const pg8::Unit& u, int wr, int wc, int fr, int fq) const {
        const int col0 = u.pn * 256 + wc * 64 + 16 * fq;
        if (u.pm != last_pm) { fill_rstd16(T, part, u.pm, wr, fr + 16 * fq); last_pm = u.pm; }
#pragma unroll
        for (int ai = 0; ai < 2; ++ai)
#pragma unroll
            for (int m = 0; m < 4; ++m) {
                const int row = u.pm * 256 + ai * 128 + wr * 64 + m * 16 + fr;
                const float rs = T[ai * 64 + m * 16 + fr];
                f32x4 v[2][2];
#pragma unroll
                for (int bj = 0; bj < 2; ++bj)
#pragma unroll
                    for (int n = 0; n < 2; ++n) {
                        f32x4 t = acc[ai][bj][m][n] * rs;
#pragma unroll
                        for (int j = 0; j < 4; ++j) { const float r = fmaxf(t[j], 0.f); t[j] = r * r; }
                        v[bj][n] = t;
                    }
                store_bf16x16(U + (size_t)row * DFF + col0, v);
            }
    }
};
struct EpiIn1 {
    static constexpr bool PERM = false, AFTER_DRAIN = false;
    const float* part; const float* cs; const float* kg; bf16_t* CQ; float* cqp; bf16_t* K; bf16_t* V; bf16_t* KI; float* widx; float wscale; LAS float* T;
    mutable int last_pm = -1;
    __device__ __forceinline__ void operator()(const acc_t& acc, const pg8::Unit& u, int wr, int wc, int fr, int fq) const {
        const int pn = u.pn;
        if (pn == 9 && wc >= 2) return;
        f32x4 g[2][2] = {};
        if (pn >= 1 && pn <= 4) load_gain16(g, kg, fq);
        if (u.pm != last_pm) { fill_rstd16(T, part, u.pm, wr, fr + 16 * fq); last_pm = u.pm; }
#pragma unroll
        for (int ai = 0; ai < 2; ++ai)
#pragma unroll
            for (int m = 0; m < 4; ++m) {
                const int row = u.pm * 256 + ai * 128 + wr * 64 + m * 16 + fr;
                const float rs = T[ai * 64 + m * 16 + fr];
                f32x4 v[2][2];
#pragma unroll
                for (int bj = 0; bj < 2; ++bj)
#pragma unroll
                    for (int n = 0; n < 2; ++n) v[bj][n] = acc[ai][bj][m][n] * rs;
                if (pn == 0) {
                    store_bf16x16(CQ + (size_t)row * 256 + wc * 64 + 16 * fq, v);
                    const float ss = quad_sum(sumsq16(v)); if (fq == 0) cqp[(size_t)row * 4 + wc] = ss;
                } else if (pn <= 4) {
                    head_norm_rope(v, true, true, g, cs + (size_t)row * 16, fq, 1.0f);
                    store_bf16x16(K + (size_t)row * DM + ((pn - 1) * 4 + wc) * 64 + 16 * fq, v);
                } else if (pn <= 8) {
                    store_bf16x16(V + (size_t)row * DM + ((pn - 5) * 4 + wc) * 64 + 16 * fq, v);
                } else if (wc == 0) {
                    head_norm_rope(v, true, false, g, cs + (size_t)row * 16, fq, 1.0f);
                    store_bf16x16(KI + (size_t)row * 64 + 16 * fq, v);
                } else if (fq == 0) {
                    *(f32x4*)(widx + (size_t)row * 8) = v[0][0] * wscale; *(f32x4*)(widx + (size_t)row * 8 + 4) = v[0][1] * wscale;
                }
            }
    }
};
struct EpiQup {
    static constexpr bool PERM = false, AFTER_DRAIN = false;
    const float* cqp; const float* cs; const float* qg; const float* widx; bf16_t* Q; bf16_t* QI; float* qin; float qscale; LAS float* T;
    __device__ __forceinline__ void operator()(const acc_t& acc, const pg8::Unit& u, int wr, int wc, int fr, int fq) const {
        const int pn = u.pn;
        f32x4 g[2][2] = {};
        if (pn < 4) load_gain16(g, qg, fq);
        { const int lane = fr + 16 * fq;
          const f32x4 c0 = *(const f32x4*)(cqp + (size_t)(u.pm * 256 + wr * 64 + lane) * 4), c1 = *(const f32x4*)(cqp + (size_t)(u.pm * 256 + 128 + wr * 64 + lane) * 4);
          T[lane] = 1.0f / sqrtf(((c0[0] + c0[1]) + (c0[2] + c0[3])) * (1.0f / 256.0f) + EPS); T[64 + lane] = 1.0f / sqrtf(((c1[0] + c1[1]) + (c1[2] + c1[3])) * (1.0f / 256.0f) + EPS); }
#pragma unroll
        for (int ai = 0; ai < 2; ++ai)
#pragma unroll
            for (int m = 0; m < 4; ++m) {
                const int row = u.pm * 256 + ai * 128 + wr * 64 + m * 16 + fr;
                const float rs = T[ai * 64 + m * 16 + fr];
                f32x4 v[2][2];
#pragma unroll
                for (int bj = 0; bj < 2; ++bj)
#pragma unroll
                    for (int n = 0; n < 2; ++n) v[bj][n] = acc[ai][bj][m][n] * rs;
                if (pn < 4) {
                    head_norm_rope(v, true, true, g, cs + (size_t)row * 16, fq, qscale);
                    store_bf16x16(Q + (size_t)row * DM + (pn * 4 + wc) * 64 + 16 * fq, v);
                } else {
                    const int hh = (pn - 4) * 4 + wc;
                    head_norm_rope(v, false, false, g, cs + (size_t)row * 16, fq, 1.0f);
                    const float nrm = sqrtf(quad_sum(sumsq16(v)));
                    const float inv = nrm > 0.f ? 1.0f / (8.2f * nrm) : 0.f;
#pragma unroll
                    for (int bj = 0; bj < 2; ++bj)
#pragma unroll
                        for (int n = 0; n < 2; ++n) v[bj][n] = v[bj][n] * inv;
                    store_bf16x16(QI + (size_t)row * 512 + hh * 64 + 16 * fq, v);
                    if (fq == 0) qin[(size_t)row * 8 + hh] = widx[(size_t)row * 8 + hh] * (8.2f * nrm);
                }
            }
    }
};
typedef GAS unsigned gu32;
#define RLX_AGENT __ATOMIC_RELAXED, __HIP_MEMORY_SCOPE_AGENT
#define LDS_WAIT() asm volatile("s_waitcnt lgkmcnt(0)" ::: "memory")
#define VM_WAIT() asm volatile("s_waitcnt vmcnt(0)" ::: "memory")

constexpr int RING_BYTES = 143360;
constexpr int MISC_OFF = RING_BYTES + 320;
constexpr int LDS_BYTES = 147456;
constexpr int NWAVES = 8;

#define XB_TMO      128
#define XB_XCNT(j)  (256  + 64 * (j))
#define XB_XSUB(j)  (1280 + 64 * (j))
#define XB_XGEN(j)  (2304 + 64 * (j))
#define XB_TOP      3328
#define XB_TOPGEN   3392
#define XCD_BAR_WORDS 3456
#define XB_SPIN_CAP (1u << 18)
__device__ __forceinline__ unsigned xb_ld(unsigned* p)              { return __hip_atomic_load(p, __ATOMIC_RELAXED, __HIP_MEMORY_SCOPE_AGENT); }
__device__ __forceinline__ unsigned xb_add(unsigned* p, unsigned v) { return __hip_atomic_fetch_add(p, v, __ATOMIC_RELAXED, __HIP_MEMORY_SCOPE_AGENT); }
__device__ __forceinline__ unsigned xb_xcc_id() { return (unsigned)__builtin_amdgcn_s_getreg((3 << 11) | 20) & 0xFu; }
#define XB_SPIN(cond, bar) do { unsigned _sp = 0; while (cond) { __builtin_amdgcn_s_sleep(1); \
    if ((++_sp & 255u) == 0u) { if (xb_ld(&(bar)[XB_TMO])) break; if (_sp > XB_SPIN_CAP) { atomicAdd(&(bar)[XB_TMO], 1u); break; } } } } while (0)
struct XcdBarrier { unsigned* bar; unsigned x; volatile LAS unsigned* st; };
__device__ __forceinline__ XcdBarrier xcd_barrier_post(unsigned* bar, volatile LAS unsigned* st) {
    XcdBarrier b; b.bar = bar; b.x = xb_xcc_id(); b.st = st;
    if (threadIdx.x == 0) (void)xb_add(&bar[XB_XCNT(b.x)], 1u);
    return b;
}
__device__ __forceinline__ void xcd_barrier_complete(unsigned* bar, unsigned x, unsigned& nloc, unsigned& nx) {
    const unsigned G = gridDim.x * gridDim.y * gridDim.z;
    unsigned sum, cnt, mine, sp = 0u;
    for (;;) {
        sum = 0u; cnt = 0u; mine = 0u;
#pragma unroll
        for (unsigned j = 0; j < 16; ++j) { const unsigned c = xb_ld(&bar[XB_XCNT(j)]); sum += c; cnt += (c > 0u) ? 1u : 0u; mine = (j == x) ? c : mine; }
        if (sum == G) break;
        __builtin_amdgcn_s_sleep(1);
        if ((++sp & 255u) == 0u) { if (xb_ld(&bar[XB_TMO])) break; if (sp > XB_SPIN_CAP) { atomicAdd(&bar[XB_TMO], 1u); break; } }
    }
    nloc = mine > 0u ? mine : 1u; nx = cnt > 0u ? cnt : 1u;
}
__device__ __forceinline__ void xcd_barrier(const XcdBarrier& b, const int wave) {
    asm volatile("s_waitcnt vmcnt(0)" ::: "memory");
    __syncthreads();
    if (wave == 0 && fresh_lane() == 0) {
        unsigned* bar = b.bar;
        __builtin_amdgcn_s_waitcnt(0);
        unsigned nloc = b.st[0], nx = b.st[1];
        if (nloc == 0u) { xcd_barrier_complete(bar, b.x, nloc, nx); b.st[0] = nloc; b.st[1] = nx; }
        const unsigned old = xb_add(&bar[XB_XSUB(b.x)], 1u);
        const unsigned gen = old / nloc;
        if (old + 1u == (gen + 1u) * nloc) {
            __builtin_amdgcn_fence(__ATOMIC_RELEASE, "agent");
            asm volatile("s_waitcnt vmcnt(0)" ::: "memory");
            const unsigned og = xb_add(&bar[XB_TOP], 1u);
            const unsigned tg = og / nx;
            if (og + 1u == (tg + 1u) * nx) xb_add(&bar[XB_TOPGEN], 1u);
            else XB_SPIN(xb_ld(&bar[XB_TOPGEN]) == tg, bar);
            __builtin_amdgcn_fence(__ATOMIC_ACQUIRE, "agent");
            xb_add(&bar[XB_XGEN(b.x)], 1u);
            asm volatile("s_waitcnt vmcnt(0)" ::: "memory");
        } else {
            XB_SPIN(xb_ld(&bar[XB_XGEN(b.x)]) == gen, bar);
            __builtin_amdgcn_fence(__ATOMIC_ACQUIRE, "agent");
            asm volatile("s_waitcnt vmcnt(0)" ::: "memory");
        }
    }
    __syncthreads();
}

__device__ __forceinline__ unsigned f2bf(float f) { unsigned u = __builtin_bit_cast(unsigned, f); return (u + 0x7fffu + ((u >> 16) & 1u)) >> 16; }
__device__ __forceinline__ unsigned pk2(float lo, float hi) { return f2bf(lo) | (f2bf(hi) << 16); }
__device__ __forceinline__ void p0_transpose_item(const float* __restrict__ W, int K, int N, const float* __restrict__ gain, bf16_t* WT, int row_off, LAS float* scr, int item, int nblk, int lane) {
    const int kb = item / nblk, nb = item % nblk, k0 = 64 * kb, n0 = 32 * nb;
    const int cc = n0 + (lane & 31);
    float wv[32];
#pragma unroll
    for (int i = 0; i < 32; ++i) { const int kk = 2 * i + (lane >> 5); wv[i] = (cc < N) ? W[(size_t)(k0 + kk) * N + cc] : 0.f; }
    if (gain) {
#pragma unroll
        for (int i = 0; i < 32; ++i) wv[i] *= gain[k0 + 2 * i + (lane >> 5)];
    }
#pragma unroll
    for (int i = 0; i < 32; ++i) scr[(2 * i + (lane >> 5)) * 33 + (lane & 31)] = wv[i];
    LDS_WAIT(); asm volatile("" ::: "memory");
    const int c = lane & 7;
#pragma unroll
    for (int j = 0; j < 4; ++j) { const int n = (lane >> 3) + 8 * j; const LAS float* s = scr + (8 * c) * 33 + n;
        u32x4 o; o.x = pk2(s[0 * 33], s[1 * 33]); o.y = pk2(s[2 * 33], s[3 * 33]); o.z = pk2(s[4 * 33], s[5 * 33]); o.w = pk2(s[6 * 33], s[7 * 33]);
        const int cl = n0 + n; const int drow = row_off + (cl & ~255) + tile_pos(cl & 255);
        *(GAS u32x4*)(WT + (size_t)drow * K + k0 + 8 * c) = o; }
    LDS_WAIT(); asm volatile("" ::: "memory");
}
struct WJob { const float* W; const float* gain; bf16_t* WT; int K, N, Npad, row_off; };
template <int NR> __device__ __forceinline__ void rows_to_bf16(const float* x, bf16_t* xb, float* part, int m, int rstride, int lane) {
    f32x4 v[NR][4];
#pragma unroll
    for (int r = 0; r < NR; ++r) { const GAS f32x4* xr = (const GAS f32x4*)(x + (size_t)(m + r * rstride) * DM) + lane;
#pragma unroll
        for (int j = 0; j < 4; ++j) v[r][j] = xr[64 * j]; }
#pragma unroll
    for (int r = 0; r < NR; ++r) {
        float s = 0.f;
#pragma unroll
        for (int j = 0; j < 4; ++j) s += (v[r][j][0] * v[r][j][0] + v[r][j][1] * v[r][j][1]) + (v[r][j][2] * v[r][j][2] + v[r][j][3] * v[r][j][3]);
        s = wave_sum(s);
        GAS u32x2* o8 = (GAS u32x2*)(xb + (size_t)(m + r * rstride) * DM) + lane;
#pragma unroll
        for (int j = 0; j < 4; ++j) { u32x2 w; w.x = cvt_pk_bf16(v[r][j][0], v[r][j][1]); w.y = cvt_pk_bf16(v[r][j][2], v[r][j][3]); o8[64 * j] = w; }
        if (lane < 16) part[(size_t)(m + r * rstride) * 16 + lane] = (lane == 0) ? s : 0.f;
    }
}
constexpr int ATT_SCR = 131072;
constexpr int ATT_NST = 4;
typedef short v4i16_t __attribute__((ext_vector_type(4)));
typedef short s16x4 __attribute__((ext_vector_type(4)));
__device__ __forceinline__ int crow(int r, int hi) { return (r & 3) + 8 * (r >> 2) + 4 * hi; }
__device__ __forceinline__ s16x4 vtr(const LAS unsigned char* p) { return __builtin_bit_cast(s16x4, __builtin_amdgcn_ds_read_tr16_b64_v4i16((LAS v4i16_t*)p)); }
__device__ __forceinline__ void glds16(const void* gsrc, unsigned lds_dst) { unsigned keep;
    asm volatile("s_mov_b32 %0, m0\n\ts_mov_b32 m0, %2\n\ts_nop 0\n\tglobal_load_lds_dwordx4 %1, off\n\ts_mov_b32 m0, %0" : "=&s"(keep) : "v"(gsrc), "s"(lds_dst) : "memory"); }
__device__ __forceinline__ void glds4(const void* gsrc, unsigned lds_dst) { unsigned keep;
    asm volatile("s_mov_b32 %0, m0\n\ts_mov_b32 m0, %2\n\ts_nop 0\n\tglobal_load_lds_dword %1, off\n\ts_mov_b32 m0, %0" : "=&s"(keep) : "v"(gsrc), "s"(lds_dst) : "memory"); }
#define ATT_WAIT_BAR() do { asm volatile("s_waitcnt vmcnt(0) lgkmcnt(0)" ::: "memory"); __builtin_amdgcn_s_barrier(); asm volatile("" ::: "memory"); } while (0)
#define ATT_WAIT_BAR_N(N) do { asm volatile("s_waitcnt vmcnt(" #N ") lgkmcnt(0)" ::: "memory"); __builtin_amdgcn_s_barrier(); asm volatile("" ::: "memory"); } while (0)

__device__ __forceinline__ int att_k_src_chunk(int row, int slot) { return slot ^ ((row >> 1) & 7); }
__device__ __forceinline__ void att_qkt(f32x16& p0, f32x16& p1, const LAS unsigned char* Kslot, const int (&koff)[4], const bf16x8 (&qr)[4]) {
    p0 = (f32x16){}; p1 = (f32x16){};
#pragma unroll
    for (int d0 = 0; d0 < 4; ++d0) {
        const bf16x8 b0 = *(const LAS bf16x8*)(Kslot + koff[d0]);
        const bf16x8 b1 = *(const LAS bf16x8*)(Kslot + koff[d0] + 4096);
        p0 = __builtin_amdgcn_mfma_f32_32x32x16_bf16(b0, qr[d0], p0, 0, 0, 0);
        p1 = __builtin_amdgcn_mfma_f32_32x32x16_bf16(b1, qr[d0], p1, 0, 0, 0);
    }
}
__device__ __forceinline__ bf16x8 pack8(const f32x16& p, int base) {
    u32x4 w; w.x = cvt_pk_bf16(p[base], p[base + 1]); w.y = cvt_pk_bf16(p[base + 2], p[base + 3]); w.z = cvt_pk_bf16(p[base + 4], p[base + 5]); w.w = cvt_pk_bf16(p[base + 6], p[base + 7]);
    return __builtin_bit_cast(bf16x8, w);
}

template <int NDB, bool MASKED, int VAR = 0> __device__ __forceinline__ void att_step(f32x16 (&o)[NDB], f32x16& ol, bf16x8 (&pa)[4], float& l, const LAS unsigned char* Kslot, const LAS unsigned char* Vslot,
                                                                       const int (&koff)[4], const int (&vboff)[NDB], const bf16x8 (&qr)[4], unsigned mlo, unsigned mhi, const bool live) {
    constexpr int ROWB = NDB * 64;
    bf16x8 vfa[NDB == 2 ? 8 : 1];
    if (NDB == 2) {
#pragma unroll
        for (int i = 0; i < 8; ++i) { const int d = i >> 2, ks = i & 3;
            const s16x4 lo = vtr(Vslot + vboff[d] + ks * 16 * ROWB), hi4 = vtr(Vslot + vboff[d] + ks * 16 * ROWB + 8 * ROWB);
            vfa[i] = (bf16x8){lo[0], lo[1], lo[2], lo[3], hi4[0], hi4[1], hi4[2], hi4[3]}; }
    }
    f32x16 p0, p1;
    if (VAR & 8) { p0 = (f32x16){}; p1 = (f32x16){}; asm volatile("" : "+v"(p0), "+v"(p1)); } else att_qkt(p0, p1, Kslot, koff, qr);
    __builtin_amdgcn_sched_barrier(0);
    bf16x8 pn[4];
#pragma unroll
    for (int sl = 0; sl < 4; ++sl) {
#pragma unroll
        for (int j = 0; j < NDB; ++j) {
            const int d = (NDB == 4) ? sl : (sl >> 1), ks = (NDB == 4) ? j : (2 * (sl & 1) + j);
            bf16x8 vf;
            if (NDB == 2) { vf = vfa[d * 4 + ks]; } else
            if (VAR & 16) { vf = pa[ks]; } else {
                const s16x4 lo = vtr(Vslot + vboff[d] + ks * 16 * ROWB), hi4 = vtr(Vslot + vboff[d] + ks * 16 * ROWB + 8 * ROWB);
                vf = (bf16x8){lo[0], lo[1], lo[2], lo[3], hi4[0], hi4[1], hi4[2], hi4[3]}; }
            if (VAR & 4) { asm volatile("" :: "v"(vf)); } else
            o[d] = __builtin_amdgcn_mfma_f32_32x32x16_bf16(pa[ks], vf, o[d], 0, 0, 0);
        }
        if (NDB == 2) {
            const bf16x8 ones = (bf16x8){0x3F80, 0x3F80, 0x3F80, 0x3F80, 0x3F80, 0x3F80, 0x3F80, 0x3F80};
            ol = __builtin_amdgcn_mfma_f32_32x32x16_bf16(pa[sl], ones, ol, 0, 0, 0);
        }
        f32x16& p = (sl < 2) ? p0 : p1;
        const unsigned mk = (sl < 2) ? mlo : mhi;
        const int rb0 = 8 * (sl & 1);
        float ps = 0.f;
#pragma unroll
        for (int r = rb0; r < rb0 + 8; ++r) {
            float e = (VAR & 2) ? p[r] : __builtin_amdgcn_exp2f(p[r]);
            if (MASKED && !(VAR & 1)) {
                unsigned kk; asm("v_bfe_i32 %0, %1, %2, 1" : "=v"(kk) : "v"(mk), "i"((r & 3) + 8 * (r >> 2)));
                e = __uint_as_float(__float_as_uint(e) & kk);
            }
            p[r] = e; if (NDB != 2) ps += e;
        }
        if (NDB != 2) l += live ? ps : 0.f;
        pn[sl] = pack8(p, rb0);
        __builtin_amdgcn_sched_barrier(0);
    }
#pragma unroll
    for (int ks = 0; ks < 4; ++ks) pa[ks] = pn[ks];
}

constexpr int A0_STAGE = 32768;
template <int VAR = 0> __device__ __forceinline__ void attn0_unit(LAS unsigned char* lds, const int wave, int b, int h, int qb, const bf16_t* Q, const bf16_t* __restrict__ K, const bf16_t* __restrict__ V, bf16_t* O,
                                           float lam, const float* __restrict__ subg, float outscale, bool dry) {
    const int lane = fresh_lane(), r32 = lane & 31, hi = lane >> 5;
    const int cc = wave >> 2, rb = wave & 3;
    const size_t rowbase = (size_t)b * SEQ;
    const int q0 = qb * 128 + rb * 32;
    const int NT = 2 * qb + 2;
    const int mylast = 2 * qb + (rb >> 1);
    const int krow = 8 * wave + (lane >> 3), kch = att_k_src_chunk(krow, lane & 7);
    const bf16_t* ksrc0 = K + (rowbase + krow) * DM + (2 * h + 0) * 64 + kch * 8;
    const bf16_t* ksrc1 = K + (rowbase + krow) * DM + (2 * h + 1) * 64 + kch * 8;
    const int vp0 = wave, vp1 = wave + 8;
    const int vrow0 = 4 * vp0 + (lane >> 4), vrow1 = 4 * vp1 + (lane >> 4), vs = lane & 15;
    const bf16_t* vsrc0 = V + (rowbase + vrow0) * DM + h * 128 + ((((vs >> 2) ^ (vrow0 & 3)) << 2) | (vs & 3)) * 8;
    const bf16_t* vsrc1 = V + (rowbase + vrow1) * DM + h * 128 + ((((vs >> 2) ^ (vrow1 & 3)) << 2) | (vs & 3)) * 8;
    const unsigned ldsb = (unsigned)(unsigned long long)lds;
#define A0_ISSUE(t, st) do { const unsigned sb_ = (unsigned)__builtin_amdgcn_readfirstlane(ldsb + (st) * A0_STAGE); const size_t go_ = (size_t)(t) * 64 * DM; \
        glds16(ksrc0 + go_, sb_ + wave * 1024); glds16(ksrc1 + go_, sb_ + 8192 + wave * 1024); \
        glds16(vsrc0 + go_, sb_ + 16384 + vp0 * 1024); glds16(vsrc1 + go_, sb_ + 16384 + vp1 * 1024); } while (0)
    bf16x8 qr[4];
    { const bf16_t* Qw = Q + (rowbase + q0) * DM + (2 * h + cc) * 64;
#pragma unroll
      for (int d0 = 0; d0 < 4; ++d0) qr[d0] = *(const bf16x8*)(Qw + (size_t)r32 * DM + d0 * 16 + hi * 8); }
    A0_ISSUE(0, 0); A0_ISSUE(1, 1);
    f32x16 o[4]; o[0] = (f32x16){}; o[1] = (f32x16){}; o[2] = (f32x16){}; o[3] = (f32x16){};
    float l = 0.f;
    int koff[4], vboff[4];
    { const int sw = (r32 >> 1) & 7, q4 = (lane & 15) >> 2, vbase = (4 * hi + q4) * 256 + ((lane >> 4) & 1) * 32 + (lane & 3) * 8;
#pragma unroll
      for (int d = 0; d < 4; ++d) { koff[d] = r32 * 128 + (((2 * d + hi) ^ sw) << 4); vboff[d] = vbase + ((d ^ q4) << 6); } }
    if (wave >= 4) __builtin_amdgcn_s_setprio(1);
    bf16x8 pa[4]; pa[0] = (bf16x8){}; pa[1] = (bf16x8){}; pa[2] = (bf16x8){}; pa[3] = (bf16x8){};
    int sk = 0, sv = 3;
    for (int t = 0; t <= NT; ++t) {
        if (t + 1 < NT) ATT_WAIT_BAR_N(4); else ATT_WAIT_BAR();
        if (t + 2 < NT) A0_ISSUE(t + 2, ((sk + 2) & 3));
        if (t <= mylast + 1) {
            const LAS unsigned char* Kslot = lds + sk * A0_STAGE + cc * 8192;
            const LAS unsigned char* Vslot = lds + (t == 0 ? 0 : sv) * A0_STAGE + 16384;
            att_step<4, false, VAR>(o, o[0], pa, l, Kslot, Vslot, koff, vboff, qr, 0u, 0u, t <= mylast);
        }
        sv = sk; sk = (sk + 1) & 3;
    }
#undef A0_ISSUE
    __builtin_amdgcn_s_setprio(0);
    ATT_WAIT_BAR();
    const int lane_e = fresh_lane(), r32e = lane_e & 31, hie = lane_e >> 5;
    l += __shfl_xor(l, 32);
    LAS float* wsf = (LAS float*)(lds + ATT_SCR + wave * 256);
    if (hie == 0) wsf[r32e] = l;
    asm volatile("s_waitcnt lgkmcnt(0)" ::: "memory");
    float rli[16];
#pragma unroll
    for (int r = 0; r < 16; ++r) rli[r] = 1.0f / wsf[crow(r, hie)];
    LAS float* X = (LAS float*)lds;
    if (cc == 1) {
#pragma unroll
        for (int r = 0; r < 16; ++r)
#pragma unroll
            for (int d = 0; d < 4; ++d) X[(rb * 32 + crow(r, hie)) * 128 + d * 32 + r32e] = o[d][r] * rli[r];
    }
    ATT_WAIT_BAR();
    if (cc == 0 && !dry) {
        float gsub[4];
#pragma unroll
        for (int d = 0; d < 4; ++d) gsub[d] = subg[d * 32 + r32e] * outscale;
#pragma unroll
        for (int r = 0; r < 16; ++r) {
            float v[4]; float ss = 0.f;
#pragma unroll
            for (int d = 0; d < 4; ++d) { v[d] = o[d][r] * rli[r] - lam * X[(rb * 32 + crow(r, hie)) * 128 + d * 32 + r32e]; ss += v[d] * v[d]; }
            ss += __shfl_xor(ss, 1); ss += __shfl_xor(ss, 2); ss += __shfl_xor(ss, 4); ss += __shfl_xor(ss, 8); ss += __shfl_xor(ss, 16);
            const float rn = 1.0f / sqrtf(ss * (1.0f / 128.0f) + EPS);
            bf16_t* op = O + (rowbase + q0 + crow(r, hie)) * DM + h * 128 + r32e;
#pragma unroll
            for (int d = 0; d < 4; ++d) op[d * 32] = (bf16_t)(cvt_pk_bf16(v[d] * rn * gsub[d], 0.f) & 0xffffu);
        }
    }
    ATT_WAIT_BAR();
}
__device__ __forceinline__ void attn0_phase(LAS unsigned char* lds, const int wave, unsigned char* ws, const float* subln, bool dry) {
    const int G = gridDim.x, bx = blockIdx.x;
    const bf16_t* Q = (const bf16_t*)(ws + WS_Q); const bf16_t* K = (const bf16_t*)(ws + WS_K); const bf16_t* V = (const bf16_t*)(ws + WS_V);
    const float lam = *(const float*)(ws + WS_MISC);
    for (int vb = bx; vb < 256; vb += G) {
        const int x = vb & 7, j = vb >> 3;
#pragma unroll 1
        for (int i = 0; i < 4; ++i) {
            const int r = i >> 1, jj = (j + 16 * r) & 31, qb = (i & 1) ? 63 - jj : jj, bh = 2 * x + r;
#if defined(PROBE_ATT0_VAR)
            if (dry) attn0_unit<PROBE_ATT0_VAR>(lds, wave, bh >> 3, bh & 7, qb, Q, K, V, (bf16_t*)(ws + WS_Q), lam, subln, 0.8f, dry); else
#endif
            attn0_unit<0>(lds, wave, bh >> 3, bh & 7, qb, Q, K, V, (bf16_t*)(ws + WS_Q), lam, subln, 0.8f, dry);
        }
    }
}

constexpr int A1_STAGE = 16384;
constexpr int A1_MASK = ATT_NST * A1_STAGE;
template <int VAR = 0> __device__ __forceinline__ void attn1_unit(LAS unsigned char* lds, const int wave, int b, int h, int qb, const bf16_t* Q, const bf16_t* __restrict__ K, const bf16_t* __restrict__ V, bf16_t* O,
                                           const unsigned long long* __restrict__ MASK, bool dry) {
    const int lane = fresh_lane(), r32 = lane & 31, hi = lane >> 5;
    const size_t rowbase = (size_t)b * SEQ;
    const int q0 = qb * 256 + wave * 32;
    const int NT = 4 * qb + 4;
    const int mylast = 4 * qb + (wave >> 1);
    const int krow = 8 * wave + (lane >> 3);
    const bf16_t* ksrc = K + (rowbase + krow) * DM + h * 64 + att_k_src_chunk(krow, lane & 7) * 8;
    const bf16_t* vsrc = V + (rowbase + krow) * DM + h * 64 + ((lane & 7) ^ (((krow >> 1) & 1) << 2)) * 8;
    const unsigned ldsb = (unsigned)(unsigned long long)lds;
    const unsigned long long* mrow = MASK + (size_t)b * 128 * SEQ + q0;
#define A1_ISSUE(t, st) do { const unsigned sb_ = (unsigned)__builtin_amdgcn_readfirstlane(ldsb + (st) * A1_STAGE); const size_t go_ = (size_t)(t) * 64 * DM; \
        glds16(ksrc + go_, sb_ + wave * 1024); glds16(vsrc + go_, sb_ + 8192 + wave * 1024); \
        glds4((const unsigned*)(mrow + (size_t)(t) * SEQ) + lane, (unsigned)__builtin_amdgcn_readfirstlane(ldsb + A1_MASK + ((st) * NWAVES + wave) * 256)); } while (0)
    bf16x8 qr[4];
    { const bf16_t* Qw = Q + (rowbase + q0) * DM + h * 64;
#pragma unroll
      for (int d0 = 0; d0 < 4; ++d0) qr[d0] = *(const bf16x8*)(Qw + (size_t)r32 * DM + d0 * 16 + hi * 8); }
    A1_ISSUE(0, 0); A1_ISSUE(1, 1);
    f32x16 o[2]; o[0] = (f32x16){}; o[1] = (f32x16){};
    f32x16 ol = (f32x16){};
    float l = 0.f;
    int koff[4], vboff[2];
    { const int sw = (r32 >> 1) & 7, q4 = (lane & 15) >> 2, vbase = (4 * hi + q4) * 128 + ((lane >> 4) & 1) * 32 + (lane & 3) * 8;
#pragma unroll
      for (int d = 0; d < 4; ++d) koff[d] = r32 * 128 + (((2 * d + hi) ^ sw) << 4);
#pragma unroll
      for (int d = 0; d < 2; ++d) vboff[d] = vbase + ((d ^ ((q4 >> 1) & 1)) << 6); }
    bf16x8 pa[4]; pa[0] = (bf16x8){}; pa[1] = (bf16x8){}; pa[2] = (bf16x8){}; pa[3] = (bf16x8){};
    int sk = 0, sv = 3;
    if (wave >= 4) __builtin_amdgcn_s_setprio(1);
    for (int t = 0; t <= NT; ++t) {
        if (VAR & 32) { asm volatile("s_waitcnt vmcnt(0) lgkmcnt(0)" ::: "memory"); } else
        if (t + 1 < NT) ATT_WAIT_BAR_N(3); else ATT_WAIT_BAR();
        if (!(VAR & 64)) if (t + 2 < NT) A1_ISSUE(t + 2, ((sk + 2) & 3));
        const unsigned long long mw = *(const LAS unsigned long long*)(lds + A1_MASK + (sk * NWAVES + wave) * 256 + r32 * 8);
        const unsigned mlo = (unsigned)mw >> (4 * hi), mhi = (unsigned)(mw >> 32) >> (4 * hi);
        if (t <= mylast + 1) {
            const LAS unsigned char* Kslot = lds + sk * A1_STAGE;
            const LAS unsigned char* Vslot = lds + (t == 0 ? 0 : sv) * A1_STAGE + 8192;
            att_step<2, true, VAR>(o, ol, pa, l, Kslot, Vslot, koff, vboff, qr, mlo, mhi, t <= mylast);
        }
        sv = sk; sk = (sk + 1) & 3;
    }
#undef A1_ISSUE
    __builtin_amdgcn_s_setprio(0);
    if (dry) asm volatile("" :: "v"(o[0]), "v"(o[1]), "v"(ol));
    const int lane_e = fresh_lane(), r32e = lane_e & 31, hie = lane_e >> 5;
    if (!dry)
#pragma unroll
    for (int r = 0; r < 16; ++r) {
        const float rl = 1.0f / ol[r];
        bf16_t* op = O + (rowbase + q0 + crow(r, hie)) * DM + h * 64 + r32e;
        op[0] = (bf16_t)(cvt_pk_bf16(o[0][r] * rl, 0.f) & 0xffffu); op[32] = (bf16_t)(cvt_pk_bf16(o[1][r] * rl, 0.f) & 0xffffu);
    }
    (void)l;
    ATT_WAIT_BAR();
}
__device__ __forceinline__ void attn1_phase(LAS unsigned char* lds, const int wave, unsigned char* ws, bool dry) {
    const int G = gridDim.x, bx = blockIdx.x;
    const bf16_t* Q = (const bf16_t*)(ws + WS_Q); const bf16_t* K = (const bf16_t*)(ws + WS_K); const bf16_t* V = (const bf16_t*)(ws + WS_V);
    for (int vb = bx; vb < 256; vb += G) {
        const int x = vb & 7, j = vb >> 3;
#pragma unroll 1
        for (int i = 0; i < 4; ++i) {
            const int jj = (j + 16 * (i >> 1)) & 31, qb = (i & 1) ? 31 - jj : jj, bh = 4 * x + i;
#if defined(PROBE_ATT1_VAR)
            if (dry) attn1_unit<PROBE_ATT1_VAR>(lds, wave, bh >> 4, bh & 15, qb, Q, K, V, (bf16_t*)(ws + WS_Q), (const unsigned long long*)(ws + WS_MASK), dry); else
#endif
            attn1_unit<0>(lds, wave, bh >> 4, bh & 15, qb, Q, K, V, (bf16_t*)(ws + WS_Q), (const unsigned long long*)(ws + WS_MASK), dry);
        }
    }
}
constexpr int IX_NB = 512, IX_HSTR = 513, IX_CAP = 320, IX_BSTR = 257;
constexpr int IX_HIST = 0, IX_CK = 0, IX_CI = 32 * IX_CAP * 4, IX_BM = 66560, IX_META = IX_BM + 32 * IX_BSTR * 4 + 128;
static_assert(IX_CI + 32 * IX_CAP * 2 <= IX_BM && 32 * IX_HSTR * 4 <= IX_BM && IX_META + 512 <= RING_BYTES, "indexer LDS map");

__device__ __forceinline__ void ix_abs_fma(f32x16& sc, const f32x16& d, float ah) {
#pragma unroll
    for (int r = 0; r < 16; ++r) { float t = sc[r]; asm("v_fma_f32 %0, %1, |%2|, %0" : "+v"(t) : "v"(ah), "v"(d[r])); sc[r] = t; }
}
__device__ __forceinline__ void ix_scores(f32x16& sc, const bf16x8 (&kf)[4], const bf16x8 (&qf)[8][4], const bf16x8 (&qc)[4], const float (&ah)[8]) {
    sc = (f32x16){};
#pragma unroll
    for (int s = 0; s < 4; ++s) sc = __builtin_amdgcn_mfma_f32_32x32x16_bf16(kf[s], qc[s], sc, 0, 0, 0);
    f32x16 d0 = (f32x16){}, d1;
#pragma unroll
    for (int s = 0; s < 4; ++s) d0 = __builtin_amdgcn_mfma_f32_32x32x16_bf16(kf[s], qf[0][s], d0, 0, 0, 0);
    asm volatile("" : "+v"(sc), "+v"(d0));
    __builtin_amdgcn_sched_barrier(0);
#pragma unroll
    for (int h = 0; h < 8; h += 2) {
        d1 = (f32x16){};
#pragma unroll
        for (int s = 0; s < 4; ++s) d1 = __builtin_amdgcn_mfma_f32_32x32x16_bf16(kf[s], qf[h + 1][s], d1, 0, 0, 0);
        asm volatile("" : "+v"(d1), "+v"(d0), "+v"(sc));
        __builtin_amdgcn_sched_barrier(0);
        ix_abs_fma(sc, d0, ah[h]);
        asm volatile("" : "+v"(sc));
        __builtin_amdgcn_sched_barrier(0);
        if (h + 2 < 8) {
            d0 = (f32x16){};
#pragma unroll
            for (int s = 0; s < 4; ++s) d0 = __builtin_amdgcn_mfma_f32_32x32x16_bf16(kf[s], qf[h + 2][s], d0, 0, 0, 0);
            asm volatile("" : "+v"(d0), "+v"(d1), "+v"(sc));
        } else {
            asm volatile("s_nop 15\n\ts_nop 3" : "+v"(d1), "+v"(sc));
        }
        __builtin_amdgcn_sched_barrier(0);
        ix_abs_fma(sc, d1, ah[h + 1]);
        asm volatile("" : "+v"(sc));
        __builtin_amdgcn_sched_barrier(0);
    }
}
__device__ __forceinline__ void ix_combine(bf16x8 (&qc)[4], const bf16x8 (&qf)[8][4], const float (&ah)[8]) {
#pragma unroll
    for (int s = 0; s < 4; ++s) {
        float acc[8];
#pragma unroll
        for (int j = 0; j < 8; ++j) acc[j] = 0.f;
#pragma unroll
        for (int h = 0; h < 8; ++h)
#pragma unroll
            for (int j = 0; j < 8; ++j) acc[j] = __builtin_fmaf(ah[h], __uint_as_float((unsigned)(unsigned short)qf[h][s][j] << 16), acc[j]);
        u32x4 w; w.x = cvt_pk_bf16(acc[0], acc[1]); w.y = cvt_pk_bf16(acc[2], acc[3]); w.z = cvt_pk_bf16(acc[4], acc[5]); w.w = cvt_pk_bf16(acc[6], acc[7]);
        qc[s] = __builtin_bit_cast(bf16x8, w);
    }
}
__device__ __forceinline__ int ix_bin(float sc, float Rs, float scale) {
    const int b = (int)__builtin_fmaf(sc, scale, Rs);
    return b < 0 ? 0 : (b > IX_NB - 1 ? IX_NB - 1 : b);
}
__device__ __forceinline__ void ix_loadk(bf16x8 (&kf)[4], const bf16_t* KIb, int kt, int r32, int hi) {
    const int l_ = fresh_lane();
    const bf16_t* p = KIb + (size_t)(unsigned)((kt * 32 + (l_ & 31)) * 64 + (l_ >> 5) * 8);
#pragma unroll
    for (int s = 0; s < 4; ++s) kf[s] = *(const bf16x8*)(p + s * 16);
}

__device__ __forceinline__ void idx_unit(LAS unsigned char* lds, const int wave, unsigned char* ws, int b, int qt, const int dry) {
    const int lane = fresh_lane(), r32 = lane & 31, hi = lane >> 5, tid = wave * 64 + lane;
    const int chunk = qt >> 1;
    const size_t tok0 = (size_t)b * SEQ + (size_t)qt * 32;
    unsigned* MASK32 = (unsigned*)(ws + WS_MASK);
    if (chunk < 4) {
        if (!dry) for (int t = wave; t <= chunk; t += 8) MASK32[((size_t)(b * 128 + t) * SEQ + qt * 32 + r32) * 2 + hi] = 0xFFFFFFFFu;
        return;
    }
    const bf16_t* KIb = (const bf16_t*)(ws + WS_KI) + (size_t)b * SEQ * 64;
    LAS unsigned* HIST = (LAS unsigned*)(lds + IX_HIST);
    LAS float* CK = (LAS float*)(lds + IX_CK);
    LAS unsigned short* CI = (LAS unsigned short*)(lds + IX_CI);
    LAS unsigned* BM = (LAS unsigned*)(lds + IX_BM);
    LAS int* META = (LAS int*)(lds + IX_META);
#define IX_LOADQ(qf) do { const int l_ = fresh_lane(); const bf16_t* qp_ = (const bf16_t*)(ws + WS_QI) + tok0 * 512 + (unsigned)((l_ & 31) * 512 + (l_ >> 5) * 8); \
        _Pragma("unroll") for (int h = 0; h < 8; ++h) _Pragma("unroll") for (int s = 0; s < 4; ++s) qf[h][s] = *(const bf16x8*)(qp_ + h * 64 + s * 16); } while (0)
    float a[8]; float R;
    { const float* np = (const float*)(ws + WS_QIN) + (tok0 + r32) * 8;
      const f32x4 n0 = *(const f32x4*)np, n1 = *(const f32x4*)(np + 4);
#pragma unroll
      for (int h = 0; h < 4; ++h) { a[h] = 0.5f * n0[h]; a[4 + h] = 0.5f * n1[h]; }
      R = (((fabsf(n0[0]) + fabsf(n0[1])) + (fabsf(n0[2]) + fabsf(n0[3]))) + ((fabsf(n1[0]) + fabsf(n1[1])) + (fabsf(n1[2]) + fabsf(n1[3])))) * 1.03f;
      R = fmaxf(R, 1e-30f); }
    const float scale = (float)(IX_NB / 2) / R, Rs = (float)(IX_NB / 2);
    const int nkt = 2 * (chunk + 1);
    for (int i = tid; i < 32 * IX_HSTR; i += NWAVES * 64) HIST[i] = 0u;
    for (int i = tid; i < 32 * IX_BSTR; i += NWAVES * 64) BM[i] = 0u;
    if (tid < 128) META[tid] = 0;
    LDS_WAIT(); __builtin_amdgcn_s_barrier(); asm volatile("" ::: "memory");
    {
        bf16x8 qf[8][4]; IX_LOADQ(qf);
        bf16x8 qc[4]; ix_combine(qc, qf, a);
        bf16x8 kf[4], kn[4];
        if (wave < nkt) ix_loadk(kf, KIb, wave, r32, hi);
#pragma unroll 1
        for (int kt = wave; kt < nkt; kt += 8) {
            if (kt + 8 < nkt) ix_loadk(kn, KIb, kt + 8, r32, hi);
            f32x16 sc;
            ix_scores(sc, kf, qf, qc, a);
#pragma unroll
            for (int r = 0; r < 16; ++r) {
                const int bin = ix_bin(sc[r], Rs, scale);
                __hip_atomic_fetch_add(HIST + r32 * IX_HSTR + bin, 1u, __ATOMIC_RELAXED, __HIP_MEMORY_SCOPE_WORKGROUP);
            }
#pragma unroll
            for (int s = 0; s < 4; ++s) kf[s] = kn[s];
        }
    }
    LDS_WAIT(); __builtin_amdgcn_s_barrier(); asm volatile("" ::: "memory");
#pragma unroll 1
    for (int i = 0; i < 4; ++i) {
        const int q = wave * 4 + i;
        int lane8 = 8 * lane; asm volatile("" : "+v"(lane8));
        unsigned wv[8]; unsigned c = 0;
#pragma unroll
        for (int w = 0; w < 8; ++w) { wv[w] = HIST[q * IX_HSTR + lane8 + w]; c += wv[w]; }
        unsigned x = c;
#pragma unroll
        for (int off = 1; off < 64; off <<= 1) { const unsigned y = __shfl_down(x, off); if (lane + off < 64) x += y; }
        const unsigned sx = x - c;
        if (sx < 256u && x >= 256u) {
            unsigned cum = sx; int found = 0, tb = 0, kr = 0, tc = 0;
#pragma unroll
            for (int w = 7; w >= 0; --w) {
                if (!found) { if (cum + wv[w] >= 256u) { found = 1; tb = lane8 + w; kr = 256 - (int)cum; tc = (int)wv[w]; } else cum += wv[w]; }
            }
            META[q] = tb; META[32 + q] = kr; META[64 + q] = tc;
        }
    }
    LDS_WAIT(); __builtin_amdgcn_s_barrier(); asm volatile("" ::: "memory");
    if (dry == 1) return;
    {
        const int tb = META[r32];
        const float fl = (tb <= 0) ? -__builtin_inff() : (float)tb, fh = (tb >= IX_NB - 1) ? __builtin_inff() : (float)(tb + 1);
        bf16x8 qf[8][4]; IX_LOADQ(qf);
        bf16x8 qc[4]; ix_combine(qc, qf, a);
        bf16x8 kf[4], kn[4];
        if (wave < nkt) ix_loadk(kf, KIb, wave, r32, hi);
#pragma unroll 1
        for (int kt = wave; kt < nkt; kt += 8) {
            if (kt + 8 < nkt) ix_loadk(kn, KIb, kt + 8, r32, hi);
            f32x16 sc;
            ix_scores(sc, kf, qf, qc, a);
            unsigned sb = 0u, cb = 0u;
#pragma unroll
            for (int r = 15; r >= 1; r -= 2) {
                const float f1 = __builtin_fmaf(sc[r], scale, Rs), f0 = __builtin_fmaf(sc[r - 1], scale, Rs);
                unsigned long long t0, t1, t2, t3;
                asm("v_cmp_ge_f32_e64 %2, %6, %8\n\tv_cmp_ge_f32_e64 %3, %7, %8\n\tv_cmp_ge_f32_e64 %4, %6, %9\n\tv_cmp_ge_f32_e64 %5, %7, %9\n\t"
                    "v_addc_co_u32_e64 %0, vcc, %0, %0, %2\n\tv_addc_co_u32_e64 %0, vcc, %0, %0, %3\n\tv_addc_co_u32_e64 %1, vcc, %1, %1, %4\n\tv_addc_co_u32_e64 %1, vcc, %1, %1, %5"
                    : "+v"(sb), "+v"(cb), "=&s"(t0), "=&s"(t1), "=&s"(t2), "=&s"(t3) : "v"(f1), "v"(f0), "v"(fh), "v"(fl) : "vcc");
            }
            const unsigned cbits = cb & ~sb;
            if (__ballot(cbits != 0u)) {
                int base = 0;
                if (cbits) base = __hip_atomic_fetch_add(META + 96 + r32, __popc(cbits), __ATOMIC_RELAXED, __HIP_MEMORY_SCOPE_WORKGROUP);
#pragma unroll
                for (int r = 0; r < 16; ++r) {
                    const bool c = (cbits >> r) & 1u;
                    if (__ballot(c)) {
                        if (c) { if (base < IX_CAP) { CK[r32 * IX_CAP + base] = sc[r]; CI[r32 * IX_CAP + base] = (unsigned short)(kt * 32 + (r & 3) + 8 * (r >> 2) + 4 * hi); } ++base; }
                    }
                }
            }
            unsigned bits = (sb & 0xFu) | ((sb & 0xF0u) << 4) | ((sb & 0xF00u) << 8) | ((sb & 0xF000u) << 12);
            bits <<= 4 * hi;
            bits |= __shfl_xor(bits, 32);
            if (hi == 0) BM[r32 * IX_BSTR + kt] = bits;
#pragma unroll
            for (int s = 0; s < 4; ++s) kf[s] = kn[s];
        }
    }
    LDS_WAIT(); __builtin_amdgcn_s_barrier(); asm volatile("" ::: "memory");
    if (dry == 2) return;
    {
        const int q0 = wave * 4;
        unsigned key[4][5]; int kr[4], cq[4]; unsigned prefix[4];
        int maxc = 0; unsigned dmax = 0u;
#pragma unroll
        for (int i = 0; i < 4; ++i) {
            int c = META[96 + q0 + i]; c = c > IX_CAP ? IX_CAP : c; cq[i] = c; maxc = c > maxc ? c : maxc;
            kr[i] = META[32 + q0 + i];
            unsigned orv = 0u, andv = 0xFFFFFFFFu;
#pragma unroll
            for (int sl = 0; sl < 5; ++sl) {
                const int e = lane + 64 * sl; const bool v = e < c;
                const unsigned u = v ? __float_as_uint(CK[(q0 + i) * IX_CAP + e]) : 0u;
                const unsigned k = (u & 0x80000000u) ? ~u : (u | 0x80000000u);
                key[i][sl] = v ? k : 0u; orv |= key[i][sl]; andv &= v ? k : 0xFFFFFFFFu;
            }
#pragma unroll
            for (int o = 1; o < 64; o <<= 1) { orv |= (unsigned)__shfl_xor((int)orv, o); andv &= (unsigned)__shfl_xor((int)andv, o); }
            const unsigned diff = orv ^ andv;
            const unsigned low = diff ? (0xFFFFFFFFu >> __builtin_clz(diff)) : 0u;
            prefix[i] = (c > 0) ? (andv & ~low) : 0u; dmax |= diff;
        }
        maxc = __builtin_amdgcn_readfirstlane(maxc); dmax = __builtin_amdgcn_readfirstlane(dmax);
        const int nsl = (maxc + 63) >> 6;
#pragma unroll 1
        for (int bit = dmax ? 31 - __builtin_clz(dmax) : -1; bit >= 0; --bit) {
            int cnt[4] = {0, 0, 0, 0};
#pragma unroll
            for (int sl = 0; sl < 5; ++sl) if (sl < nsl) {
#pragma unroll
                for (int i = 0; i < 4; ++i) cnt[i] += __popcll(__ballot(key[i][sl] >= (prefix[i] | (1u << bit))));
            }
#pragma unroll
            for (int i = 0; i < 4; ++i) prefix[i] = (cnt[i] >= kr[i]) ? (prefix[i] | (1u << bit)) : prefix[i];
        }
#pragma unroll
        for (int i = 0; i < 4; ++i) {
            const int q = q0 + i;
            int cgt = 0, ceq = 0;
#pragma unroll
            for (int sl = 0; sl < 5; ++sl) if (sl < nsl) { const bool v = lane + 64 * sl < cq[i];
                cgt += __popcll(__ballot(v && key[i][sl] > prefix[i])); ceq += __popcll(__ballot(v && key[i][sl] == prefix[i])); }
            const int need = kr[i] - cgt;
            int idx[5];
#pragma unroll
            for (int sl = 0; sl < 5; ++sl) { const int e = lane + 64 * sl; idx[sl] = (e < cq[i]) ? (int)CI[q * IX_CAP + e] : 0x7fffffff; }
            int ithr = 0x7fffffff;
            if (need < ceq) {
                int pre = 0;
#pragma unroll 1
                for (int bit = 12; bit >= 0; --bit) {
                    const int trial = pre | (1 << bit); int cnt = 0;
#pragma unroll
                    for (int sl = 0; sl < 5; ++sl) cnt += __popcll(__ballot(lane + 64 * sl < cq[i] && key[i][sl] == prefix[i] && idx[sl] < trial));
                    if (cnt < need) pre = trial;
                }
                ithr = pre;
            }
#pragma unroll
            for (int sl = 0; sl < 5; ++sl)
                if (lane + 64 * sl < cq[i] && (key[i][sl] > prefix[i] || (key[i][sl] == prefix[i] && idx[sl] <= ithr)))
                    __hip_atomic_fetch_or(BM + q * IX_BSTR + (idx[sl] >> 5), 1u << (idx[sl] & 31), __ATOMIC_RELAXED, __HIP_MEMORY_SCOPE_WORKGROUP);
        }
    }
    LDS_WAIT(); __builtin_amdgcn_s_barrier(); asm volatile("" ::: "memory");
#undef IX_LOADQ
    if (dry) return;
    for (int t = wave; t <= chunk; t += 8) MASK32[((size_t)(b * 128 + t) * SEQ + qt * 32 + r32) * 2 + hi] = BM[r32 * IX_BSTR + 2 * t + hi];
    LDS_WAIT(); __builtin_amdgcn_s_barrier(); asm volatile("" ::: "memory");
}
__device__ __forceinline__ void idx_phase(LAS unsigned char* lds, const int wave, unsigned char* ws) {
    for (int v = blockIdx.x; v < 256; v += gridDim.x) {
        const int b = v >> 7, j = v & 127;
#if defined(PROBE_IDX_DRY)
#pragma unroll 1
        for (int u = 0; u < 6; ++u) idx_unit(lds, wave, ws, b, (u & 1) ? 255 - j : j, u < 2 ? 0 : PROBE_IDX_DRY);
#else
#pragma unroll 1
        for (int u = 0; u < 2; ++u) idx_unit(lds, wave, ws, b, u ? 255 - j : j, 0);
#endif
    }
}
struct Args { const float* in[22]; float* out; unsigned char* ws; int ph_lo, ph_hi, coop, pad; };
enum Phase { P_PRO = 0, P_IN0, P_ATT0, P_OUT0, P_UP0, P_DN0, P_IN1, P_QUP, P_IDX, P_ATT1, P_OUT1, P_UP1, P_DN1, P_N, P_BRIDGE = 20 };

constexpr int CTL_ROWCNT = 4096;
struct In1Order : pg8::StaticOrder {
    unsigned* cnt; int wave;
    __device__ __forceinline__ bool next(int i, pg8::Unit& u) const { if (!pg8::StaticOrder::next(i, u)) return false; u.pn = (u.pn == 1) ? 9 : (u.pn == 9) ? 1 : u.pn; return true; }
    __device__ __forceinline__ void a_ready(const pg8::Unit&) const {}
    __device__ __forceinline__ void done(const pg8::Unit& u) const {
        if (u.pn == 0 || u.pn == 9) {
            asm volatile("s_waitcnt vmcnt(0)" ::: "memory");
            __builtin_amdgcn_s_barrier();
            if (wave == 0) {
                __builtin_amdgcn_fence(__ATOMIC_RELEASE, "agent");
                asm volatile("s_waitcnt vmcnt(0)" ::: "memory");
                if (fresh_lane() == 0) (void)xb_add(&cnt[u.pm * 16], 8u);
            }
        }
    }
};
__device__ __forceinline__ void qup_wait_rows(const pg8::StaticOrder& S, unsigned* cnt, unsigned* tmo, const unsigned need = 16u) {
#pragma unroll 1
    for (int i = 0; ; ++i) {
        pg8::Unit u; if (!S.next(i, u)) break;
        unsigned sp = 0;
        while (xb_ld(&cnt[u.pm * 16]) < need) { __builtin_amdgcn_s_sleep(1); if ((++sp & 255u) == 0u) { if (xb_ld(tmo)) break; if (sp > XB_SPIN_CAP) { atomicAdd(tmo, 1u); break; } } }
    }
    __builtin_amdgcn_fence(__ATOMIC_ACQUIRE, "agent");
}
template <class Epi> __device__ __forceinline__ void run_gemm(LAS unsigned char* lds, const int wave, const bf16_t* A, const bf16_t* Bt, int N, int K, const Epi& E) {
    pg8::Gemm g{A, Bt, TOK, N, K}; pg8::StaticOrder S; S.init(TOK, N, (int)gridDim.x, (int)blockIdx.x);
    pg8::gemm_phase<Epi, pg8::StaticOrder, true, true>(lds, g, S, E, wave, fresh_lane());
}
__global__ void __launch_bounds__(NWAVES * 64, 2) mk_fwd(Args args) {
    extern __shared__ __attribute__((aligned(16))) unsigned char lds_raw[];
    LAS unsigned char* lds = (LAS unsigned char*)lds_raw;
    const int wave = __builtin_amdgcn_readfirstlane(threadIdx.x >> 6);
    const int G = gridDim.x;
    unsigned char* ws = args.ws;
    const int lo = args.ph_lo, hi = args.ph_hi;
    volatile LAS unsigned* MISC = (volatile LAS unsigned*)(lds + MISC_OFF);
    { const int tid = wave * 64 + fresh_lane(); for (int u = tid; u < (LDS_BYTES - RING_BYTES) / 4; u += NWAVES * 64) ((LAS unsigned*)(lds + RING_BYTES))[u] = 0u; }
    __syncthreads();
    XcdBarrier bar; bar.bar = (unsigned*)(ws + WS_CTL); bar.x = 0; bar.st = nullptr;
    if (args.coop) bar = xcd_barrier_post((unsigned*)(ws + WS_CTL), MISC + 8);
#define IN(k) (lo <= (k) && (k) < hi)
#define NREP(k) ((PROBE_PHASE == (k)) ? 3 : 1)
#define SEAM(k) do { if (args.coop && IN(k) && IN((k) + 1)) xcd_barrier(bar, wave); } while (0)
    LAS float* ETBL = (LAS float*)(lds + EPI_TBL_OFF + wave * 512);
    bf16_t* XB = (bf16_t*)(ws + WS_XB); bf16_t* QB = (bf16_t*)(ws + WS_Q); bf16_t* KB = (bf16_t*)(ws + WS_K); bf16_t* VB = (bf16_t*)(ws + WS_V); bf16_t* UB = (bf16_t*)(ws + WS_U);
    float* PART = (float*)(ws + WS_PART); float* CS = (float*)(ws + WS_CS); float* LAM = (float*)(ws + WS_MISC);

    if (IN(P_PRO)) for (int rep_ = 0; rep_ < NREP(P_PRO); ++rep_) {
        const int lane = fresh_lane(), tid = wave * 64 + lane;
        LAS float* scr = (LAS float*)(lds + wave * 16384);
        const int gw = blockIdx.x * NWAVES + wave, NGW = G * NWAVES;
        const float* nmix = args.in[2]; const float* nmlp = args.in[3];
        int base = 0;
#define DOJOB(W_, gain_, WT_, K_, N_, Npad_, roff_) do { const int nblk = (Npad_) / 32, nitems = ((K_) / 64) * nblk; \
            for (int it = (gw - base % NGW + NGW) % NGW; it < nitems; it += NGW) p0_transpose_item((W_), (K_), (N_), (gain_), (bf16_t*)(ws + (WT_)), (roff_), scr, it, nblk, lane); \
            base += nitems; } while (0)
        DOJOB(args.in[6], nmix, WS_WIN0, DM, 3072, 3072, 0);
        DOJOB(args.in[14], (const float*)nullptr, WS_WOUT0, DM, DM, DM, 0);
        DOJOB(args.in[4], nmlp, WS_W1_0, DM, DFF, DFF, 0);
        DOJOB(args.in[5], (const float*)nullptr, WS_W2_0, DFF, DM, DM, 0);
        DOJOB(args.in[15], nmix + DM, WS_WIN1, DM, NIN1, NIN1P, 0);
        DOJOB(args.in[17], args.in[16], WS_WUQ, 256, DM, DM, 0);
        DOJOB(args.in[18], args.in[16], WS_WUQ, 256, 512, 512, 1024);
        DOJOB(args.in[21], (const float*)nullptr, WS_WOUT1, DM, DM, DM, 0);
        DOJOB(args.in[4] + (size_t)DM * DFF, nmlp + DM, WS_W1_1, DM, DFF, DFF, 0);
        DOJOB(args.in[5] + (size_t)DM * DFF, (const float*)nullptr, WS_W2_1, DFF, DM, DM, 0);
#undef DOJOB
        if (TOK % (4 * NGW) == 0) { for (int m = gw; m < TOK; m += 4 * NGW) rows_to_bf16<4>(args.in[0], XB, PART, m, NGW, lane); }
        else { for (int m = gw; m < TOK; m += NGW) rows_to_bf16<1>(args.in[0], XB, PART, m, NGW, lane); }
        const int* pos = (const int*)args.in[1];
        for (int t = blockIdx.x * (NWAVES * 64) + tid; t < TOK * 8; t += G * NWAVES * 64) {
            const int tok = t >> 3, i = t & 7;
            const float inv = (float)pow(500000.0, -(double)i / 8.0);
            const float ang = (float)pos[tok] * inv;
            CS[tok * 16 + i] = (float)cos((double)ang); CS[tok * 16 + 8 + i] = (float)sin((double)ang);
        }
        if (blockIdx.x == 0 && tid == 0) {
            float s1 = 0.f, s2 = 0.f;
            for (int i = 0; i < 64; ++i) { s1 += args.in[9][i] * args.in[10][i]; s2 += args.in[11][i] * args.in[12][i]; }
            LAM[0] = expf(s1) - expf(s2) + 0.2f;
        }
    }
    SEAM(P_PRO);
    if (IN(P_BRIDGE)) {
        const int lane = fresh_lane();
        const int gw = blockIdx.x * NWAVES + wave, NGW = G * NWAVES;
        for (int m = gw; m < TOK; m += NGW) rows_to_bf16<1>(args.out, XB, PART, m, NGW, lane);
    }
    if (IN(P_IN0)) { for (int rep_ = 0; rep_ < NREP(P_IN0); ++rep_) { EpiQKV0 E{PART, CS, args.in[7], args.in[8], QB, (size_t)(WS_K - WS_Q) / 2, 0.125f * LOG2E, ETBL}; run_gemm(lds, wave, XB, (const bf16_t*)(ws + WS_WIN0), 3072, DM, E); } }
    SEAM(P_IN0);
    if (IN(P_ATT0)) { for (int rep_ = NREP(P_ATT0) - 1; rep_ >= 0; --rep_) attn0_phase(lds, wave, ws, args.in[13], rep_ != 0); }
    SEAM(P_ATT0);
    if (IN(P_OUT0)) { for (int rep_ = 0; rep_ < NREP(P_OUT0); ++rep_) { EpiResidT<true, false> E{nullptr, XB, nullptr, XB, PART}; run_gemm(lds, wave, QB, (const bf16_t*)(ws + WS_WOUT0), DM, DM, E); } }
    SEAM(P_OUT0);
    if (IN(P_UP0)) { for (int rep_ = 0; rep_ < NREP(P_UP0); ++rep_) { EpiUp E{PART, UB, ETBL}; run_gemm(lds, wave, XB, (const bf16_t*)(ws + WS_W1_0), DFF, DM, E); } }
    SEAM(P_UP0);
    if (IN(P_DN0)) { EpiResidT<true, false> E{nullptr, XB, nullptr, XB, PART}; run_gemm(lds, wave, UB, (const bf16_t*)(ws + WS_W2_0), DM, DFF, E); }
    SEAM(P_DN0);
    if (IN(P_IN1)) { for (int rep_ = 0; rep_ < NREP(P_IN1); ++rep_) { EpiIn1 E{PART, CS, args.in[20], (bf16_t*)(ws + WS_CQ), (float*)(ws + WS_CQP), KB, VB, (bf16_t*)(ws + WS_KI), (float*)(ws + WS_WIDX), 0.35355339059327373f * 0.125f, ETBL};
        pg8::Gemm g{XB, (const bf16_t*)(ws + WS_WIN1), TOK, NIN1P, DM}; In1Order S; S.init(TOK, NIN1P, G, (int)blockIdx.x); S.cnt = (unsigned*)(ws + WS_CTL) + CTL_ROWCNT; S.wave = wave;
        pg8::gemm_phase<EpiIn1, In1Order, true, true>(lds, g, S, E, wave, fresh_lane()); } }
    if (IN(P_QUP)) { for (int rep_ = 0; rep_ < NREP(P_QUP); ++rep_) { EpiQup E{(const float*)(ws + WS_CQP), CS, args.in[19], (const float*)(ws + WS_WIDX), QB, (bf16_t*)(ws + WS_QI), (float*)(ws + WS_QIN), 0.125f * LOG2E, ETBL};
        const int c = (int)blockIdx.x, cm = (G % 8 == 0) ? ((c & 7) | ((G / 8 - 1 - (c >> 3)) << 3)) : c;
        pg8::Gemm g{(const bf16_t*)(ws + WS_CQ), (const bf16_t*)(ws + WS_WUQ), TOK, 1536, 256}; pg8::StaticOrder S; S.init(TOK, 1536, G, cm);
        qup_wait_rows(S, (unsigned*)(ws + WS_CTL) + CTL_ROWCNT, (unsigned*)(ws + WS_CTL) + XB_TMO);
        pg8::gemm_phase<EpiQup, pg8::StaticOrder, true, true>(lds, g, S, E, wave, fresh_lane()); } }
    SEAM(P_QUP);
    if (IN(P_IDX)) { for (int rep_ = 0; rep_ < NREP(P_IDX); ++rep_) { idx_phase(lds, wave, ws); } }
    SEAM(P_IDX);
    if (IN(P_ATT1)) { for (int rep_ = NREP(P_ATT1) - 1; rep_ >= 0; --rep_) attn1_phase(lds, wave, ws, rep_ != 0); }
    SEAM(P_ATT1);
    if (IN(P_OUT1)) { EpiResidT<true, false> E{nullptr, XB, nullptr, XB, PART}; run_gemm(lds, wave, QB, (const bf16_t*)(ws + WS_WOUT1), DM, DM, E); }
    SEAM(P_OUT1);
    if (IN(P_UP1)) { for (int rep_ = 0; rep_ < NREP(P_UP1); ++rep_) { EpiUp E{PART, UB, ETBL}; run_gemm(lds, wave, XB, (const bf16_t*)(ws + WS_W1_1), DFF, DM, E); } }
    SEAM(P_UP1);
    if (IN(P_DN1)) { EpiResidT<true, true> E{nullptr, XB, args.out, nullptr, nullptr}; run_gemm(lds, wave, UB, (const bf16_t*)(ws + WS_W2_1), DM, DFF, E); }
#undef IN
#undef SEAM
}

static int g_mk_ready = 0;
static void mk_launch(hipStream_t st, void* const* d_in, void* d_out, void* d_ws, int lo, int hi, int coop) {
    if (!g_mk_ready) { (void)hipFuncSetAttribute((const void*)mk_fwd, hipFuncAttributeMaxDynamicSharedMemorySize, LDS_BYTES); g_mk_ready = 1; }
    Args a{};
    for (int i = 0; i < 22; ++i) a.in[i] = (const float*)d_in[i];
    a.out = (float*)d_out; a.ws = (unsigned char*)d_ws; a.ph_lo = lo; a.ph_hi = hi; a.coop = coop; a.pad = 0;
    hipLaunchKernelGGL(mk_fwd, dim3(256), dim3(NWAVES * 64), LDS_BYTES, st, a);
}

extern "C" void kernel_launch(void* const* d_in, const int* in_sizes, int n_in, void* d_out, int out_size, void* d_ws, size_t ws_size, hipStream_t stream) {
    static int grid = 0;
    if (grid == 0) {
        int dev = 0, cus = 0, per_cu = 0;
        (void)hipGetDevice(&dev);
        (void)hipDeviceGetAttribute(&cus, hipDeviceAttributeMultiprocessorCount, dev);
        (void)hipFuncSetAttribute((const void*)mk_fwd, hipFuncAttributeMaxDynamicSharedMemorySize, LDS_BYTES);
        (void)hipOccupancyMaxActiveBlocksPerMultiprocessor(&per_cu, (const void*)mk_fwd, NWAVES * 64, LDS_BYTES);
        if (per_cu < 1) per_cu = 1;
        if (per_cu > 1) per_cu = 1;
        grid = cus * per_cu; if (grid > 256) grid = 256; if (grid < 1) grid = 1;
        if (ws_size < WS_END) { fprintf(stderr, "kernel_launch: workspace too small (%zu)\n", ws_size); }
    }
    (void)hipMemsetAsync((char*)d_ws + WS_CTL, 0, CTL_BYTES, stream);
    Args a{};
    for (int i = 0; i < 22; ++i) a.in[i] = (const float*)d_in[i];
    a.out = (float*)d_out; a.ws = (unsigned char*)d_ws; a.ph_lo = 0; a.ph_hi = P_N; a.coop = 1; a.pad = 0;
    void* kargs[] = {&a};
    hipError_t e = hipLaunchCooperativeKernel((const void*)mk_fwd, dim3(grid), dim3(NWAVES * 64), kargs, LDS_BYTES, stream);
    if (e != hipSuccess) fprintf(stderr, "cooperative launch failed: %s (grid %d)\n", hipGetErrorString(e), grid);
}
```

```cpp
#include <hip/hip_runtime.h>
#include <stdint.h>
#include <math.h>
#include <stdio.h>
#ifndef PROBE_PHASE
#define PROBE_PHASE (-1)
#endif
#define LAS __attribute__((address_space(3)))
#define GAS __attribute__((address_space(1)))
typedef unsigned short bf16_t;
typedef short bf16x8 __attribute__((ext_vector_type(8)));
typedef float f32x4 __attribute__((ext_vector_type(4)));
typedef float f32x16 __attribute__((ext_vector_type(16)));
typedef unsigned u32x4 __attribute__((ext_vector_type(4)));
typedef unsigned u32x2 __attribute__((ext_vector_type(2)));

constexpr int BATCH = 2, SEQ = 8192, DM = 1024, DFF = 4096, TOK = BATCH * SEQ;
constexpr float EPS = 1e-6f;
constexpr float LOG2E = 1.4426950408889634f;
constexpr int NIN1 = 2376, NIN1P = 2560;
constexpr size_t MiB = 1u << 20;
constexpr size_t WS_XB = 0, WS_Q = 32 * MiB, WS_K = 64 * MiB, WS_V = 96 * MiB, WS_U = 32 * MiB;
constexpr size_t WS_CQ = 160 * MiB, WS_QI = 168 * MiB, WS_KI = 184 * MiB, WS_MASK = 186 * MiB;
constexpr size_t WS_CS = 204 * MiB, WS_MISC = 205 * MiB, WS_PART = 206 * MiB, WS_CQP = 207 * MiB, WS_WIDX = 207 * MiB + 256 * 1024;
constexpr size_t WS_QIN = WS_MISC + 512 * 1024;
constexpr size_t WS_CTL = WS_MISC + 4096;
constexpr size_t CTL_BYTES = 64 * 1024;
constexpr size_t WS_WIN0 = 208 * MiB, WS_WOUT0 = 214 * MiB, WS_W1_0 = 216 * MiB, WS_W2_0 = 224 * MiB, WS_WIN1 = 232 * MiB, WS_WUQ = 237 * MiB,
                 WS_WOUT1 = 238 * MiB, WS_W1_1 = 240 * MiB, WS_W2_1 = 248 * MiB, WS_END = 256 * MiB;

__device__ __forceinline__ unsigned cvt_pk_bf16(float lo, float hi) {
    typedef float f32x2_t __attribute__((ext_vector_type(2))); typedef __bf16 bf16x2_t __attribute__((ext_vector_type(2)));
    f32x2_t v = {lo, hi}; bf16x2_t b = __builtin_convertvector(v, bf16x2_t); return __builtin_bit_cast(unsigned, b);
}
__host__ __device__ __forceinline__ int tile_pos(int cl) { const int wc = cl >> 6, fq = (cl >> 4) & 3, bj = (cl >> 3) & 1, n = (cl >> 2) & 1, j = cl & 3; return 128 * bj + 32 * wc + 16 * n + 4 * fq + j; }
__device__ __forceinline__ int fresh_lane() { int l; asm volatile("v_mbcnt_lo_u32_b32 %0, -1, 0\n\tv_mbcnt_hi_u32_b32 %0, -1, %0" : "=v"(l)); return l; }
__device__ __forceinline__ float wave_sum(float v) {
#pragma unroll
    for (int o = 1; o < 64; o <<= 1) v += __shfl_xor(v, o);
    return v;
}
namespace pg8 {
#define PG8_LAS __attribute__((address_space(3)))
typedef unsigned short bf16_t;
typedef short bf16x8 __attribute__((ext_vector_type(8)));
typedef float f32x4 __attribute__((ext_vector_type(4)));
typedef unsigned u32x4 __attribute__((ext_vector_type(4)));
constexpr int BM = 256, BK = 64, HALF = 128, HTB = HALF * BK * 2  , STAGE_BYTES = 8 * HTB, NXCD = 8, WGM = 8;

__host__ __device__ __forceinline__ int lds_byte(int r, int c) { const int st = (r >> 4) * 2 + (c >> 5), rr = r & 15, cc = c & 31, ob = rr * 64 + cc * 2; return st * 1024 + (ob ^ (((ob >> 9) & 1) << 5)); }
__host__ __device__ __forceinline__ void stage_rc(int b, int& R, int& C) { const int st = b / 1024, sb = b % 1024, swz = sb ^ (((sb >> 9) & 1) << 5); R = (st >> 1) * 16 + swz / 64; C = (st & 1) * 32 + (swz % 64) / 2; }
__host__ __device__ __forceinline__ int perm32(int rho) { const int n = rho >> 4, i = rho & 15; return 8 * (i >> 2) + 4 * n + (i & 3); }

struct Unit { int pm, pn; };
struct Gemm { const bf16_t* A; const bf16_t* Bt; int M, N, K; };

struct StaticOrder {
    int nM, nN, nwg, G, c;
    __host__ __device__ void init(int M, int N, int G_, int c_) { nM = M / BM; nN = N / BM; nwg = nM * nN; G = G_; c = c_; }
    __host__ __device__ bool next(int i, Unit& u) const {
        const long L = (long)i * G + c; if (L >= nwg) return false;
        int wgid = (int)L; { const int q = nwg / NXCD, r = nwg % NXCD, xcd = wgid % NXCD, off = wgid / NXCD; wgid = (xcd < r ? xcd * (q + 1) : r * (q + 1) + (xcd - r) * q) + off; }
        const int nig = WGM * nN, gid = wgid / nig, fm = gid * WGM, gsz = (nM - fm) < WGM ? (nM - fm) : WGM;
        u.pm = fm + ((wgid % nig) % gsz); u.pn = (wgid % nig) / gsz; return true;
    }
    __device__ __forceinline__ void a_ready(const Unit&) const {}
    __device__ __forceinline__ void done(const Unit&) const {}
};

__device__ __forceinline__ unsigned cvt_pk_bf16(float lo, float hi) { unsigned r; asm volatile("v_cvt_pk_bf16_f32 %0, %1, %2" : "=v"(r) : "v"(lo), "v"(hi)); return r; }
typedef float f32x2 __attribute__((ext_vector_type(2)));
template <class Epi, class Sched, bool ALIGN_EPI = false, bool SP2 = false>
__device__ __forceinline__ void gemm_phase(PG8_LAS unsigned char* lds, const Gemm g, const Sched& S, const Epi& E, const int wid, const int lane) {
    const int tid = wid * 64 + lane, wr = wid >> 2, wc = wid & 3, fr = lane & 15, fq = lane >> 4;
    const int K = g.K, nt = K / BK;
    unsigned voffA[2], voffB[2];
#pragma unroll
    for (int i = 0; i < 2; ++i) { int R, C; stage_rc(tid * 16 + i * 8192, R, C); const int Rb = Epi::PERM ? ((R & ~31) + perm32(R & 31)) : R;
        voffA[i] = (unsigned)(R * K + C) * 2u; voffB[i] = (unsigned)(Rb * K + C) * 2u; }
    const size_t kstep = (size_t)(BK * 2);
    const size_t hstep = (size_t)HALF * K * 2;
    const size_t tstep = 2 * hstep;
    const unsigned ldsw = (unsigned)wid * 1024u;
    const int aoff = lds_byte(wr * 64 + fr, fq * 8), boff = lds_byte(wc * 32 + fr, fq * 8);
#define PG8_SA(b, h) (((b) * 2 + (h)) * HTB)
#define PG8_SB(b, h) ((4 + (b) * 2 + (h)) * HTB)
#define PG8_STAGE(bufoff, gbase, voff) do { _Pragma("unroll") for (int _i = 0; _i < 2; ++_i) \
        __builtin_amdgcn_global_load_lds((const unsigned*)((const char*)(gbase) + (voff)[_i]), (PG8_LAS unsigned*)(lds + (bufoff) + ldsw + _i * 8192), 16, 0, 0); } while (0)
#define PG8_LDA(dst, b, h) do { _Pragma("unroll") for (int m = 0; m < 4; ++m) _Pragma("unroll") for (int k = 0; k < 2; ++k) dst[m][k] = *(const PG8_LAS bf16x8*)(lds + PG8_SA(b, h) + aoff + m * 2048 + k * 1024); } while (0)
#define PG8_LDB(dst, b, h) do { _Pragma("unroll") for (int n = 0; n < 2; ++n) _Pragma("unroll") for (int k = 0; k < 2; ++k) dst[n][k] = *(const PG8_LAS bf16x8*)(lds + PG8_SB(b, h) + boff + n * 2048 + k * 1024); } while (0)
#define PG8_MMA(ai, bj, At, Bt) do { __builtin_amdgcn_s_setprio(1); _Pragma("unroll") for (int m = 0; m < 4; ++m) _Pragma("unroll") for (int n = 0; n < 2; ++n) _Pragma("unroll") for (int k = 0; k < 2; ++k) \
        acc[ai][bj][m][n] = __builtin_amdgcn_mfma_f32_16x16x32_bf16(Bt[n][k], At[m][k], acc[ai][bj][m][n], 0, 0, 0); __builtin_amdgcn_s_setprio(0); } while (0)
#define PG8_WAIT_V(n) asm volatile("s_waitcnt vmcnt(" #n ")" ::: "memory")
#define PG8_WAIT_L(n) asm volatile("s_waitcnt lgkmcnt(" #n ")" ::: "memory")
#define PG8_BAR __builtin_amdgcn_s_barrier()
#define PG8_SCHED __builtin_amdgcn_sched_barrier(0)
    Unit cur, nxt; int ui = 0;
    if (!S.next(0, cur)) return;
    f32x4 acc[2][2][4][2];
#pragma unroll
    for (int a = 0; a < 2; ++a)
#pragma unroll
        for (int b = 0; b < 2; ++b)
#pragma unroll
            for (int m = 0; m < 4; ++m)
#pragma unroll
                for (int n = 0; n < 2; ++n) acc[a][b][m][n] = (f32x4){0.f, 0.f, 0.f, 0.f};
    bf16x8 At[4][2], B0[2][2], B1[2][2];
    const char* cA = (const char*)g.A + (size_t)cur.pm * tstep; const char* cB = (const char*)g.Bt + (size_t)cur.pn * tstep;
    S.a_ready(cur);
    if constexpr (SP2) {
        PG8_STAGE(PG8_SB(0, 0), cB, voffB); PG8_STAGE(PG8_SB(0, 1), cB + hstep, voffB); PG8_STAGE(PG8_SA(0, 0), cA, voffA); PG8_STAGE(PG8_SA(0, 1), cA + hstep, voffA);
        if (wr == 1) PG8_BAR;
        PG8_WAIT_V(2); PG8_BAR;
        PG8_STAGE(PG8_SB(1, 0), cB + kstep, voffB); PG8_STAGE(PG8_SA(1, 0), cA + kstep, voffA); PG8_STAGE(PG8_SB(1, 1), cB + hstep + kstep, voffB);
        PG8_WAIT_V(6); PG8_BAR;
    } else {
        PG8_STAGE(PG8_SB(0, 0), cB, voffB); PG8_STAGE(PG8_SA(0, 0), cA, voffA); PG8_STAGE(PG8_SB(0, 1), cB + hstep, voffB); PG8_STAGE(PG8_SA(0, 1), cA + hstep, voffA);
        if (wr == 1) PG8_BAR;
        PG8_WAIT_V(4); PG8_BAR;
        PG8_STAGE(PG8_SB(1, 0), cB + kstep, voffB); PG8_STAGE(PG8_SA(1, 0), cA + kstep, voffA); PG8_STAGE(PG8_SB(1, 1), cB + hstep + kstep, voffB);
        PG8_WAIT_V(6); PG8_BAR;
    }
    for (;;) {
        const bool has_next = S.next(ui + 1, nxt);
        const char* nA = has_next ? (const char*)g.A + (size_t)nxt.pm * tstep : cA; const char* nB = has_next ? (const char*)g.Bt + (size_t)nxt.pn * tstep : cB;
        for (int t = 0; t < nt; t += 2) {
            const bool last = (t == nt - 2);
            const char* a1 = cA + (size_t)(t + 1) * kstep;
            const char* a2 = last ? nA : cA + (size_t)(t + 2) * kstep; const char* b2 = last ? nB : cB + (size_t)(t + 2) * kstep;
            const char* a3 = a2 + kstep; const char* b3 = b2 + kstep;
            if (last && has_next) S.a_ready(nxt);
            if constexpr (SP2) {
            PG8_LDB(B0, 0, 0); PG8_LDB(B1, 0, 1); PG8_SCHED; PG8_LDA(At, 0, 0); PG8_STAGE(PG8_SA(1, 1), a1 + hstep, voffA);
            PG8_WAIT_V(8); PG8_WAIT_L(0); PG8_BAR; PG8_MMA(0, 0, At, B0); PG8_MMA(0, 1, At, B1); PG8_BAR; PG8_SCHED;
            PG8_LDA(At, 0, 1); PG8_STAGE(PG8_SB(0, 0), b2, voffB); PG8_STAGE(PG8_SB(0, 1), b2 + hstep, voffB); PG8_STAGE(PG8_SA(0, 0), a2, voffA);
            PG8_WAIT_V(8); PG8_WAIT_L(0); PG8_BAR; PG8_MMA(1, 0, At, B0); PG8_MMA(1, 1, At, B1); PG8_BAR; PG8_SCHED;
            PG8_LDB(B0, 1, 0); PG8_LDB(B1, 1, 1); PG8_SCHED; PG8_LDA(At, 1, 0); PG8_STAGE(PG8_SA(0, 1), a2 + hstep, voffA);
            PG8_WAIT_V(8); PG8_WAIT_L(0); PG8_BAR; PG8_MMA(0, 0, At, B0); PG8_MMA(0, 1, At, B1); PG8_BAR; PG8_SCHED;
            PG8_LDA(At, 1, 1); PG8_STAGE(PG8_SB(1, 0), b3, voffB); PG8_STAGE(PG8_SB(1, 1), b3 + hstep, voffB); PG8_STAGE(PG8_SA(1, 0), a3, voffA);
            PG8_WAIT_V(8); PG8_WAIT_L(0); PG8_BAR; PG8_MMA(1, 0, At, B0); PG8_MMA(1, 1, At, B1); PG8_BAR; PG8_SCHED;
            } else {
            PG8_LDB(B0, 0, 0); PG8_SCHED; PG8_LDA(At, 0, 0); PG8_STAGE(PG8_SA(1, 1), a1 + hstep, voffA);
            PG8_WAIT_L(8); PG8_BAR; PG8_WAIT_L(0); PG8_MMA(0, 0, At, B0); PG8_BAR; PG8_SCHED;
            PG8_LDB(B1, 0, 1); PG8_STAGE(PG8_SB(0, 0), b2, voffB);
            PG8_BAR; PG8_WAIT_L(0); PG8_MMA(0, 1, At, B1); PG8_BAR;
            PG8_LDA(At, 0, 1); PG8_STAGE(PG8_SA(0, 0), a2, voffA);
            PG8_BAR; PG8_WAIT_L(0); PG8_MMA(1, 0, At, B0); PG8_BAR; PG8_SCHED;
            PG8_STAGE(PG8_SB(0, 1), b2 + hstep, voffB);
            PG8_WAIT_V(6); PG8_BAR; PG8_MMA(1, 1, At, B1); PG8_BAR;
            PG8_LDB(B0, 1, 0); PG8_SCHED; PG8_LDA(At, 1, 0); PG8_STAGE(PG8_SA(0, 1), a2 + hstep, voffA);
            PG8_WAIT_L(8); PG8_BAR; PG8_WAIT_L(0); PG8_MMA(0, 0, At, B0); PG8_BAR; PG8_SCHED;
            PG8_LDB(B1, 1, 1); PG8_STAGE(PG8_SB(1, 0), b3, voffB);
            PG8_BAR; PG8_WAIT_L(0); PG8_MMA(0, 1, At, B1); PG8_BAR;
            PG8_LDA(At, 1, 1); PG8_STAGE(PG8_SA(1, 0), a3, voffA);
            PG8_BAR; PG8_WAIT_L(0); PG8_MMA(1, 0, At, B0); PG8_BAR; PG8_SCHED;
            PG8_STAGE(PG8_SB(1, 1), b3 + hstep, voffB);
            PG8_WAIT_V(6); PG8_BAR; PG8_MMA(1, 1, At, B1); PG8_BAR;
            }
        }
        if constexpr (ALIGN_EPI) { if (wr == 0) PG8_BAR; }
        if constexpr (!Epi::AFTER_DRAIN) { const int le = fresh_lane(); E(acc, cur, wr, wc, le & 15, le >> 4); S.done(cur); }
        if (!has_next) break;
#pragma unroll
        for (int a = 0; a < 2; ++a)
#pragma unroll
            for (int b = 0; b < 2; ++b)
#pragma unroll
                for (int m = 0; m < 4; ++m)
#pragma unroll
                    for (int n = 0; n < 2; ++n) acc[a][b][m][n] = (f32x4){0.f, 0.f, 0.f, 0.f};
        cur = nxt; cA = nA; cB = nB; ++ui;
        if constexpr (ALIGN_EPI) { if (wr == 1) PG8_BAR; }
    }
    PG8_WAIT_V(0);
    if constexpr (!ALIGN_EPI) { if (wr == 0) PG8_BAR; }
    PG8_BAR;
    if constexpr (Epi::AFTER_DRAIN) { E.fused(acc, cur, wr, wc, fr, fq, lds, wid, lane); S.done(cur); }
#undef PG8_SA
#undef PG8_SB
#undef PG8_STAGE
#undef PG8_LDA
#undef PG8_LDB
#undef PG8_MMA
#undef PG8_WAIT_V
#undef PG8_WAIT_L
#undef PG8_BAR
#undef PG8_SCHED
}
}
typedef f32x4 acc_t[2][2][4][2];

__device__ __forceinline__ float rstd_from_parts16(const float* __restrict__ part, int row) {
    const f32x4* p = (const f32x4*)(part + (size_t)row * 16);
    const f32x4 a = p[0], b = p[1], c = p[2], d = p[3];
    const float s = ((a[0] + a[1]) + (a[2] + a[3])) + ((b[0] + b[1]) + (b[2] + b[3])) + ((c[0] + c[1]) + (c[2] + c[3])) + ((d[0] + d[1]) + (d[2] + d[3]));
    return 1.0f / sqrtf(s * (1.0f / 1024.0f) + EPS);
}
constexpr int EPI_TBL_OFF = 131072;
__device__ __forceinline__ void fill_rstd16(LAS float* T, const float* __restrict__ part, int pm, int wr, int lane) {
    const float r0 = rstd_from_parts16(part, pm * 256 + wr * 64 + lane), r1 = rstd_from_parts16(part, pm * 256 + 128 + wr * 64 + lane);
    T[lane] = r0; T[64 + lane] = r1;
}
__device__ __forceinline__ float quad_sum(float s) { s += __shfl_xor(s, 16); s += __shfl_xor(s, 32); return s; }
__device__ __forceinline__ float sumsq16(const f32x4 (&v)[2][2]) {
    float s = 0.f;
#pragma unroll
    for (int bj = 0; bj < 2; ++bj)
#pragma unroll
        for (int n = 0; n < 2; ++n) s += (v[bj][n][0] * v[bj][n][0] + v[bj][n][1] * v[bj][n][1]) + (v[bj][n][2] * v[bj][n][2] + v[bj][n][3] * v[bj][n][3]);
    return s;
}
__device__ __forceinline__ void head_norm_rope(f32x4 (&v)[2][2], bool do_norm, bool use_gain, const f32x4 (&g)[2][2], const float* __restrict__ cs_row, int fq, float scale) {
    if (do_norm) {
        const float ss = quad_sum(sumsq16(v));
        const float rn = 1.0f / sqrtf(ss * (1.0f / 64.0f) + EPS);
#pragma unroll
        for (int bj = 0; bj < 2; ++bj)
#pragma unroll
            for (int n = 0; n < 2; ++n) { v[bj][n] = v[bj][n] * rn; if (use_gain) v[bj][n] = v[bj][n] * g[bj][n]; }
    }
    if (fq == 0) {
        const f32x4* c4 = (const f32x4*)cs_row;
#pragma unroll
        for (int n = 0; n < 2; ++n) {
            const f32x4 c = c4[n], s = c4[2 + n];
            const f32x4 x1 = v[0][n], x2 = v[1][n];
            v[0][n] = x1 * c - x2 * s;
            v[1][n] = x2 * c + x1 * s;
        }
    }
    if (scale != 1.0f) {
#pragma unroll
        for (int bj = 0; bj < 2; ++bj)
#pragma unroll
            for (int n = 0; n < 2; ++n) v[bj][n] = v[bj][n] * scale;
    }
}
__device__ __forceinline__ void store_bf16x16(bf16_t* p, const f32x4 (&v)[2][2]) {
#pragma unroll
    for (int bj = 0; bj < 2; ++bj) {
        u32x4 w; w.x = cvt_pk_bf16(v[bj][0][0], v[bj][0][1]); w.y = cvt_pk_bf16(v[bj][0][2], v[bj][0][3]); w.z = cvt_pk_bf16(v[bj][1][0], v[bj][1][1]); w.w = cvt_pk_bf16(v[bj][1][2], v[bj][1][3]);
        *(u32x4*)(p + 8 * bj) = w;
    }
}
__device__ __forceinline__ void load_gain16(f32x4 (&g)[2][2], const float* __restrict__ gp, int fq) {
#pragma unroll
    for (int bj = 0; bj < 2; ++bj)
#pragma unroll
        for (int n = 0; n < 2; ++n) g[bj][n] = *(const f32x4*)(gp + 16 * fq + 8 * bj + 4 * n);
}

struct EpiQKV0 {
    static constexpr bool PERM = false, AFTER_DRAIN = false;
    const float* part; const float* cs; const float* qg; const float* kg; bf16_t* QKV; size_t stride; float qscale; LAS float* T;
    mutable int last_pm = -1;
    __device__ __forceinline__ void operator()(const acc_t& acc, const pg8::Unit& u, int wr, int wc, int fr, int fq) const {
        const int kind = u.pn >> 2, head = (u.pn & 3) * 4 + wc;
        bf16_t* dst = QKV + (size_t)kind * stride + head * 64 + 16 * fq;
        f32x4 g[2][2] = {};
        if (kind < 2) load_gain16(g, kind == 0 ? qg : kg, fq);
        if (u.pm != last_pm) { fill_rstd16(T, part, u.pm, wr, fr + 16 * fq); last_pm = u.pm; }
#pragma unroll
        for (int ai = 0; ai < 2; ++ai)
#pragma unroll
            for (int m = 0; m < 4; ++m) {
                const int row = u.pm * 256 + ai * 128 + wr * 64 + m * 16 + fr;
                const float rs = T[ai * 64 + m * 16 + fr];
                f32x4 v[2][2];
#pragma unroll
                for (int bj = 0; bj < 2; ++bj)
#pragma unroll
                    for (int n = 0; n < 2; ++n) v[bj][n] = acc[ai][bj][m][n] * rs;
                if (kind < 2) head_norm_rope(v, true, true, g, cs + (size_t)row * 16, fq, kind == 0 ? qscale : 1.0f);
                store_bf16x16(dst + (size_t)row * DM, v);
            }
    }
};
template <bool RES_BF16, bool OUT_F32> struct EpiResidT {
    static constexpr bool PERM = false, AFTER_DRAIN = false;
    const float* R; const bf16_t* Rb; float* out; bf16_t* xb; float* part;
    __device__ __forceinline__ void operator()(const acc_t& acc, const pg8::Unit& u, int wr, int wc, int fr, int fq) const {
        const int col0 = u.pn * 256 + wc * 64 + 16 * fq;
#pragma unroll
        for (int ai = 0; ai < 2; ++ai)
#pragma unroll
            for (int m = 0; m < 4; ++m) {
                const int row = u.pm * 256 + ai * 128 + wr * 64 + m * 16 + fr;
                const size_t off = (size_t)row * DM + col0;
                f32x4 v[2][2];
                if (RES_BF16) {
#pragma unroll
                    for (int bj = 0; bj < 2; ++bj) {
                        const u32x4 w = *(const u32x4*)(Rb + off + 8 * bj);
                        const unsigned ww[4] = {w.x, w.y, w.z, w.w};
#pragma unroll
                        for (int n = 0; n < 2; ++n) {
                            f32x4 r; r[0] = __builtin_bit_cast(float, ww[2 * n] << 16); r[1] = __builtin_bit_cast(float, ww[2 * n] & 0xffff0000u);
                            r[2] = __builtin_bit_cast(float, ww[2 * n + 1] << 16); r[3] = __builtin_bit_cast(float, ww[2 * n + 1] & 0xffff0000u);
                            v[bj][n] = r + acc[ai][bj][m][n];
                        }
                    }
                } else {
#pragma unroll
                    for (int bj = 0; bj < 2; ++bj)
#pragma unroll
                        for (int n = 0; n < 2; ++n) v[bj][n] = *(const f32x4*)(R + off + 8 * bj + 4 * n) + acc[ai][bj][m][n];
                }
                if (OUT_F32) {
#pragma unroll
                    for (int bj = 0; bj < 2; ++bj)
#pragma unroll
                        for (int n = 0; n < 2; ++n) *(f32x4*)(out + off + 8 * bj + 4 * n) = v[bj][n];
                }
                if (xb) store_bf16x16(xb + off, v);
                if (part) { const float ss = quad_sum(sumsq16(v)); if (fq == 0) part[(size_t)row * 16 + u.pn * 4 + wc] = ss; }
            }
    }
};
struct EpiUp {
    static constexpr bool PERM = false, AFTER_DRAIN = false;
    const float* part; bf16_t* U; LAS float* T;
    mutable int last_pm = -1;
    __device__ __forceinline__ void operator()(const acc_t& acc, const pg8::Unit& u, int wr, int wc, int fr, int fq) const {
        const int col0 = u.pn * 256 + wc * 64 + 16 * fq;
        if (u.pm != last_pm) { fill_rstd16(T, part, u.pm, wr, fr + 16 * fq); last_pm = u.pm; }
#pragma unroll
        for (int ai = 0; ai < 2; ++ai)
#pragma unroll
            for (int m = 0; m < 4; ++m) {
                const int row = u.pm * 256 + ai * 128 + wr * 64 + m * 16 + fr;
                const float rs = T[ai * 64 + m * 16 + fr];
                f32x4 v[2][2];
#pragma unroll
                for (int bj = 0; bj < 2; ++bj)
#pragma unroll
                    for (int n = 0; n < 2; ++n) {
                        f32x4 t = acc[ai][bj][m][n] * rs;
#pragma unroll
                        for (int j = 0; j < 4; ++j) { const float r = fmaxf(t[j], 0.f); t[j] = r * r; }
                        v[bj][n] = t;
                    }
                store_bf16x16(U + (size_t)row * DFF + col0, v);
            }
    }
};
struct EpiIn1 {
    static constexpr bool PERM = false, AFTER_DRAIN = false;
    const float* part; const float* cs; const float* kg; bf16_t* CQ; float* cqp; bf16_t* K; bf16_t* V; bf16_t* KI; float* widx; float wscale; LAS float* T;
    mutable int last_pm = -1;
    __device__ __forceinline__ void operator()(const acc_t& acc, const pg8::Unit& u, int wr, int wc, int fr, int fq) const {
        const int pn = u.pn;
        if (pn == 9 && wc >= 2) return;
        f32x4 g[2][2] = {};
        if (pn >= 1 && pn <= 4) load_gain16(g, kg, fq);
        if (u.pm != last_pm) { fill_rstd16(T, part, u.pm, wr, fr + 16 * fq); last_pm = u.pm; }
#pragma unroll
        for (int ai = 0; ai < 2; ++ai)
#pragma unroll
            for (int m = 0; m < 4; ++m) {
                const int row = u.pm * 256 + ai * 128 + wr * 64 + m * 16 + fr;
                const float rs = T[ai * 64 + m * 16 + fr];
                f32x4 v[2][2];
#pragma unroll
                for (int bj = 0; bj < 2; ++bj)
#pragma unroll
                    for (int n = 0; n < 2; ++n) v[bj][n] = acc[ai][bj][m][n] * rs;
                if (pn == 0) {
                    store_bf16x16(CQ + (size_t)row * 256 + wc * 64 + 16 * fq, v);
                    const float ss = quad_sum(sumsq16(v)); if (fq == 0) cqp[(size_t)row * 4 + wc] = ss;
                } else if (pn <= 4) {
                    head_norm_rope(v, true, true, g, cs + (size_t)row * 16, fq, 1.0f);
                    store_bf16x16(K + (size_t)row * DM + ((pn - 1) * 4 + wc) * 64 + 16 * fq, v);
                } else if (pn <= 8) {
                    store_bf16x16(V + (size_t)row * DM + ((pn - 5) * 4 + wc) * 64 + 16 * fq, v);
                } else if (wc == 0) {
                    head_norm_rope(v, true, false, g, cs + (size_t)row * 16, fq, 1.0f);
                    store_bf16x16(KI + (size_t)row * 64 + 16 * fq, v);
                } else if (fq == 0) {
                    *(f32x4*)(widx + (size_t)row * 8) = v[0][0] * wscale; *(f32x4*)(widx + (size_t)row * 8 + 4) = v[0][1] * wscale;
                }
            }
    }
};
struct EpiQup {
    static constexpr bool PERM = false, AFTER_DRAIN = false;
    const float* cqp; const float* cs; const float* qg; const float* widx; bf16_t* Q; bf16_t* QI; float* qin; float qscale; LAS float* T;
    __device__ __forceinline__ void operator()(const acc_t& acc, const pg8::Unit& u, int wr, int wc, int fr, int fq) const {
        const int pn = u.pn;
        f32x4 g[2][2] = {};
        if (pn < 4) load_gain16(g, qg, fq);
        { const int lane = fr + 16 * fq;
          const f32x4 c0 = *(const f32x4*)(cqp + (size_t)(u.pm * 256 + wr * 64 + lane) * 4), c1 = *(const f32x4*)(cqp + (size_t)(u.pm * 256 + 128 + wr * 64 + lane) * 4);
          T[lane] = 1.0f / sqrtf(((c0[0] + c0[1]) + (c0[2] + c0[3])) * (1.0f / 256.0f) + EPS); T[64 + lane] = 1.0f / sqrtf(((c1[0] + c1[1]) + (c1[2] + c1[3])) * (1.0f / 256.0f) + EPS); }
#pragma unroll
        for (int ai = 0; ai < 2; ++ai)
#pragma unroll
            for (int m = 0; m < 4; ++m) {
                const int row = u.pm * 256 + ai * 128 + wr * 64 + m * 16 + fr;
                const float rs = T[ai * 64 + m * 16 + fr];
                f32x4 v[2][2];
#pragma unroll
                for (int bj = 0; bj < 2; ++bj)
#pragma unroll
                    for (int n = 0; n < 2; ++n) v[bj][n] = acc[ai][bj][m][n] * rs;
                if (pn < 4) {
                    head_norm_rope(v, true, true, g, cs + (size_t)row * 16, fq, qscale);
                    store_bf16x16(Q + (size_t)row * DM + (pn * 4 + wc) * 64 + 16 * fq, v);
                } else {
                    const int hh = (pn - 4) * 4 + wc;
                    head_norm_rope(v, false, false, g, cs + (size_t)row * 16, fq, 1.0f);
                    const float nrm = sqrtf(quad_sum(sumsq16(v)));
                    const float inv = nrm > 0.f ? 1.0f / (8.2f * nrm) : 0.f;
#pragma unroll
                    for (int bj = 0; bj < 2; ++bj)
#pragma unroll
                        for (int n = 0; n < 2; ++n) v[bj][n] = v[bj][n] * inv;
                    store_bf16x16(QI + (size_t)row * 512 + hh * 64 + 16 * fq, v);
                    if (fq == 0) qin[(size_t)row * 8 + hh] = widx[(size_t)row * 8 + hh] * (8.2f * nrm);
                }
            }
    }
};
typedef GAS unsigned gu32;
#define RLX_AGENT __ATOMIC_RELAXED, __HIP_MEMORY_SCOPE_AGENT
#define LDS_WAIT() asm volatile("s_waitcnt lgkmcnt(0)" ::: "memory")
#define VM_WAIT() asm volatile("s_waitcnt vmcnt(0)" ::: "memory")

constexpr int RING_BYTES = 143360;
constexpr int MISC_OFF = RING_BYTES + 320;
constexpr int LDS_BYTES = 147456;
constexpr int NWAVES = 8;

#define XB_TMO      128
#define XB_XCNT(j)  (256  + 64 * (j))
#define XB_XSUB(j)  (1280 + 64 * (j))
#define XB_XGEN(j)  (2304 + 64 * (j))
#define XB_TOP      3328
#define XB_TOPGEN   3392
#define XCD_BAR_WORDS 3456
#define XB_SPIN_CAP (1u << 18)
__device__ __forceinline__ unsigned xb_ld(unsigned* p)              { return __hip_atomic_load(p, __ATOMIC_RELAXED, __HIP_MEMORY_SCOPE_AGENT); }
__device__ __forceinline__ unsigned xb_add(unsigned* p, unsigned v) { return __hip_atomic_fetch_add(p, v, __ATOMIC_RELAXED, __HIP_MEMORY_SCOPE_AGENT); }
__device__ __forceinline__ unsigned xb_xcc_id() { return (unsigned)__builtin_amdgcn_s_getreg((3 << 11) | 20) & 0xFu; }
#define XB_SPIN(cond, bar) do { unsigned _sp = 0; while (cond) { __builtin_amdgcn_s_sleep(1); \
    if ((++_sp & 255u) == 0u) { if (xb_ld(&(bar)[XB_TMO])) break; if (_sp > XB_SPIN_CAP) { atomicAdd(&(bar)[XB_TMO], 1u); break; } } } } while (0)
struct XcdBarrier { unsigned* bar; unsigned x; volatile LAS unsigned* st; };
__device__ __forceinline__ XcdBarrier xcd_barrier_post(unsigned* bar, volatile LAS unsigned* st) {
    XcdBarrier b; b.bar = bar; b.x = xb_xcc_id(); b.st = st;
    if (threadIdx.x == 0) (void)xb_add(&bar[XB_XCNT(b.x)], 1u);
    return b;
}
__device__ __forceinline__ void xcd_barrier_complete(unsigned* bar, unsigned x, unsigned& nloc, unsigned& nx) {
    const unsigned G = gridDim.x * gridDim.y * gridDim.z;
    unsigned sum, cnt, mine, sp = 0u;
    for (;;) {
        sum = 0u; cnt = 0u; mine = 0u;
#pragma unroll
        for (unsigned j = 0; j < 16; ++j) { const unsigned c = xb_ld(&bar[XB_XCNT(j)]); sum += c; cnt += (c > 0u) ? 1u : 0u; mine = (j == x) ? c : mine; }
        if (sum == G) break;
        __builtin_amdgcn_s_sleep(1);
        if ((++sp & 255u) == 0u) { if (xb_ld(&bar[XB_TMO])) break; if (sp > XB_SPIN_CAP) { atomicAdd(&bar[XB_TMO], 1u); break; } }
    }
    nloc = mine > 0u ? mine : 1u; nx = cnt > 0u ? cnt : 1u;
}
__device__ __forceinline__ void xcd_barrier(const XcdBarrier& b, const int wave) {
    asm volatile("s_waitcnt vmcnt(0)" ::: "memory");
    __syncthreads();
    if (wave == 0 && fresh_lane() == 0) {
        unsigned* bar = b.bar;
        __builtin_amdgcn_s_waitcnt(0);
        unsigned nloc = b.st[0], nx = b.st[1];
        if (nloc == 0u) { xcd_barrier_complete(bar, b.x, nloc, nx); b.st[0] = nloc; b.st[1] = nx; }
        const unsigned old = xb_add(&bar[XB_XSUB(b.x)], 1u);
        const unsigned gen = old / nloc;
        if (old + 1u == (gen + 1u) * nloc) {
            __builtin_amdgcn_fence(__ATOMIC_RELEASE, "agent");
            asm volatile("s_waitcnt vmcnt(0)" ::: "memory");
            const unsigned og = xb_add(&bar[XB_TOP], 1u);
            const unsigned tg = og / nx;
            if (og + 1u == (tg + 1u) * nx) xb_add(&bar[XB_TOPGEN], 1u);
            else XB_SPIN(xb_ld(&bar[XB_TOPGEN]) == tg, bar);
            __builtin_amdgcn_fence(__ATOMIC_ACQUIRE, "agent");
            xb_add(&bar[XB_XGEN(b.x)], 1u);
            asm volatile("s_waitcnt vmcnt(0)" ::: "memory");
        } else {
            XB_SPIN(xb_ld(&bar[XB_XGEN(b.x)]) == gen, bar);
            __builtin_amdgcn_fence(__ATOMIC_ACQUIRE, "agent");
            asm volatile("s_waitcnt vmcnt(0)" ::: "memory");
        }
    }
    __syncthreads();
}

__device__ __forceinline__ unsigned f2bf(float f) { unsigned u = __builtin_bit_cast(unsigned, f); return (u + 0x7fffu + ((u >> 16) & 1u)) >> 16; }
__device__ __forceinline__ unsigned pk2(float lo, float hi) { return f2bf(lo) | (f2bf(hi) << 16); }
__device__ __forceinline__ void p0_transpose_item(const float* __restrict__ W, int K, int N, const float* __restrict__ gain, bf16_t* WT, int row_off, LAS float* scr, int item, int nblk, int lane) {
    const int kb = item / nblk, nb = item % nblk, k0 = 64 * kb, n0 = 32 * nb;
    const int cc = n0 + (lane & 31);
    float wv[32];
#pragma unroll
    for (int i = 0; i < 32; ++i) { const int kk = 2 * i + (lane >> 5); wv[i] = (cc < N) ? W[(size_t)(k0 + kk) * N + cc] : 0.f; }
    if (gain) {
#pragma unroll
        for (int i = 0; i < 32; ++i) wv[i] *= gain[k0 + 2 * i + (lane >> 5)];
    }
#pragma unroll
    for (int i = 0; i < 32; ++i) scr[(2 * i + (lane >> 5)) * 33 + (lane & 31)] = wv[i];
    LDS_WAIT(); asm volatile("" ::: "memory");
    const int c = lane & 7;
#pragma unroll
    for (int j = 0; j < 4; ++j) { const int n = (lane >> 3) + 8 * j; const LAS float* s = scr + (8 * c) * 33 + n;
        u32x4 o; o.x = pk2(s[0 * 33], s[1 * 33]); o.y = pk2(s[2 * 33], s[3 * 33]); o.z = pk2(s[4 * 33], s[5 * 33]); o.w = pk2(s[6 * 33], s[7 * 33]);
        const int cl = n0 + n; const int drow = row_off + (cl & ~255) + tile_pos(cl & 255);
        *(GAS u32x4*)(WT + (size_t)drow * K + k0 + 8 * c) = o; }
    LDS_WAIT(); asm volatile("" ::: "memory");
}
struct WJob { const float* W; const float* gain; bf16_t* WT; int K, N, Npad, row_off; };
template <int NR> __device__ __forceinline__ void rows_to_bf16(const float* x, bf16_t* xb, float* part, int m, int rstride, int lane) {
    f32x4 v[NR][4];
#pragma unroll
    for (int r = 0; r < NR; ++r) { const GAS f32x4* xr = (const GAS f32x4*)(x + (size_t)(m + r * rstride) * DM) + lane;
#pragma unroll
        for (int j = 0; j < 4; ++j) v[r][j] = xr[64 * j]; }
#pragma unroll
    for (int r = 0; r < NR; ++r) {
        float s = 0.f;
#pragma unroll
        for (int j = 0; j < 4; ++j) s += (v[r][j][0] * v[r][j][0] + v[r][j][1] * v[r][j][1]) + (v[r][j][2] * v[r][j][2] + v[r][j][3] * v[r][j][3]);
        s = wave_sum(s);
        GAS u32x2* o8 = (GAS u32x2*)(xb + (size_t)(m + r * rstride) * DM) + lane;
#pragma unroll
        for (int j = 0; j < 4; ++j) { u32x2 w; w.x = cvt_pk_bf16(v[r][j][0], v[r][j][1]); w.y = cvt_pk_bf16(v[r][j][2], v[r][j][3]); o8[64 * j] = w; }
        if (lane < 16) part[(size_t)(m + r * rstride) * 16 + lane] = (lane == 0) ? s : 0.f;
    }
}
constexpr int ATT_SCR = 131072;
constexpr int ATT_NST = 4;
typedef short v4i16_t __attribute__((ext_vector_type(4)));
typedef short s16x4 __attribute__((ext_vector_type(4)));
__device__ __forceinline__ int crow(int r, int hi) { return (r & 3) + 8 * (r >> 2) + 4 * hi; }
__device__ __forceinline__ s16x4 vtr(const LAS unsigned char* p) { return __builtin_bit_cast(s16x4, __builtin_amdgcn_ds_read_tr16_b64_v4i16((LAS v4i16_t*)p)); }
__device__ __forceinline__ void glds16(const void* gsrc, unsigned lds_dst) { unsigned keep;
    asm volatile("s_mov_b32 %0, m0\n\ts_mov_b32 m0, %2\n\ts_nop 0\n\tglobal_load_lds_dwordx4 %1, off\n\ts_mov_b32 m0, %0" : "=&s"(keep) : "v"(gsrc), "s"(lds_dst) : "memory"); }
__device__ __forceinline__ void glds4(const void* gsrc, unsigned lds_dst) { unsigned keep;
    asm volatile("s_mov_b32 %0, m0\n\ts_mov_b32 m0, %2\n\ts_nop 0\n\tglobal_load_lds_dword %1, off\n\ts_mov_b32 m0, %0" : "=&s"(keep) : "v"(gsrc), "s"(lds_dst) : "memory"); }
#define ATT_WAIT_BAR() do { asm volatile("s_waitcnt vmcnt(0) lgkmcnt(0)" ::: "memory"); __builtin_amdgcn_s_barrier(); asm volatile("" ::: "memory"); } while (0)
#define ATT_WAIT_BAR_N(N) do { asm volatile("s_waitcnt vmcnt(" #N ") lgkmcnt(0)" ::: "memory"); __builtin_amdgcn_s_barrier(); asm volatile("" ::: "memory"); } while (0)

__device__ __forceinline__ int att_k_src_chunk(int row, int slot) { return slot ^ ((row >> 1) & 7); }
__device__ __forceinline__ void att_qkt(f32x16& p0, f32x16& p1, const LAS unsigned char* Kslot, const int (&koff)[4], const bf16x8 (&qr)[4]) {
    p0 = (f32x16){}; p1 = (f32x16){};
#pragma unroll
    for (int d0 = 0; d0 < 4; ++d0) {
        const bf16x8 b0 = *(const LAS bf16x8*)(Kslot + koff[d0]);
        const bf16x8 b1 = *(const LAS bf16x8*)(Kslot + koff[d0] + 4096);
        p0 = __builtin_amdgcn_mfma_f32_32x32x16_bf16(b0, qr[d0], p0, 0, 0, 0);
        p1 = __builtin_amdgcn_mfma_f32_32x32x16_bf16(b1, qr[d0], p1, 0, 0, 0);
    }
}
__device__ __forceinline__ bf16x8 pack8(const f32x16& p, int base) {
    u32x4 w; w.x = cvt_pk_bf16(p[base], p[base + 1]); w.y = cvt_pk_bf16(p[base + 2], p[base + 3]); w.z = cvt_pk_bf16(p[base + 4], p[base + 5]); w.w = cvt_pk_bf16(p[base + 6], p[base + 7]);
    return __builtin_bit_cast(bf16x8, w);
}

template <int NDB, bool MASKED, int VAR = 0> __device__ __forceinline__ void att_step(f32x16 (&o)[NDB], f32x16& ol, bf16x8 (&pa)[4], float& l, const LAS unsigned char* Kslot, const LAS unsigned char* Vslot,
                                                                       const int (&koff)[4], const int (&vboff)[NDB], const bf16x8 (&qr)[4], unsigned mlo, unsigned mhi, const bool live) {
    constexpr int ROWB = NDB * 64;
    bf16x8 vfa[NDB == 2 ? 8 : 1];
    if (NDB == 2) {
#pragma unroll
        for (int i = 0; i < 8; ++i) { const int d = i >> 2, ks = i & 3;
            const s16x4 lo = vtr(Vslot + vboff[d] + ks * 16 * ROWB), hi4 = vtr(Vslot + vboff[d] + ks * 16 * ROWB + 8 * ROWB);
            vfa[i] = (bf16x8){lo[0], lo[1], lo[2], lo[3], hi4[0], hi4[1], hi4[2], hi4[3]}; }
    }
    f32x16 p0, p1;
    if (VAR & 8) { p0 = (f32x16){}; p1 = (f32x16){}; asm volatile("" : "+v"(p0), "+v"(p1)); } else att_qkt(p0, p1, Kslot, koff, qr);
    __builtin_amdgcn_sched_barrier(0);
    bf16x8 pn[4];
#pragma unroll
    for (int sl = 0; sl < 4; ++sl) {
#pragma unroll
        for (int j = 0; j < NDB; ++j) {
            const int d = (NDB == 4) ? sl : (sl >> 1), ks = (NDB == 4) ? j : (2 * (sl & 1) + j);
            bf16x8 vf;
            if (NDB == 2) { vf = vfa[d * 4 + ks]; } else
            if (VAR & 16) { vf = pa[ks]; } else {
                const s16x4 lo = vtr(Vslot + vboff[d] + ks * 16 * ROWB), hi4 = vtr(Vslot + vboff[d] + ks * 16 * ROWB + 8 * ROWB);
                vf = (bf16x8){lo[0], lo[1], lo[2], lo[3], hi4[0], hi4[1], hi4[2], hi4[3]}; }
            if (VAR & 4) { asm volatile("" :: "v"(vf)); } else
            o[d] = __builtin_amdgcn_mfma_f32_32x32x16_bf16(pa[ks], vf, o[d], 0, 0, 0);
        }
        if (NDB == 2) {
            const bf16x8 ones = (bf16x8){0x3F80, 0x3F80, 0x3F80, 0x3F80, 0x3F80, 0x3F80, 0x3F80, 0x3F80};
            ol = __builtin_amdgcn_mfma_f32_32x32x16_bf16(pa[sl], ones, ol, 0, 0, 0);
        }
        f32x16& p = (sl < 2) ? p0 : p1;
        const unsigned mk = (sl < 2) ? mlo : mhi;
        const int rb0 = 8 * (sl & 1);
        float ps = 0.f;
        if (MASKED && !(VAR & 1)) {
            const unsigned m3 = mk, m2 = mk << 1, m1 = mk << 2, m0 = mk << 3;
            float e[8];
#pragma unroll
            for (int i = 0; i < 8; ++i) e[i] = (VAR & 2) ? p[rb0 + i] : __builtin_amdgcn_exp2f(p[rb0 + i]);
#define SDWA_AND_(d, m, B) "v_and_b32_sdwa " d ", " d ", sext(" m ") dst_sel:DWORD dst_unused:UNUSED_PAD src0_sel:DWORD src1_sel:BYTE_" B "\n\t"
            if (sl & 1)
                asm("s_nop 0\n\t" SDWA_AND_("%0", "%8", "2") SDWA_AND_("%1", "%9", "2") SDWA_AND_("%2", "%10", "2") SDWA_AND_("%3", "%11", "2")
                                  SDWA_AND_("%4", "%8", "3") SDWA_AND_("%5", "%9", "3") SDWA_AND_("%6", "%10", "3") SDWA_AND_("%7", "%11", "3")
                    : "+v"(e[0]), "+v"(e[1]), "+v"(e[2]), "+v"(e[3]), "+v"(e[4]), "+v"(e[5]), "+v"(e[6]), "+v"(e[7]) : "v"(m0), "v"(m1), "v"(m2), "v"(m3));
            else
                asm("s_nop 0\n\t" SDWA_AND_("%0", "%8", "0") SDWA_AND_("%1", "%9", "0") SDWA_AND_("%2", "%10", "0") SDWA_AND_("%3", "%11", "0")
                                  SDWA_AND_("%4", "%8", "1") SDWA_AND_("%5", "%9", "1") SDWA_AND_("%6", "%10", "1") SDWA_AND_("%7", "%11", "1")
                    : "+v"(e[0]), "+v"(e[1]), "+v"(e[2]), "+v"(e[3]), "+v"(e[4]), "+v"(e[5]), "+v"(e[6]), "+v"(e[7]) : "v"(m0), "v"(m1), "v"(m2), "v"(m3));
#undef SDWA_AND_
#pragma unroll
            for (int i = 0; i < 8; ++i) { p[rb0 + i] = e[i]; if (NDB != 2) ps += e[i]; }
        } else {
#pragma unroll
            for (int r = rb0; r < rb0 + 8; ++r) { const float e = (VAR & 2) ? p[r] : __builtin_amdgcn_exp2f(p[r]); p[r] = e; if (NDB != 2) ps += e; }
        }
        if (NDB != 2) l += live ? ps : 0.f;
        pn[sl] = pack8(p, rb0);
        __builtin_amdgcn_sched_barrier(0);
    }
#pragma unroll
    for (int ks = 0; ks < 4; ++ks) pa[ks] = pn[ks];
}

constexpr int A0_STAGE = 32768;
template <int VAR = 0> __device__ __forceinline__ void attn0_unit(LAS unsigned char* lds, const int wave, int b, int h, int qb, const bf16_t* Q, const bf16_t* __restrict__ K, const bf16_t* __restrict__ V, bf16_t* O,
                                           float lam, const float* __restrict__ subg, float outscale, bool dry) {
    const int lane = fresh_lane(), r32 = lane & 31, hi = lane >> 5;
    const int cc = wave >> 2, rb = wave & 3;
    const size_t rowbase = (size_t)b * SEQ;
    const int q0 = qb * 128 + rb * 32;
    const int NT = 2 * qb + 2;
    const int mylast = 2 * qb + (rb >> 1);
    const int krow = 8 * wave + (lane >> 3), kch = att_k_src_chunk(krow, lane & 7);
    const bf16_t* ksrc0 = K + (rowbase + krow) * DM + (2 * h + 0) * 64 + kch * 8;
    const bf16_t* ksrc1 = K + (rowbase + krow) * DM + (2 * h + 1) * 64 + kch * 8;
    const int vp0 = wave, vp1 = wave + 8;
    const int vrow0 = 4 * vp0 + (lane >> 4), vrow1 = 4 * vp1 + (lane >> 4), vs = lane & 15;
    const bf16_t* vsrc0 = V + (rowbase + vrow0) * DM + h * 128 + ((((vs >> 2) ^ (vrow0 & 3)) << 2) | (vs & 3)) * 8;
    const bf16_t* vsrc1 = V + (rowbase + vrow1) * DM + h * 128 + ((((vs >> 2) ^ (vrow1 & 3)) << 2) | (vs & 3)) * 8;
    const unsigned ldsb = (unsigned)(unsigned long long)lds;
#define A0_ISSUE(t, st) do { const unsigned sb_ = (unsigned)__builtin_amdgcn_readfirstlane(ldsb + (st) * A0_STAGE); const size_t go_ = (size_t)(t) * 64 * DM; \
        glds16(ksrc0 + go_, sb_ + wave * 1024); glds16(ksrc1 + go_, sb_ + 8192 + wave * 1024); \
        glds16(vsrc0 + go_, sb_ + 16384 + vp0 * 1024); glds16(vsrc1 + go_, sb_ + 16384 + vp1 * 1024); } while (0)
    bf16x8 qr[4];
    { const bf16_t* Qw = Q + (rowbase + q0) * DM + (2 * h + cc) * 64;
#pragma unroll
      for (int d0 = 0; d0 < 4; ++d0) qr[d0] = *(const bf16x8*)(Qw + (size_t)r32 * DM + d0 * 16 + hi * 8); }
    A0_ISSUE(0, 0); A0_ISSUE(1, 1);
    f32x16 o[4]; o[0] = (f32x16){}; o[1] = (f32x16){}; o[2] = (f32x16){}; o[3] = (f32x16){};
    float l = 0.f;
    int koff[4], vboff[4];
    { const int sw = (r32 >> 1) & 7, q4 = (lane & 15) >> 2, vbase = (4 * hi + q4) * 256 + ((lane >> 4) & 1) * 32 + (lane & 3) * 8;
#pragma unroll
      for (int d = 0; d < 4; ++d) { koff[d] = r32 * 128 + (((2 * d + hi) ^ sw) << 4); vboff[d] = vbase + ((d ^ q4) << 6); } }
    if (wave >= 4) __builtin_amdgcn_s_setprio(1);
    bf16x8 pa[4]; pa[0] = (bf16x8){}; pa[1] = (bf16x8){}; pa[2] = (bf16x8){}; pa[3] = (bf16x8){};
    int sk = 0, sv = 3;
    for (int t = 0; t <= NT; ++t) {
        if (t + 1 < NT) ATT_WAIT_BAR_N(4); else ATT_WAIT_BAR();
        if (t + 2 < NT) A0_ISSUE(t + 2, ((sk + 2) & 3));
        if (t <= mylast + 1) {
            const LAS unsigned char* Kslot = lds + sk * A0_STAGE + cc * 8192;
            const LAS unsigned char* Vslot = lds + (t == 0 ? 0 : sv) * A0_STAGE + 16384;
            att_step<4, false, VAR>(o, o[0], pa, l, Kslot, Vslot, koff, vboff, qr, 0u, 0u, t <= mylast);
        }
        sv = sk; sk = (sk + 1) & 3;
    }
#undef A0_ISSUE
    __builtin_amdgcn_s_setprio(0);
    ATT_WAIT_BAR();
    const int lane_e = fresh_lane(), r32e = lane_e & 31, hie = lane_e >> 5;
    l += __shfl_xor(l, 32);
    LAS float* wsf = (LAS float*)(lds + ATT_SCR + wave * 256);
    if (hie == 0) wsf[r32e] = l;
    asm volatile("s_waitcnt lgkmcnt(0)" ::: "memory");
    float rli[16];
#pragma unroll
    for (int r = 0; r < 16; ++r) rli[r] = 1.0f / wsf[crow(r, hie)];
    LAS float* X = (LAS float*)lds;
    if (cc == 1) {
#pragma unroll
        for (int r = 0; r < 16; ++r)
#pragma unroll
            for (int d = 0; d < 4; ++d) X[(rb * 32 + crow(r, hie)) * 128 + d * 32 + r32e] = o[d][r] * rli[r];
    }
    ATT_WAIT_BAR();
    if (cc == 0 && !dry) {
        float gsub[4];
#pragma unroll
        for (int d = 0; d < 4; ++d) gsub[d] = subg[d * 32 + r32e] * outscale;
#pragma unroll
        for (int r = 0; r < 16; ++r) {
            float v[4]; float ss = 0.f;
#pragma unroll
            for (int d = 0; d < 4; ++d) { v[d] = o[d][r] * rli[r] - lam * X[(rb * 32 + crow(r, hie)) * 128 + d * 32 + r32e]; ss += v[d] * v[d]; }
            ss += __shfl_xor(ss, 1); ss += __shfl_xor(ss, 2); ss += __shfl_xor(ss, 4); ss += __shfl_xor(ss, 8); ss += __shfl_xor(ss, 16);
            const float rn = 1.0f / sqrtf(ss * (1.0f / 128.0f) + EPS);
            bf16_t* op = O + (rowbase + q0 + crow(r, hie)) * DM + h * 128 + r32e;
#pragma unroll
            for (int d = 0; d < 4; ++d) op[d * 32] = (bf16_t)(cvt_pk_bf16(v[d] * rn * gsub[d], 0.f) & 0xffffu);
        }
    }
    ATT_WAIT_BAR();
}
__device__ __forceinline__ void attn0_phase(LAS unsigned char* lds, const int wave, unsigned char* ws, const float* subln, bool dry) {
    const int G = gridDim.x, bx = blockIdx.x;
    const bf16_t* Q = (const bf16_t*)(ws + WS_Q); const bf16_t* K = (const bf16_t*)(ws + WS_K); const bf16_t* V = (const bf16_t*)(ws + WS_V);
    const float lam = *(const float*)(ws + WS_MISC);
    for (int vb = bx; vb < 256; vb += G) {
        const int x = vb & 7, j = vb >> 3;
#pragma unroll 1
        for (int i = 0; i < 4; ++i) {
            const int r = i >> 1, jj = (j + 16 * r) & 31, qb = (i & 1) ? 63 - jj : jj, bh = 2 * x + r;
#if defined(PROBE_ATT0_VAR)
            if (dry) attn0_unit<PROBE_ATT0_VAR>(lds, wave, bh >> 3, bh & 7, qb, Q, K, V, (bf16_t*)(ws + WS_Q), lam, subln, 0.8f, dry); else
#endif
            attn0_unit<0>(lds, wave, bh >> 3, bh & 7, qb, Q, K, V, (bf16_t*)(ws + WS_Q), lam, subln, 0.8f, dry);
        }
    }
}

constexpr int A1_STAGE = 16384;
constexpr int A1_OUT = 73728;
constexpr int A1_MASK = ATT_NST * A1_STAGE;
template <int VAR = 0> __device__ __forceinline__ void attn1_unit(LAS unsigned char* lds, const int wave, int b, int h, int qb, const bf16_t* Q, const bf16_t* __restrict__ K, const bf16_t* __restrict__ V, bf16_t* O,
                                           const unsigned long long* __restrict__ MASK, bool dry, const bool pre = false, const int nb = 0, const int nh = 0, const int nqb = -1) {
    const int lane = fresh_lane(), r32 = lane & 31, hi = lane >> 5;
    const size_t rowbase = (size_t)b * SEQ;
    const int q0 = qb * 256 + wave * 32;
    const int NT = 4 * qb + 4;
    const int mylast = 4 * qb + (wave >> 1);
    const int krow = 8 * wave + (lane >> 3);
    const bf16_t* ksrc = K + (rowbase + krow) * DM + h * 64 + att_k_src_chunk(krow, lane & 7) * 8;
    const bf16_t* vsrc = V + (rowbase + krow) * DM + h * 64 + ((lane & 7) ^ (((krow >> 1) & 1) << 2)) * 8;
    const unsigned ldsb = (unsigned)(unsigned long long)lds;
    const unsigned long long* mrow = MASK + (size_t)b * 128 * SEQ + q0;
#define A1_ISSUE(t, st) do { const unsigned sb_ = (unsigned)__builtin_amdgcn_readfirstlane(ldsb + (st) * A1_STAGE); const size_t go_ = (size_t)(t) * 64 * DM; \
        glds16(ksrc + go_, sb_ + wave * 1024); glds16(vsrc + go_, sb_ + 8192 + wave * 1024); \
        glds4((const unsigned*)(mrow + (size_t)(t) * SEQ) + lane, (unsigned)__builtin_amdgcn_readfirstlane(ldsb + A1_MASK + ((st) * NWAVES + wave) * 256)); } while (0)
    bf16x8 qr[4];
    { const bf16_t* Qw = Q + (rowbase + q0) * DM + h * 64;
#pragma unroll
      for (int d0 = 0; d0 < 4; ++d0) qr[d0] = *(const bf16x8*)(Qw + (size_t)r32 * DM + d0 * 16 + hi * 8); }
    if (!pre) { A1_ISSUE(0, 0); A1_ISSUE(1, 1); }
    f32x16 o[2]; o[0] = (f32x16){}; o[1] = (f32x16){};
    f32x16 ol = (f32x16){};
    float l = 0.f;
    int koff[4], vboff[2];
    { const int sw = (r32 >> 1) & 7, q4 = (lane & 15) >> 2, vbase = (4 * hi + q4) * 128 + ((lane >> 4) & 1) * 32 + (lane & 3) * 8;
#pragma unroll
      for (int d = 0; d < 4; ++d) koff[d] = r32 * 128 + (((2 * d + hi) ^ sw) << 4);
#pragma unroll
      for (int d = 0; d < 2; ++d) vboff[d] = vbase + ((d ^ ((q4 >> 1) & 1)) << 6); }
    bf16x8 pa[4]; pa[0] = (bf16x8){}; pa[1] = (bf16x8){}; pa[2] = (bf16x8){}; pa[3] = (bf16x8){};
    int sk = 0, sv = 3;
    if (wave >= 4) __builtin_amdgcn_s_setprio(1);
    for (int t = 0; t <= NT; ++t) {
        if (VAR & 32) { asm volatile("s_waitcnt vmcnt(0) lgkmcnt(0)" ::: "memory"); } else
        if (t + 1 < NT) ATT_WAIT_BAR_N(3); else ATT_WAIT_BAR();
        if (!(VAR & 64)) if (t + 2 < NT) A1_ISSUE(t + 2, ((sk + 2) & 3));
        const unsigned long long mw = *(const LAS unsigned long long*)(lds + A1_MASK + (sk * NWAVES + wave) * 256 + r32 * 8);
        const unsigned mlo = (unsigned)mw << (4 - 4 * hi), mhi = (unsigned)(mw >> 32) << (4 - 4 * hi);
        if (t <= mylast + 1) {
            const LAS unsigned char* Kslot = lds + sk * A1_STAGE;
            const LAS unsigned char* Vslot = lds + (t == 0 ? 0 : sv) * A1_STAGE + 8192;
            att_step<2, true, VAR>(o, ol, pa, l, Kslot, Vslot, koff, vboff, qr, mlo, mhi, t <= mylast);
        }
        sv = sk; sk = (sk + 1) & 3;
    }
#undef A1_ISSUE
    __builtin_amdgcn_s_setprio(0);
    if (nqb >= 0) {
        const int ln = fresh_lane(), krn = 8 * wave + (ln >> 3);
        const size_t nrow = (size_t)nb * SEQ;
        const bf16_t* ks_n = K + (nrow + krn) * DM + nh * 64 + att_k_src_chunk(krn, ln & 7) * 8;
        const bf16_t* vs_n = V + (nrow + krn) * DM + nh * 64 + ((ln & 7) ^ (((krn >> 1) & 1) << 2)) * 8;
        const unsigned long long* mr_n = MASK + (size_t)nb * 128 * SEQ + nqb * 256 + wave * 32;
#pragma unroll
        for (int tt = 0; tt < 2; ++tt) {
            const unsigned sb_ = (unsigned)__builtin_amdgcn_readfirstlane(ldsb + tt * A1_STAGE); const size_t go_ = (size_t)tt * 64 * DM;
            glds16(ks_n + go_, sb_ + wave * 1024); glds16(vs_n + go_, sb_ + 8192 + wave * 1024);
            glds4((const unsigned*)(mr_n + (size_t)tt * SEQ) + ln, (unsigned)__builtin_amdgcn_readfirstlane(ldsb + A1_MASK + (tt * NWAVES + wave) * 256));
        }
    }
    if (dry) asm volatile("" :: "v"(o[0]), "v"(o[1]), "v"(ol));
    const int lane_e = fresh_lane(), r32e = lane_e & 31, hie = lane_e >> 5;
    if (!dry) {
        LAS unsigned char* T = lds + A1_OUT + wave * (32 * 144);
#pragma unroll
        for (int r = 0; r < 16; ++r) {
            const float rl = 1.0f / ol[r];
            LAS bf16_t* tp = (LAS bf16_t*)(T + crow(r, hie) * 144) + r32e;
            tp[0] = (bf16_t)(cvt_pk_bf16(o[0][r] * rl, 0.f) & 0xffffu); tp[32] = (bf16_t)(cvt_pk_bf16(o[1][r] * rl, 0.f) & 0xffffu);
        }
        asm volatile("s_waitcnt lgkmcnt(0)" ::: "memory");
#pragma unroll
        for (int i = 0; i < 4; ++i) {
            const int row = 8 * i + (lane_e >> 3), ch = lane_e & 7;
            const u32x4 w = *(const LAS u32x4*)(T + row * 144 + ch * 16);
            *(u32x4*)(O + (rowbase + q0 + row) * DM + h * 64 + ch * 8) = w;
        }
    }
    (void)l;
    ATT_WAIT_BAR();
}
__device__ __forceinline__ void attn1_phase(LAS unsigned char* lds, const int wave, unsigned char* ws, bool dry) {
    const int G = gridDim.x, bx = blockIdx.x;
    const bf16_t* Q = (const bf16_t*)(ws + WS_Q); const bf16_t* K = (const bf16_t*)(ws + WS_K); const bf16_t* V = (const bf16_t*)(ws + WS_V);
    for (int vb = bx; vb < 256; vb += G) {
        const int x = vb & 7, j = vb >> 3;
#pragma unroll 1
        for (int i = 0; i < 4; ++i) {
            const int jj = (j + 16 * (i >> 1)) & 31, qb = (i & 1) ? 31 - jj : jj, bh = 4 * x + i;
#if defined(PROBE_ATT1_VAR)
            if (dry) attn1_unit<PROBE_ATT1_VAR>(lds, wave, bh >> 4, bh & 15, qb, Q, K, V, (bf16_t*)(ws + WS_Q), (const unsigned long long*)(ws + WS_MASK), dry); else
#endif
            {   const int i2 = i + 1, jn = (j + 16 * (i2 >> 1)) & 31, nqb = (i2 < 4 && !dry) ? ((i2 & 1) ? 31 - jn : jn) : -1, nbh = 4 * x + i2;
                attn1_unit<0>(lds, wave, bh >> 4, bh & 15, qb, Q, K, V, (bf16_t*)(ws + WS_Q), (const unsigned long long*)(ws + WS_MASK), dry, i > 0 && !dry, nbh >> 4, nbh & 15, nqb); }
        }
    }
}
constexpr int IX_NB = 512, IX_HSTR = 513, IX_CAP = 320, IX_BSTR = 257;
constexpr int IX_HIST = 0, IX_CK = 0, IX_CI = 32 * IX_CAP * 4, IX_BM = 66560, IX_META = IX_BM + 32 * IX_BSTR * 4 + 128;
static_assert(IX_CI + 32 * IX_CAP * 2 <= IX_BM && 32 * IX_HSTR * 4 <= IX_BM && IX_META + 512 <= RING_BYTES, "indexer LDS map");

__device__ __forceinline__ void ix_abs_fma(f32x16& sc, const f32x16& d, float ah) {
#pragma unroll
    for (int r = 0; r < 16; ++r) { float t = sc[r]; asm("v_fma_f32 %0, %1, |%2|, %0" : "+v"(t) : "v"(ah), "v"(d[r])); sc[r] = t; }
}
__device__ __forceinline__ void ix_scores(f32x16& sc, const bf16x8 (&kf)[4], const bf16x8 (&qf)[8][4], const bf16x8 (&qc)[4], const float (&ah)[8]) {
    sc = (f32x16){};
#pragma unroll
    for (int s = 0; s < 4; ++s) sc = __builtin_amdgcn_mfma_f32_32x32x16_bf16(kf[s], qc[s], sc, 0, 0, 0);
    f32x16 d0 = (f32x16){}, d1;
#pragma unroll
    for (int s = 0; s < 4; ++s) d0 = __builtin_amdgcn_mfma_f32_32x32x16_bf16(kf[s], qf[0][s], d0, 0, 0, 0);
    asm volatile("" : "+v"(sc), "+v"(d0));
    __builtin_amdgcn_sched_barrier(0);
#pragma unroll
    for (int h = 0; h < 8; h += 2) {
        d1 = (f32x16){};
#pragma unroll
        for (int s = 0; s < 4; ++s) d1 = __builtin_amdgcn_mfma_f32_32x32x16_bf16(kf[s], qf[h + 1][s], d1, 0, 0, 0);
        asm volatile("" : "+v"(d1), "+v"(d0), "+v"(sc));
        __builtin_amdgcn_sched_barrier(0);
        ix_abs_fma(sc, d0, ah[h]);
        asm volatile("" : "+v"(sc));
        __builtin_amdgcn_sched_barrier(0);
        if (h + 2 < 8) {
            d0 = (f32x16){};
#pragma unroll
            for (int s = 0; s < 4; ++s) d0 = __builtin_amdgcn_mfma_f32_32x32x16_bf16(kf[s], qf[h + 2][s], d0, 0, 0, 0);
            asm volatile("" : "+v"(d0), "+v"(d1), "+v"(sc));
        } else {
            asm volatile("s_nop 15\n\ts_nop 3" : "+v"(d1), "+v"(sc));
        }
        __builtin_amdgcn_sched_barrier(0);
        ix_abs_fma(sc, d1, ah[h + 1]);
        asm volatile("" : "+v"(sc));
        __builtin_amdgcn_sched_barrier(0);
    }
}
__device__ __forceinline__ void ix_combine(bf16x8 (&qc)[4], const bf16x8 (&qf)[8][4], const float (&ah)[8]) {
#pragma unroll
    for (int s = 0; s < 4; ++s) {
        float acc[8];
#pragma unroll
        for (int j = 0; j < 8; ++j) acc[j] = 0.f;
#pragma unroll
        for (int h = 0; h < 8; ++h)
#pragma unroll
            for (int j = 0; j < 8; ++j) acc[j] = __builtin_fmaf(ah[h], __uint_as_float((unsigned)(unsigned short)qf[h][s][j] << 16), acc[j]);
        u32x4 w; w.x = cvt_pk_bf16(acc[0], acc[1]); w.y = cvt_pk_bf16(acc[2], acc[3]); w.z = cvt_pk_bf16(acc[4], acc[5]); w.w = cvt_pk_bf16(acc[6], acc[7]);
        qc[s] = __builtin_bit_cast(bf16x8, w);
    }
}
__device__ __forceinline__ int ix_bin(float sc, float Rs, float scale) {
    const int b = (int)__builtin_fmaf(sc, scale, Rs);
    return b < 0 ? 0 : (b > IX_NB - 1 ? IX_NB - 1 : b);
}
__device__ __forceinline__ void ix_loadk(bf16x8 (&kf)[4], const bf16_t* KIb, int kt, int r32, int hi) {
    const int l_ = fresh_lane();
    const bf16_t* p = KIb + (size_t)(unsigned)((kt * 32 + (l_ & 31)) * 64 + (l_ >> 5) * 8);
#pragma unroll
    for (int s = 0; s < 4; ++s) kf[s] = *(const bf16x8*)(p + s * 16);
}

__device__ __forceinline__ void idx_unit(LAS unsigned char* lds, const int wave, unsigned char* ws, int b, int qt, const int dry) {
    const int lane = fresh_lane(), r32 = lane & 31, hi = lane >> 5, tid = wave * 64 + lane;
    const int chunk = qt >> 1;
    const size_t tok0 = (size_t)b * SEQ + (size_t)qt * 32;
    unsigned* MASK32 = (unsigned*)(ws + WS_MASK);
    if (chunk < 4) {
        if (!dry) for (int t = wave; t <= chunk; t += 8) MASK32[((size_t)(b * 128 + t) * SEQ + qt * 32 + r32) * 2 + hi] = 0xFFFFFFFFu;
        return;
    }
    const bf16_t* KIb = (const bf16_t*)(ws + WS_KI) + (size_t)b * SEQ * 64;
    LAS unsigned* HIST = (LAS unsigned*)(lds + IX_HIST);
    LAS float* CK = (LAS float*)(lds + IX_CK);
    LAS unsigned short* CI = (LAS unsigned short*)(lds + IX_CI);
    LAS unsigned* BM = (LAS unsigned*)(lds + IX_BM);
    LAS int* META = (LAS int*)(lds + IX_META);
#define IX_LOADQ(qf) do { const int l_ = fresh_lane(); const bf16_t* qp_ = (const bf16_t*)(ws + WS_QI) + tok0 * 512 + (unsigned)((l_ & 31) * 512 + (l_ >> 5) * 8); \
        _Pragma("unroll") for (int h = 0; h < 8; ++h) _Pragma("unroll") for (int s = 0; s < 4; ++s) qf[h][s] = *(const bf16x8*)(qp_ + h * 64 + s * 16); } while (0)
    float a[8]; float R;
    { const float* np = (const float*)(ws + WS_QIN) + (tok0 + r32) * 8;
      const f32x4 n0 = *(const f32x4*)np, n1 = *(const f32x4*)(np + 4);
#pragma unroll
      for (int h = 0; h < 4; ++h) { a[h] = 0.5f * n0[h]; a[4 + h] = 0.5f * n1[h]; }
      R = (((fabsf(n0[0]) + fabsf(n0[1])) + (fabsf(n0[2]) + fabsf(n0[3]))) + ((fabsf(n1[0]) + fabsf(n1[1])) + (fabsf(n1[2]) + fabsf(n1[3])))) * 1.03f;
      R = fmaxf(R, 1e-30f); }
    const float scale = (float)(IX_NB / 2) / R, Rs = (float)(IX_NB / 2);
    const int nkt = 2 * (chunk + 1);
    for (int i = tid; i < 32 * IX_HSTR; i += NWAVES * 64) HIST[i] = 0u;
    for (int i = tid; i < 32 * IX_BSTR; i += NWAVES * 64) BM[i] = 0u;
    if (tid < 128) META[tid] = 0;
    LDS_WAIT(); __builtin_amdgcn_s_barrier(); asm volatile("" ::: "memory");
    {
        bf16x8 qf[8][4]; IX_LOADQ(qf);
        bf16x8 qc[4]; ix_combine(qc, qf, a);
        bf16x8 kf[4], kn[4];
        if (wave < nkt) ix_loadk(kf, KIb, wave, r32, hi);
#pragma unroll 1
        for (int kt = wave; kt < nkt; kt += 8) {
            if (kt + 8 < nkt) ix_loadk(kn, KIb, kt + 8, r32, hi);
            f32x16 sc;
            ix_scores(sc, kf, qf, qc, a);
#pragma unroll
            for (int r = 0; r < 16; ++r) {
                const int bin = ix_bin(sc[r], Rs, scale);
                __hip_atomic_fetch_add(HIST + r32 * IX_HSTR + bin, 1u, __ATOMIC_RELAXED, __HIP_MEMORY_SCOPE_WORKGROUP);
            }
#pragma unroll
            for (int s = 0; s < 4; ++s) kf[s] = kn[s];
        }
    }
    LDS_WAIT(); __builtin_amdgcn_s_barrier(); asm volatile("" ::: "memory");
#pragma unroll 1
    for (int i = 0; i < 4; ++i) {
        const int q = wave * 4 + i;
        int lane8 = 8 * lane; asm volatile("" : "+v"(lane8));
        unsigned wv[8]; unsigned c = 0;
#pragma unroll
        for (int w = 0; w < 8; ++w) { wv[w] = HIST[q * IX_HSTR + lane8 + w]; c += wv[w]; }
        unsigned x = c;
#pragma unroll
        for (int off = 1; off < 64; off <<= 1) { const unsigned y = __shfl_down(x, off); if (lane + off < 64) x += y; }
        const unsigned sx = x - c;
        if (sx < 256u && x >= 256u) {
            unsigned cum = sx; int found = 0, tb = 0, kr = 0, tc = 0;
#pragma unroll
            for (int w = 7; w >= 0; --w) {
                if (!found) { if (cum + wv[w] >= 256u) { found = 1; tb = lane8 + w; kr = 256 - (int)cum; tc = (int)wv[w]; } else cum += wv[w]; }
            }
            META[q] = tb; META[32 + q] = kr; META[64 + q] = tc;
        }
    }
    LDS_WAIT(); __builtin_amdgcn_s_barrier(); asm volatile("" ::: "memory");
    if (dry == 1) return;
    {
        const int tb = META[r32];
        const float fl = (tb <= 0) ? -__builtin_inff() : (float)tb, fh = (tb >= IX_NB - 1) ? __builtin_inff() : (float)(tb + 1);
        bf16x8 qf[8][4]; IX_LOADQ(qf);
        bf16x8 qc[4]; ix_combine(qc, qf, a);
        bf16x8 kf[4], kn[4];
        if (wave < nkt) ix_loadk(kf, KIb, wave, r32, hi);
#pragma unroll 1
        for (int kt = wave; kt < nkt; kt += 8) {
            if (kt + 8 < nkt) ix_loadk(kn, KIb, kt + 8, r32, hi);
            f32x16 sc;
            ix_scores(sc, kf, qf, qc, a);
            unsigned sb = 0u, cb = 0u;
#pragma unroll
            for (int r = 15; r >= 1; r -= 2) {
                const float f1 = __builtin_fmaf(sc[r], scale, Rs), f0 = __builtin_fmaf(sc[r - 1], scale, Rs);
                unsigned long long t0, t1, t2, t3;
                asm("v_cmp_ge_f32_e64 %2, %6, %8\n\tv_cmp_ge_f32_e64 %3, %7, %8\n\tv_cmp_ge_f32_e64 %4, %6, %9\n\tv_cmp_ge_f32_e64 %5, %7, %9\n\t"
                    "v_addc_co_u32_e64 %0, vcc, %0, %0, %2\n\tv_addc_co_u32_e64 %0, vcc, %0, %0, %3\n\tv_addc_co_u32_e64 %1, vcc, %1, %1, %4\n\tv_addc_co_u32_e64 %1, vcc, %1, %1, %5"
                    : "+v"(sb), "+v"(cb), "=&s"(t0), "=&s"(t1), "=&s"(t2), "=&s"(t3) : "v"(f1), "v"(f0), "v"(fh), "v"(fl) : "vcc");
            }
            const unsigned cbits = cb & ~sb;
            if (__ballot(cbits != 0u)) {
                int base = 0;
                if (cbits) base = __hip_atomic_fetch_add(META + 96 + r32, __popc(cbits), __ATOMIC_RELAXED, __HIP_MEMORY_SCOPE_WORKGROUP);
#pragma unroll
                for (int r = 0; r < 16; ++r) {
                    const bool c = (cbits >> r) & 1u;
                    if (__ballot(c)) {
                        if (c) { if (base < IX_CAP) { CK[r32 * IX_CAP + base] = sc[r]; CI[r32 * IX_CAP + base] = (unsigned short)(kt * 32 + (r & 3) + 8 * (r >> 2) + 4 * hi); } ++base; }
                    }
                }
            }
            unsigned bits = (sb & 0xFu) | ((sb & 0xF0u) << 4) | ((sb & 0xF00u) << 8) | ((sb & 0xF000u) << 12);
            bits <<= 4 * hi;
            bits |= __shfl_xor(bits, 32);
            if (hi == 0) BM[r32 * IX_BSTR + kt] = bits;
#pragma unroll
            for (int s = 0; s < 4; ++s) kf[s] = kn[s];
        }
    }
    LDS_WAIT(); __builtin_amdgcn_s_barrier(); asm volatile("" ::: "memory");
    if (dry == 2) return;
    {
        const int q0 = wave * 4;
        unsigned key[4][5]; int kr[4], cq[4]; unsigned prefix[4];
        int maxc = 0; unsigned dmax = 0u;
#pragma unroll
        for (int i = 0; i < 4; ++i) {
            int c = META[96 + q0 + i]; c = c > IX_CAP ? IX_CAP : c; cq[i] = c; maxc = c > maxc ? c : maxc;
            kr[i] = META[32 + q0 + i];
            unsigned orv = 0u, andv = 0xFFFFFFFFu;
#pragma unroll
            for (int sl = 0; sl < 5; ++sl) {
                const int e = lane + 64 * sl; const bool v = e < c;
                const unsigned u = v ? __float_as_uint(CK[(q0 + i) * IX_CAP + e]) : 0u;
                const unsigned k = (u & 0x80000000u) ? ~u : (u | 0x80000000u);
                key[i][sl] = v ? k : 0u; orv |= key[i][sl]; andv &= v ? k : 0xFFFFFFFFu;
            }
#pragma unroll
            for (int o = 1; o < 64; o <<= 1) { orv |= (unsigned)__shfl_xor((int)orv, o); andv &= (unsigned)__shfl_xor((int)andv, o); }
            const unsigned diff = orv ^ andv;
            const unsigned low = diff ? (0xFFFFFFFFu >> __builtin_clz(diff)) : 0u;
            prefix[i] = (c > 0) ? (andv & ~low) : 0u; dmax |= diff;
        }
        maxc = __builtin_amdgcn_readfirstlane(maxc); dmax = __builtin_amdgcn_readfirstlane(dmax);
        const int nsl = (maxc + 63) >> 6;
#pragma unroll 1
        for (int bit = dmax ? 31 - __builtin_clz(dmax) : -1; bit >= 0; --bit) {
            int cnt[4] = {0, 0, 0, 0};
#pragma unroll
            for (int sl = 0; sl < 5; ++sl) if (sl < nsl) {
#pragma unroll
                for (int i = 0; i < 4; ++i) cnt[i] += __popcll(__ballot(key[i][sl] >= (prefix[i] | (1u << bit))));
            }
#pragma unroll
            for (int i = 0; i < 4; ++i) prefix[i] = (cnt[i] >= kr[i]) ? (prefix[i] | (1u << bit)) : prefix[i];
        }
#pragma unroll
        for (int i = 0; i < 4; ++i) {
            const int q = q0 + i;
            int cgt = 0, ceq = 0;
#pragma unroll
            for (int sl = 0; sl < 5; ++sl) if (sl < nsl) { const bool v = lane + 64 * sl < cq[i];
                cgt += __popcll(__ballot(v && key[i][sl] > prefix[i])); ceq += __popcll(__ballot(v && key[i][sl] == prefix[i])); }
            const int need = kr[i] - cgt;
            int idx[5];
#pragma unroll
            for (int sl = 0; sl < 5; ++sl) { const int e = lane + 64 * sl; idx[sl] = (e < cq[i]) ? (int)CI[q * IX_CAP + e] : 0x7fffffff; }
            int ithr = 0x7fffffff;
            if (need < ceq) {
                int pre = 0;
#pragma unroll 1
                for (int bit = 12; bit >= 0; --bit) {
                    const int trial = pre | (1 << bit); int cnt = 0;
#pragma unroll
                    for (int sl = 0; sl < 5; ++sl) cnt += __popcll(__ballot(lane + 64 * sl < cq[i] && key[i][sl] == prefix[i] && idx[sl] < trial));
                    if (cnt < need) pre = trial;
                }
                ithr = pre;
            }
#pragma unroll
            for (int sl = 0; sl < 5; ++sl)
                if (lane + 64 * sl < cq[i] && (key[i][sl] > prefix[i] || (key[i][sl] == prefix[i] && idx[sl] <= ithr)))
                    __hip_atomic_fetch_or(BM + q * IX_BSTR + (idx[sl] >> 5), 1u << (idx[sl] & 31), __ATOMIC_RELAXED, __HIP_MEMORY_SCOPE_WORKGROUP);
        }
    }
    LDS_WAIT(); __builtin_amdgcn_s_barrier(); asm volatile("" ::: "memory");
#undef IX_LOADQ
    if (dry) return;
    for (int t = wave; t <= chunk; t += 8) MASK32[((size_t)(b * 128 + t) * SEQ + qt * 32 + r32) * 2 + hi] = BM[r32 * IX_BSTR + 2 * t + hi];
    LDS_WAIT(); __builtin_amdgcn_s_barrier(); asm volatile("" ::: "memory");
}
__device__ __forceinline__ void idx_phase(LAS unsigned char* lds, const int wave, unsigned char* ws) {
    for (int v = blockIdx.x; v < 256; v += gridDim.x) {
        const int b = v >> 7, j = v & 127;
#if defined(PROBE_IDX_DRY)
#pragma unroll 1
        for (int u = 0; u < 6; ++u) idx_unit(lds, wave, ws, b, (u & 1) ? 255 - j : j, u < 2 ? 0 : PROBE_IDX_DRY);
#else
#pragma unroll 1
        for (int u = 0; u < 2; ++u) idx_unit(lds, wave, ws, b, u ? 255 - j : j, 0);
#endif
    }
}
struct Args { const float* in[22]; float* out; unsigned char* ws; int ph_lo, ph_hi, coop, pad; };
enum Phase { P_PRO = 0, P_IN0, P_ATT0, P_OUT0, P_UP0, P_DN0, P_IN1, P_QUP, P_IDX, P_ATT1, P_OUT1, P_UP1, P_DN1, P_N, P_BRIDGE = 20 };

constexpr int CTL_ROWCNT = 4096;
struct In1Order : pg8::StaticOrder {
    unsigned* cnt; int wave;
    __device__ __forceinline__ bool next(int i, pg8::Unit& u) const { if (!pg8::StaticOrder::next(i, u)) return false; u.pn = (u.pn == 1) ? 9 : (u.pn == 9) ? 1 : u.pn; return true; }
    __device__ __forceinline__ void a_ready(const pg8::Unit&) const {}
    __device__ __forceinline__ void done(const pg8::Unit& u) const {
        if (u.pn == 0 || u.pn == 9) {
            asm volatile("s_waitcnt vmcnt(0)" ::: "memory");
            __builtin_amdgcn_s_barrier();
            if (wave == 0) {
                __builtin_amdgcn_fence(__ATOMIC_RELEASE, "agent");
                asm volatile("s_waitcnt vmcnt(0)" ::: "memory");
                if (fresh_lane() == 0) (void)xb_add(&cnt[u.pm * 16], 8u);
            }
        }
    }
};
__device__ __forceinline__ void qup_wait_rows(const pg8::StaticOrder& S, unsigned* cnt, unsigned* tmo, const unsigned need = 16u) {
#pragma unroll 1
    for (int i = 0; ; ++i) {
        pg8::Unit u; if (!S.next(i, u)) break;
        unsigned sp = 0;
        while (xb_ld(&cnt[u.pm * 16]) < need) { __builtin_amdgcn_s_sleep(1); if ((++sp & 255u) == 0u) { if (xb_ld(tmo)) break; if (sp > XB_SPIN_CAP) { atomicAdd(tmo, 1u); break; } } }
    }
    __builtin_amdgcn_fence(__ATOMIC_ACQUIRE, "agent");
}
template <class Epi> __device__ __forceinline__ void run_gemm(LAS unsigned char* lds, const int wave, const bf16_t* A, const bf16_t* Bt, int N, int K, const Epi& E) {
    pg8::Gemm g{A, Bt, TOK, N, K}; pg8::StaticOrder S; S.init(TOK, N, (int)gridDim.x, (int)blockIdx.x);
    pg8::gemm_phase<Epi, pg8::StaticOrder, true, true>(lds, g, S, E, wave, fresh_lane());
}
__global__ void __launch_bounds__(NWAVES * 64, 2) mk_fwd(Args args) {
    extern __shared__ __attribute__((aligned(16))) unsigned char lds_raw[];
    LAS unsigned char* lds = (LAS unsigned char*)lds_raw;
    const int wave = __builtin_amdgcn_readfirstlane(threadIdx.x >> 6);
    const int G = gridDim.x;
    unsigned char* ws = args.ws;
    const int lo = args.ph_lo, hi = args.ph_hi;
    volatile LAS unsigned* MISC = (volatile LAS unsigned*)(lds + MISC_OFF);
    { const int tid = wave * 64 + fresh_lane(); for (int u = tid; u < (LDS_BYTES - RING_BYTES) / 4; u += NWAVES * 64) ((LAS unsigned*)(lds + RING_BYTES))[u] = 0u; }
    __syncthreads();
    XcdBarrier bar; bar.bar = (unsigned*)(ws + WS_CTL); bar.x = 0; bar.st = nullptr;
    if (args.coop) bar = xcd_barrier_post((unsigned*)(ws + WS_CTL), MISC + 8);
#define IN(k) (lo <= (k) && (k) < hi)
#define NREP(k) ((PROBE_PHASE == (k)) ? 3 : 1)
#define SEAM(k) do { if (args.coop && IN(k) && IN((k) + 1)) xcd_barrier(bar, wave); } while (0)
    LAS float* ETBL = (LAS float*)(lds + EPI_TBL_OFF + wave * 512);
    bf16_t* XB = (bf16_t*)(ws + WS_XB); bf16_t* QB = (bf16_t*)(ws + WS_Q); bf16_t* KB = (bf16_t*)(ws + WS_K); bf16_t* VB = (bf16_t*)(ws + WS_V); bf16_t* UB = (bf16_t*)(ws + WS_U);
    float* PART = (float*)(ws + WS_PART); float* CS = (float*)(ws + WS_CS); float* LAM = (float*)(ws + WS_MISC);

    if (IN(P_PRO)) for (int rep_ = 0; rep_ < NREP(P_PRO); ++rep_) {
        const int lane = fresh_lane(), tid = wave * 64 + lane;
        LAS float* scr = (LAS float*)(lds + wave * 16384);
        const int gw = blockIdx.x * NWAVES + wave, NGW = G * NWAVES;
        const float* nmix = args.in[2]; const float* nmlp = args.in[3];
        int base = 0;
#define DOJOB(W_, gain_, WT_, K_, N_, Npad_, roff_) do { const int nblk = (Npad_) / 32, nitems = ((K_) / 64) * nblk; \
            for (int it = (gw - base % NGW + NGW) % NGW; it < nitems; it += NGW) p0_transpose_item((W_), (K_), (N_), (gain_), (bf16_t*)(ws + (WT_)), (roff_), scr, it, nblk, lane); \
            base += nitems; } while (0)
        DOJOB(args.in[6], nmix, WS_WIN0, DM, 3072, 3072, 0);
        DOJOB(args.in[14], (const float*)nullptr, WS_WOUT0, DM, DM, DM, 0);
        DOJOB(args.in[4], nmlp, WS_W1_0, DM, DFF, DFF, 0);
        DOJOB(args.in[5], (const float*)nullptr, WS_W2_0, DFF, DM, DM, 0);
        DOJOB(args.in[15], nmix + DM, WS_WIN1, DM, NIN1, NIN1P, 0);
        DOJOB(args.in[17], args.in[16], WS_WUQ, 256, DM, DM, 0);
        DOJOB(args.in[18], args.in[16], WS_WUQ, 256, 512, 512, 1024);
        DOJOB(args.in[21], (const float*)nullptr, WS_WOUT1, DM, DM, DM, 0);
        DOJOB(args.in[4] + (size_t)DM * DFF, nmlp + DM, WS_W1_1, DM, DFF, DFF, 0);
        DOJOB(args.in[5] + (size_t)DM * DFF, (const float*)nullptr, WS_W2_1, DFF, DM, DM, 0);
#undef DOJOB
        if (TOK % (4 * NGW) == 0) { for (int m = gw; m < TOK; m += 4 * NGW) rows_to_bf16<4>(args.in[0], XB, PART, m, NGW, lane); }
        else { for (int m = gw; m < TOK; m += NGW) rows_to_bf16<1>(args.in[0], XB, PART, m, NGW, lane); }
        const int* pos = (const int*)args.in[1];
        for (int t = blockIdx.x * (NWAVES * 64) + tid; t < TOK * 8; t += G * NWAVES * 64) {
            const int tok = t >> 3, i = t & 7;
            const float inv = (float)pow(500000.0, -(double)i / 8.0);
            const float ang = (float)pos[tok] * inv;
            CS[tok * 16 + i] = (float)cos((double)ang); CS[tok * 16 + 8 + i] = (float)sin((double)ang);
        }
        if (blockIdx.x == 0 && tid == 0) {
            float s1 = 0.f, s2 = 0.f;
            for (int i = 0; i < 64; ++i) { s1 += args.in[9][i] * args.in[10][i]; s2 += args.in[11][i] * args.in[12][i]; }
            LAM[0] = expf(s1) - expf(s2) + 0.2f;
        }
    }
    SEAM(P_PRO);
    if (IN(P_BRIDGE)) {
        const int lane = fresh_lane();
        const int gw = blockIdx.x * NWAVES + wave, NGW = G * NWAVES;
        for (int m = gw; m < TOK; m += NGW) rows_to_bf16<1>(args.out, XB, PART, m, NGW, lane);
    }
    if (IN(P_IN0)) { for (int rep_ = 0; rep_ < NREP(P_IN0); ++rep_) { EpiQKV0 E{PART, CS, args.in[7], args.in[8], QB, (size_t)(WS_K - WS_Q) / 2, 0.125f * LOG2E, ETBL}; run_gemm(lds, wave, XB, (const bf16_t*)(ws + WS_WIN0), 3072, DM, E); } }
    SEAM(P_IN0);
    if (IN(P_ATT0)) { for (int rep_ = NREP(P_ATT0) - 1; rep_ >= 0; --rep_) attn0_phase(lds, wave, ws, args.in[13], rep_ != 0); }
    SEAM(P_ATT0);
    if (IN(P_OUT0)) { for (int rep_ = 0; rep_ < NREP(P_OUT0); ++rep_) { EpiResidT<true, false> E{nullptr, XB, nullptr, XB, PART}; run_gemm(lds, wave, QB, (const bf16_t*)(ws + WS_WOUT0), DM, DM, E); } }
    SEAM(P_OUT0);
    if (IN(P_UP0)) { for (int rep_ = 0; rep_ < NREP(P_UP0); ++rep_) { EpiUp E{PART, UB, ETBL}; run_gemm(lds, wave, XB, (const bf16_t*)(ws + WS_W1_0), DFF, DM, E); } }
    SEAM(P_UP0);
    if (IN(P_DN0)) { EpiResidT<true, false> E{nullptr, XB, nullptr, XB, PART}; run_gemm(lds, wave, UB, (const bf16_t*)(ws + WS_W2_0), DM, DFF, E); }
    SEAM(P_DN0);
    if (IN(P_IN1)) { for (int rep_ = 0; rep_ < NREP(P_IN1); ++rep_) { EpiIn1 E{PART, CS, args.in[20], (bf16_t*)(ws + WS_CQ), (float*)(ws + WS_CQP), KB, VB, (bf16_t*)(ws + WS_KI), (float*)(ws + WS_WIDX), 0.35355339059327373f * 0.125f, ETBL};
        pg8::Gemm g{XB, (const bf16_t*)(ws + WS_WIN1), TOK, NIN1P, DM}; In1Order S; S.init(TOK, NIN1P, G, (int)blockIdx.x); S.cnt = (unsigned*)(ws + WS_CTL) + CTL_ROWCNT; S.wave = wave;
        pg8::gemm_phase<EpiIn1, In1Order, true, true>(lds, g, S, E, wave, fresh_lane()); } }
    if (IN(P_QUP)) { for (int rep_ = 0; rep_ < NREP(P_QUP); ++rep_) { EpiQup E{(const float*)(ws + WS_CQP), CS, args.in[19], (const float*)(ws + WS_WIDX), QB, (bf16_t*)(ws + WS_QI), (float*)(ws + WS_QIN), 0.125f * LOG2E, ETBL};
        const int c = (int)blockIdx.x, cm = (G % 8 == 0) ? ((c & 7) | ((G / 8 - 1 - (c >> 3)) << 3)) : c;
        pg8::Gemm g{(const bf16_t*)(ws + WS_CQ), (const bf16_t*)(ws + WS_WUQ), TOK, 1536, 256}; pg8::StaticOrder S; S.init(TOK, 1536, G, cm);
        qup_wait_rows(S, (unsigned*)(ws + WS_CTL) + CTL_ROWCNT, (unsigned*)(ws + WS_CTL) + XB_TMO);
        pg8::gemm_phase<EpiQup, pg8::StaticOrder, true, true>(lds, g, S, E, wave, fresh_lane()); } }
    SEAM(P_QUP);
    if (IN(P_IDX)) { for (int rep_ = 0; rep_ < NREP(P_IDX); ++rep_) { idx_phase(lds, wave, ws); } }
    SEAM(P_IDX);
    if (IN(P_ATT1)) { for (int rep_ = NREP(P_ATT1) - 1; rep_ >= 0; --rep_) attn1_phase(lds, wave, ws, rep_ != 0); }
    SEAM(P_ATT1);
    if (IN(P_OUT1)) { EpiResidT<true, false> E{nullptr, XB, nullptr, XB, PART}; run_gemm(lds, wave, QB, (const bf16_t*)(ws + WS_WOUT1), DM, DM, E); }
    SEAM(P_OUT1);
    if (IN(P_UP1)) { for (int rep_ = 0; rep_ < NREP(P_UP1); ++rep_) { EpiUp E{PART, UB, ETBL}; run_gemm(lds, wave, XB, (const bf16_t*)(ws + WS_W1_1), DFF, DM, E); } }
    SEAM(P_UP1);
    if (IN(P_DN1)) { EpiResidT<true, true> E{nullptr, XB, args.out, nullptr, nullptr}; run_gemm(lds, wave, UB, (const bf16_t*)(ws + WS_W2_1), DM, DFF, E); }
#undef IN
#undef SEAM
}

static int g_mk_ready = 0;
static void mk_launch(hipStream_t st, void* const* d_in, void* d_out, void* d_ws, int lo, int hi, int coop) {
    if (!g_mk_ready) { (void)hipFuncSetAttribute((const void*)mk_fwd, hipFuncAttributeMaxDynamicSharedMemorySize, LDS_BYTES); g_mk_ready = 1; }
    Args a{};
    for (int i = 0; i < 22; ++i) a.in[i] = (const float*)d_in[i];
    a.out = (float*)d_out; a.ws = (unsigned char*)d_ws; a.ph_lo = lo; a.ph_hi = hi; a.coop = coop; a.pad = 0;
    hipLaunchKernelGGL(mk_fwd, dim3(256), dim3(NWAVES * 64), LDS_BYTES, st, a);
}

extern "C" void kernel_launch(void* const* d_in, const int* in_sizes, int n_in, void* d_out, int out_size, void* d_ws, size_t ws_size, hipStream_t stream) {
    static int grid = 0;
    if (grid == 0) {
        int dev = 0, cus = 0, per_cu = 0;
        (void)hipGetDevice(&dev);
        (void)hipDeviceGetAttribute(&cus, hipDeviceAttributeMultiprocessorCount, dev);
        (void)hipFuncSetAttribute((const void*)mk_fwd, hipFuncAttributeMaxDynamicSharedMemorySize, LDS_BYTES);
        (void)hipOccupancyMaxActiveBlocksPerMultiprocessor(&per_cu, (const void*)mk_fwd, NWAVES * 64, LDS_BYTES);
        if (per_cu < 1) per_cu = 1;
        if (per_cu > 1) per_cu = 1;
        grid = cus * per_cu; if (grid > 256) grid = 256; if (grid < 1) grid = 1;
        if (ws_size < WS_END) { fprintf(stderr, "kernel_launch: workspace too small (%zu)\n", ws_size); }
    }
    (void)hipMemsetAsync((char*)d_ws + WS_CTL, 0, CTL_BYTES, stream);
    Args a{};
    for (int i = 0; i < 22; ++i) a.in[i] = (const float*)d_in[i];
    a.out = (float*)d_out; a.ws = (unsigned char*)d_ws; a.ph_lo = 0; a.ph_hi = P_N; a.coop = 1; a.pad = 0;
    void* kargs[] = {&a};
    hipError_t e = hipLaunchCooperativeKernel((const void*)mk_fwd, dim3(grid), dim3(NWAVES * 64), kargs, LDS_BYTES, stream);
    if (e != hipSuccess) fprintf(stderr, "cooperative launch failed: %s (grid %d)\n", hipGetErrorString(e), grid);
}
```

```cpp
#include <hip/hip_runtime.h>
#include <stdint.h>
#include <math.h>
#include <stdio.h>
#ifndef PROBE_PHASE
#define PROBE_PHASE (-1)
#endif
#define LAS __attribute__((address_space(3)))
#define GAS __attribute__((address_space(1)))
typedef unsigned short bf16_t;
typedef short bf16x8 __attribute__((ext_vector_type(8)));
typedef float f32x4 __attribute__((ext_vector_type(4)));
typedef float f32x16 __attribute__((ext_vector_type(16)));
typedef unsigned u32x4 __attribute__((ext_vector_type(4)));
typedef unsigned u32x2 __attribute__((ext_vector_type(2)));

constexpr int BATCH = 2, SEQ = 8192, DM = 1024, DFF = 4096, TOK = BATCH * SEQ;
constexpr float EPS = 1e-6f;
constexpr float LOG2E = 1.4426950408889634f;
constexpr int NIN1 = 2376, NIN1P = 2560;
constexpr size_t MiB = 1u << 20;
constexpr size_t WS_XB = 0, WS_Q = 32 * MiB, WS_K = 64 * MiB, WS_V = 96 * MiB, WS_U = 32 * MiB;
constexpr size_t WS_CQ = 160 * MiB, WS_QI = 168 * MiB, WS_KI = 184 * MiB, WS_MASK = 186 * MiB;
constexpr size_t WS_CS = 204 * MiB, WS_MISC = 205 * MiB, WS_PART = 206 * MiB, WS_CQP = 207 * MiB, WS_WIDX = 207 * MiB + 256 * 1024;
constexpr size_t WS_QIN = WS_MISC + 512 * 1024;
constexpr size_t WS_CTL = WS_MISC + 4096;
constexpr size_t CTL_BYTES = 64 * 1024;
constexpr size_t WS_WIN0 = 208 * MiB, WS_WOUT0 = 214 * MiB, WS_W1_0 = 216 * MiB, WS_W2_0 = 224 * MiB, WS_WIN1 = 232 * MiB, WS_WUQ = 237 * MiB,
                 WS_WOUT1 = 238 * MiB, WS_W1_1 = 240 * MiB, WS_W2_1 = 248 * MiB, WS_END = 256 * MiB;

__device__ __forceinline__ unsigned cvt_pk_bf16(float lo, float hi) {
    typedef float f32x2_t __attribute__((ext_vector_type(2))); typedef __bf16 bf16x2_t __attribute__((ext_vector_type(2)));
    f32x2_t v = {lo, hi}; bf16x2_t b = __builtin_convertvector(v, bf16x2_t); return __builtin_bit_cast(unsigned, b);
}
__host__ __device__ __forceinline__ int tile_pos(int cl) { const int wc = cl >> 6, fq = (cl >> 4) & 3, bj = (cl >> 3) & 1, n = (cl >> 2) & 1, j = cl & 3; return 128 * bj + 32 * wc + 16 * n + 4 * fq + j; }
__device__ __forceinline__ int fresh_lane() { int l; asm volatile("v_mbcnt_lo_u32_b32 %0, -1, 0\n\tv_mbcnt_hi_u32_b32 %0, -1, %0" : "=v"(l)); return l; }
__device__ __forceinline__ float wave_sum(float v) {
#pragma unroll
    for (int o = 1; o < 64; o <<= 1) v += __shfl_xor(v, o);
    return v;
}
namespace pg8 {
#define PG8_LAS __attribute__((address_space(3)))
typedef unsigned short bf16_t;
typedef short bf16x8 __attribute__((ext_vector_type(8)));
typedef float f32x4 __attribute__((ext_vector_type(4)));
typedef unsigned u32x4 __attribute__((ext_vector_type(4)));
constexpr int BM = 256, BK = 64, HALF = 128, HTB = HALF * BK * 2  , STAGE_BYTES = 8 * HTB, NXCD = 8, WGM = 8;

__host__ __device__ __forceinline__ int lds_byte(int r, int c) { const int st = (r >> 4) * 2 + (c >> 5), rr = r & 15, cc = c & 31, ob = rr * 64 + cc * 2; return st * 1024 + (ob ^ (((ob >> 9) & 1) << 5)); }
__host__ __device__ __forceinline__ void stage_rc(int b, int& R, int& C) { const int st = b / 1024, sb = b % 1024, swz = sb ^ (((sb >> 9) & 1) << 5); R = (st >> 1) * 16 + swz / 64; C = (st & 1) * 32 + (swz % 64) / 2; }
__host__ __device__ __forceinline__ int perm32(int rho) { const int n = rho >> 4, i = rho & 15; return 8 * (i >> 2) + 4 * n + (i & 3); }

struct Unit { int pm, pn; };
struct Gemm { const bf16_t* A; const bf16_t* Bt; int M, N, K; };

struct StaticOrder {
    int nM, nN, nwg, G, c;
    __host__ __device__ void init(int M, int N, int G_, int c_) { nM = M / BM; nN = N / BM; nwg = nM * nN; G = G_; c = c_; }
    __host__ __device__ bool next(int i, Unit& u) const {
        const long L = (long)i * G + c; if (L >= nwg) return false;
        int wgid = (int)L; { const int q = nwg / NXCD, r = nwg % NXCD, xcd = wgid % NXCD, off = wgid / NXCD; wgid = (xcd < r ? xcd * (q + 1) : r * (q + 1) + (xcd - r) * q) + off; }
        const int nig = WGM * nN, gid = wgid / nig, fm = gid * WGM, gsz = (nM - fm) < WGM ? (nM - fm) : WGM;
        u.pm = fm + ((wgid % nig) % gsz); u.pn = (wgid % nig) / gsz; return true;
    }
    __device__ __forceinline__ void a_ready(const Unit&) const {}
    __device__ __forceinline__ void done(const Unit&) const {}
};

__device__ __forceinline__ unsigned cvt_pk_bf16(float lo, float hi) { unsigned r; asm volatile("v_cvt_pk_bf16_f32 %0, %1, %2" : "=v"(r) : "v"(lo), "v"(hi)); return r; }
typedef float f32x2 __attribute__((ext_vector_type(2)));
template <class Epi, class Sched, bool ALIGN_EPI = false, bool SP2 = false>
__device__ __forceinline__ void gemm_phase(PG8_LAS unsigned char* lds, const Gemm g, const Sched& S, const Epi& E, const int wid, const int lane) {
    const int tid = wid * 64 + lane, wr = wid >> 2, wc = wid & 3, fr = lane & 15, fq = lane >> 4;
    const int K = g.K, nt = K / BK;
    unsigned voffA[2], voffB[2];
#pragma unroll
    for (int i = 0; i < 2; ++i) { int R, C; stage_rc(tid * 16 + i * 8192, R, C); const int Rb = Epi::PERM ? ((R & ~31) + perm32(R & 31)) : R;
        voffA[i] = (unsigned)(R * K + C) * 2u; voffB[i] = (unsigned)(Rb * K + C) * 2u; }
    const size_t kstep = (size_t)(BK * 2);
    const size_t hstep = (size_t)HALF * K * 2;
    const size_t tstep = 2 * hstep;
    const unsigned ldsw = (unsigned)wid * 1024u;
    const int aoff = lds_byte(wr * 64 + fr, fq * 8), boff = lds_byte(wc * 32 + fr, fq * 8);
#define PG8_SA(b, h) (((b) * 2 + (h)) * HTB)
#define PG8_SB(b, h) ((4 + (b) * 2 + (h)) * HTB)
#define PG8_STAGE(bufoff, gbase, voff) do { _Pragma("unroll") for (int _i = 0; _i < 2; ++_i) \
        __builtin_amdgcn_global_load_lds((const unsigned*)((const char*)(gbase) + (voff)[_i]), (PG8_LAS unsigned*)(lds + (bufoff) + ldsw + _i * 8192), 16, 0, 0); } while (0)
#define PG8_LDA(dst, b, h) do { _Pragma("unroll") for (int m = 0; m < 4; ++m) _Pragma("unroll") for (int k = 0; k < 2; ++k) dst[m][k] = *(const PG8_LAS bf16x8*)(lds + PG8_SA(b, h) + aoff + m * 2048 + k * 1024); } while (0)
#define PG8_LDB(dst, b, h) do { _Pragma("unroll") for (int n = 0; n < 2; ++n) _Pragma("unroll") for (int k = 0; k < 2; ++k) dst[n][k] = *(const PG8_LAS bf16x8*)(lds + PG8_SB(b, h) + boff + n * 2048 + k * 1024); } while (0)
#define PG8_MMA(ai, bj, At, Bt) do { __builtin_amdgcn_s_setprio(1); _Pragma("unroll") for (int m = 0; m < 4; ++m) _Pragma("unroll") for (int n = 0; n < 2; ++n) _Pragma("unroll") for (int k = 0; k < 2; ++k) \
        acc[ai][bj][m][n] = __builtin_amdgcn_mfma_f32_16x16x32_bf16(Bt[n][k], At[m][k], acc[ai][bj][m][n], 0, 0, 0); __builtin_amdgcn_s_setprio(0); } while (0)
#define PG8_WAIT_V(n) asm volatile("s_waitcnt vmcnt(" #n ")" ::: "memory")
#define PG8_WAIT_L(n) asm volatile("s_waitcnt lgkmcnt(" #n ")" ::: "memory")
#define PG8_BAR __builtin_amdgcn_s_barrier()
#define PG8_SCHED __builtin_amdgcn_sched_barrier(0)
    Unit cur, nxt; int ui = 0;
    if (!S.next(0, cur)) return;
    f32x4 acc[2][2][4][2];
#pragma unroll
    for (int a = 0; a < 2; ++a)
#pragma unroll
        for (int b = 0; b < 2; ++b)
#pragma unroll
            for (int m = 0; m < 4; ++m)
#pragma unroll
                for (int n = 0; n < 2; ++n) acc[a][b][m][n] = (f32x4){0.f, 0.f, 0.f, 0.f};
    bf16x8 At[4][2], B0[2][2], B1[2][2];
    const char* cA = (const char*)g.A + (size_t)cur.pm * tstep; const char* cB = (const char*)g.Bt + (size_t)cur.pn * tstep;
    S.a_ready(cur);
    if constexpr (SP2) {
        PG8_STAGE(PG8_SB(0, 0), cB, voffB); PG8_STAGE(PG8_SB(0, 1), cB + hstep, voffB); PG8_STAGE(PG8_SA(0, 0), cA, voffA); PG8_STAGE(PG8_SA(0, 1), cA + hstep, voffA);
        if (wr == 1) PG8_BAR;
        PG8_WAIT_V(2); PG8_BAR;
        PG8_STAGE(PG8_SB(1, 0), cB + kstep, voffB); PG8_STAGE(PG8_SA(1, 0), cA + kstep, voffA); PG8_STAGE(PG8_SB(1, 1), cB + hstep + kstep, voffB);
        PG8_WAIT_V(6); PG8_BAR;
    } else {
        PG8_STAGE(PG8_SB(0, 0), cB, voffB); PG8_STAGE(PG8_SA(0, 0), cA, voffA); PG8_STAGE(PG8_SB(0, 1), cB + hstep, voffB); PG8_STAGE(PG8_SA(0, 1), cA + hstep, voffA);
        if (wr == 1) PG8_BAR;
        PG8_WAIT_V(4); PG8_BAR;
        PG8_STAGE(PG8_SB(1, 0), cB + kstep, voffB); PG8_STAGE(PG8_SA(1, 0), cA + kstep, voffA); PG8_STAGE(PG8_SB(1, 1), cB + hstep + kstep, voffB);
        PG8_WAIT_V(6); PG8_BAR;
    }
    for (;;) {
        const bool has_next = S.next(ui + 1, nxt);
        const char* nA = has_next ? (const char*)g.A + (size_t)nxt.pm * tstep : cA; const char* nB = has_next ? (const char*)g.Bt + (size_t)nxt.pn * tstep : cB;
        for (int t = 0; t < nt; t += 2) {
            const bool last = (t == nt - 2);
            const char* a1 = cA + (size_t)(t + 1) * kstep;
            const char* a2 = last ? nA : cA + (size_t)(t + 2) * kstep; const char* b2 = last ? nB : cB + (size_t)(t + 2) * kstep;
            const char* a3 = a2 + kstep; const char* b3 = b2 + kstep;
            if (last && has_next) S.a_ready(nxt);
            if constexpr (SP2) {
            PG8_LDB(B0, 0, 0); PG8_LDB(B1, 0, 1); PG8_SCHED; PG8_LDA(At, 0, 0); PG8_STAGE(PG8_SA(1, 1), a1 + hstep, voffA);
            PG8_WAIT_V(8); PG8_WAIT_L(0); PG8_BAR; PG8_MMA(0, 0, At, B0); PG8_MMA(0, 1, At, B1); PG8_BAR; PG8_SCHED;
            PG8_LDA(At, 0, 1); PG8_STAGE(PG8_SB(0, 0), b2, voffB); PG8_STAGE(PG8_SB(0, 1), b2 + hstep, voffB); PG8_STAGE(PG8_SA(0, 0), a2, voffA);
            PG8_WAIT_V(8); PG8_WAIT_L(0); PG8_BAR; PG8_MMA(1, 0, At, B0); PG8_MMA(1, 1, At, B1); PG8_BAR; PG8_SCHED;
            PG8_LDB(B0, 1, 0); PG8_LDB(B1, 1, 1); PG8_SCHED; PG8_LDA(At, 1, 0); PG8_STAGE(PG8_SA(0, 1), a2 + hstep, voffA);
            PG8_WAIT_V(8); PG8_WAIT_L(0); PG8_BAR; PG8_MMA(0, 0, At, B0); PG8_MMA(0, 1, At, B1); PG8_BAR; PG8_SCHED;
            PG8_LDA(At, 1, 1); PG8_STAGE(PG8_SB(1, 0), b3, voffB); PG8_STAGE(PG8_SB(1, 1), b3 + hstep, voffB); PG8_STAGE(PG8_SA(1, 0), a3, voffA);
            PG8_WAIT_V(8); PG8_WAIT_L(0); PG8_BAR; PG8_MMA(1, 0, At, B0); PG8_MMA(1, 1, At, B1); PG8_BAR; PG8_SCHED;
            } else {
            PG8_LDB(B0, 0, 0); PG8_SCHED; PG8_LDA(At, 0, 0); PG8_STAGE(PG8_SA(1, 1), a1 + hstep, voffA);
            PG8_WAIT_L(8); PG8_BAR; PG8_WAIT_L(0); PG8_MMA(0, 0, At, B0); PG8_BAR; PG8_SCHED;
            PG8_LDB(B1, 0, 1); PG8_STAGE(PG8_SB(0, 0), b2, voffB);
            PG8_BAR; PG8_WAIT_L(0); PG8_MMA(0, 1, At, B1); PG8_BAR;
            PG8_LDA(At, 0, 1); PG8_STAGE(PG8_SA(0, 0), a2, voffA);
            PG8_BAR; PG8_WAIT_L(0); PG8_MMA(1, 0, At, B0); PG8_BAR; PG8_SCHED;
            PG8_STAGE(PG8_SB(0, 1), b2 + hstep, voffB);
            PG8_WAIT_V(6); PG8_BAR; PG8_MMA(1, 1, At, B1); PG8_BAR;
            PG8_LDB(B0, 1, 0); PG8_SCHED; PG8_LDA(At, 1, 0); PG8_STAGE(PG8_SA(0, 1), a2 + hstep, voffA);
            PG8_WAIT_L(8); PG8_BAR; PG8_WAIT_L(0); PG8_MMA(0, 0, At, B0); PG8_BAR; PG8_SCHED;
            PG8_LDB(B1, 1, 1); PG8_STAGE(PG8_SB(1, 0), b3, voffB);
            PG8_BAR; PG8_WAIT_L(0); PG8_MMA(0, 1, At, B1); PG8_BAR;
            PG8_LDA(At, 1, 1); PG8_STAGE(PG8_SA(1, 0), a3, voffA);
            PG8_BAR; PG8_WAIT_L(0); PG8_MMA(1, 0, At, B0); PG8_BAR; PG8_SCHED;
            PG8_STAGE(PG8_SB(1, 1), b3 + hstep, voffB);
            PG8_WAIT_V(6); PG8_BAR; PG8_MMA(1, 1, At, B1); PG8_BAR;
            }
        }
        if constexpr (ALIGN_EPI) { if (wr == 0) PG8_BAR; }
        if constexpr (!Epi::AFTER_DRAIN) { const int le = fresh_lane(); E(acc, cur, wr, wc, le & 15, le >> 4); S.done(cur); }
        if (!has_next) break;
#pragma unroll
        for (int a = 0; a < 2; ++a)
#pragma unroll
            for (int b = 0; b < 2; ++b)
#pragma unroll
                for (int m = 0; m < 4; ++m)
#pragma unroll
                    for (int n = 0; n < 2; ++n) acc[a][b][m][n] = (f32x4){0.f, 0.f, 0.f, 0.f};
        cur = nxt; cA = nA; cB = nB; ++ui;
        if constexpr (ALIGN_EPI) { if (wr == 1) PG8_BAR; }
    }
    PG8_WAIT_V(0);
    if constexpr (!ALIGN_EPI) { if (wr == 0) PG8_BAR; }
    PG8_BAR;
    if constexpr (Epi::AFTER_DRAIN) { E.fused(acc, cur, wr, wc, fr, fq, lds, wid, lane); S.done(cur); }
#undef PG8_SA
#undef PG8_SB
#undef PG8_STAGE
#undef PG8_LDA
#undef PG8_LDB
#undef PG8_MMA
#undef PG8_WAIT_V
#undef PG8_WAIT_L
#undef PG8_BAR
#undef PG8_SCHED
}
}
typedef f32x4 acc_t[2][2][4][2];

__device__ __forceinline__ float rstd_from_parts16(const float* __restrict__ part, int row) {
    const f32x4* p = (const f32x4*)(part + (size_t)row * 16);
    const f32x4 a = p[0], b = p[1], c = p[2], d = p[3];
    const float s = ((a[0] + a[1]) + (a[2] + a[3])) + ((b[0] + b[1]) + (b[2] + b[3])) + ((c[0] + c[1]) + (c[2] + c[3])) + ((d[0] + d[1]) + (d[2] + d[3]));
    return 1.0f / sqrtf(s * (1.0f / 1024.0f) + EPS);
}
constexpr int EPI_TBL_OFF = 131072;
__device__ __forceinline__ void fill_rstd16(LAS float* T, const float* __restrict__ part, int pm, int wr, int lane) {
    const float r0 = rstd_from_parts16(part, pm * 256 + wr * 64 + lane), r1 = rstd_from_parts16(part, pm * 256 + 128 + wr * 64 + lane);
    T[lane] = r0; T[64 + lane] = r1;
}
__device__ __forceinline__ float quad_sum(float s) { s += __shfl_xor(s, 16); s += __shfl_xor(s, 32); return s; }
__device__ __forceinline__ float sumsq16(const f32x4 (&v)[2][2]) {
    float s = 0.f;
#pragma unroll
    for (int bj = 0; bj < 2; ++bj)
#pragma unroll
        for (int n = 0; n < 2; ++n) s += (v[bj][n][0] * v[bj][n][0] + v[bj][n][1] * v[bj][n][1]) + (v[bj][n][2] * v[bj][n][2] + v[bj][n][3] * v[bj][n][3]);
    return s;
}
__device__ __forceinline__ void head_norm_rope(f32x4 (&v)[2][2], bool do_norm, bool use_gain, const f32x4 (&g)[2][2], const float* __restrict__ cs_row, int fq, float scale) {
    if (do_norm) {
        const float ss = quad_sum(sumsq16(v));
        const float rn = 1.0f / sqrtf(ss * (1.0f / 64.0f) + EPS);
#pragma unroll
        for (int bj = 0; bj < 2; ++bj)
#pragma unroll
            for (int n = 0; n < 2; ++n) { v[bj][n] = v[bj][n] * rn; if (use_gain) v[bj][n] = v[bj][n] * g[bj][n]; }
    }
    if (fq == 0) {
        const f32x4* c4 = (const f32x4*)cs_row;
#pragma unroll
        for (int n = 0; n < 2; ++n) {
            const f32x4 c = c4[n], s = c4[2 + n];
            const f32x4 x1 = v[0][n], x2 = v[1][n];
            v[0][n] = x1 * c - x2 * s;
            v[1][n] = x2 * c + x1 * s;
        }
    }
    if (scale != 1.0f) {
#pragma unroll
        for (int bj = 0; bj < 2; ++bj)
#pragma unroll
            for (int n = 0; n < 2; ++n) v[bj][n] = v[bj][n] * scale;
    }
}
__device__ __forceinline__ void store_bf16x16(bf16_t* p, const f32x4 (&v)[2][2]) {
#pragma unroll
    for (int bj = 0; bj < 2; ++bj) {
        u32x4 w; w.x = cvt_pk_bf16(v[bj][0][0], v[bj][0][1]); w.y = cvt_pk_bf16(v[bj][0][2], v[bj][0][3]); w.z = cvt_pk_bf16(v[bj][1][0], v[bj][1][1]); w.w = cvt_pk_bf16(v[bj][1][2], v[bj][1][3]);
        *(u32x4*)(p + 8 * bj) = w;
    }
}
__device__ __forceinline__ void load_gain16(f32x4 (&g)[2][2], const float* __restrict__ gp, int fq) {
#pragma unroll
    for (int bj = 0; bj < 2; ++bj)
#pragma unroll
        for (int n = 0; n < 2; ++n) g[bj][n] = *(const f32x4*)(gp + 16 * fq + 8 * bj + 4 * n);
}

struct EpiQKV0 {
    static constexpr bool PERM = false, AFTER_DRAIN = false;
    const float* part; const float* cs; const float* qg; const float* kg; bf16_t* QKV; size_t stride; float qscale; LAS float* T;
    mutable int last_pm = -1;
    __device__ __forceinline__ void operator()(const acc_t& acc, const pg8::Unit& u, int wr, int wc, int fr, int fq) const {
        const int kind = u.pn >> 2, head = (u.pn & 3) * 4 + wc;
        bf16_t* dst = QKV + (size_t)kind * stride + head * 64 + 16 * fq;
        f32x4 g[2][2] = {};
        if (kind < 2) load_gain16(g, kind == 0 ? qg : kg, fq);
        if (u.pm != last_pm) { fill_rstd16(T, part, u.pm, wr, fr + 16 * fq); last_pm = u.pm; }
#pragma unroll
        for (int ai = 0; ai < 2; ++ai)
#pragma unroll
            for (int m = 0; m < 4; ++m) {
                const int row = u.pm * 256 + ai * 128 + wr * 64 + m * 16 + fr;
                const float rs = T[ai * 64 + m * 16 + fr];
                f32x4 v[2][2];
#pragma unroll
                for (int bj = 0; bj < 2; ++bj)
#pragma unroll
                    for (int n = 0; n < 2; ++n) v[bj][n] = acc[ai][bj][m][n] * rs;
                if (kind < 2) head_norm_rope(v, true, true, g, cs + (size_t)row * 16, fq, kind == 0 ? qscale : 1.0f);
                store_bf16x16(dst + (size_t)row * DM, v);
            }
    }
};
template <bool RES_BF16, bool OUT_F32> struct EpiResidT {
    static constexpr bool PERM = false, AFTER_DRAIN = false;
    const float* R; const bf16_t* Rb; float* out; bf16_t* xb; float* part;
    __device__ __forceinline__ void operator()(const acc_t& acc, const pg8::Unit& u, int wr, int wc, int fr, int fq) const {
        const int col0 = u.pn * 256 + wc * 64 + 16 * fq;
#pragma unroll
        for (int ai = 0; ai < 2; ++ai)
#pragma unroll
            for (int m = 0; m < 4; ++m) {
                const int row = u.pm * 256 + ai * 128 + wr * 64 + m * 16 + fr;
                const size_t off = (size_t)row * DM + col0;
                f32x4 v[2][2];
                if (RES_BF16) {
#pragma unroll
                    for (int bj = 0; bj < 2; ++bj) {
                        const u32x4 w = *(const u32x4*)(Rb + off + 8 * bj);
                        const unsigned ww[4] = {w.x, w.y, w.z, w.w};
#pragma unroll
                        for (int n = 0; n < 2; ++n) {
                            f32x4 r; r[0] = __builtin_bit_cast(float, ww[2 * n] << 16); r[1] = __builtin_bit_cast(float, ww[2 * n] & 0xffff0000u);
                            r[2] = __builtin_bit_cast(float, ww[2 * n + 1] << 16); r[3] = __builtin_bit_cast(float, ww[2 * n + 1] & 0xffff0000u);
                            v[bj][n] = r + acc[ai][bj][m][n];
                        }
                    }
                } else {
#pragma unroll
                    for (int bj = 0; bj < 2; ++bj)
#pragma unroll
                        for (int n = 0; n < 2; ++n) v[bj][n] = *(const f32x4*)(R + off + 8 * bj + 4 * n) + acc[ai][bj][m][n];
                }
                if (OUT_F32) {
#pragma unroll
                    for (int bj = 0; bj < 2; ++bj)
#pragma unroll
                        for (int n = 0; n < 2; ++n) *(f32x4*)(out + off + 8 * bj + 4 * n) = v[bj][n];
                }
                if (xb) store_bf16x16(xb + off, v);
                if (part) { const float ss = quad_sum(sumsq16(v)); if (fq == 0) part[(size_t)row * 16 + u.pn * 4 + wc] = ss; }
            }
    }
};
struct EpiUp {
    static constexpr bool PERM = false, AFTER_DRAIN = false;
    const float* part; bf16_t* U; LAS float* T;
    mutable int last_pm = -1;
    __device__ __forceinline__ void operator()(const acc_t& acc, const pg8::Unit& u, int wr, int wc, int fr, int fq) const {
        const int col0 = u.pn * 256 + wc * 64 + 16 * fq;
        if (u.pm != last_pm) { fill_rstd16(T, part, u.pm, wr, fr + 16 * fq); last_pm = u.pm; }
#pragma unroll
        for (int ai = 0; ai < 2; ++ai)
#pragma unroll
            for (int m = 0; m < 4; ++m) {
                const int row = u.pm * 256 + ai * 128 + wr * 64 + m * 16 + fr;
                const float rs = T[ai * 64 + m * 16 + fr];
                f32x4 v[2][2];
#pragma unroll
                for (int bj = 0; bj < 2; ++bj)
#pragma unroll
                    for (int n = 0; n < 2; ++n) {
                        f32x4 t = acc[ai][bj][m][n] * rs;
#pragma unroll
                        for (int j = 0; j < 4; ++j) { const float r = fmaxf(t[j], 0.f); t[j] = r * r; }
                        v[bj][n] = t;
                    }
                store_bf16x16(U + (size_t)row * DFF + col0, v);
            }
    }
};
struct EpiIn1 {
    static constexpr bool PERM = false, AFTER_DRAIN = false;
    const float* part; const float* cs; const float* kg; bf16_t* CQ; float* cqp; bf16_t* K; bf16_t* V; bf16_t* KI; float* widx; float wscale; LAS float* T;
    mutable int last_pm = -1;
    __device__ __forceinline__ void operator()(const acc_t& acc, const pg8::Unit& u, int wr, int wc, int fr, int fq) const {
        const int pn = u.pn;
        if (pn == 9 && wc >= 2) return;
        f32x4 g[2][2] = {};
        if (pn >= 1 && pn <= 4) load_gain16(g, kg, fq);
        if (u.pm != last_pm) { fill_rstd16(T, part, u.pm, wr, fr + 16 * fq); last_pm = u.pm; }
#pragma unroll
        for (int ai = 0; ai < 2; ++ai)
#pragma unroll
            for (int m = 0; m < 4; ++m) {
                const int row = u.pm * 256 + ai * 128 + wr * 64 + m * 16 + fr;
                const float rs = T[ai * 64 + m * 16 + fr];
                f32x4 v[2][2];
#pragma unroll
                for (int bj = 0; bj < 2; ++bj)
#pragma unroll
                    for (int n = 0; n < 2; ++n) v[bj][n] = acc[ai][bj][m][n] * rs;
                if (pn == 0) {
                    store_bf16x16(CQ + (size_t)row * 256 + wc * 64 + 16 * fq, v);
                    const float ss = quad_sum(sumsq16(v)); if (fq == 0) cqp[(size_t)row * 4 + wc] = ss;
                } else if (pn <= 4) {
                    head_norm_rope(v, true, true, g, cs + (size_t)row * 16, fq, 1.0f);
                    store_bf16x16(K + (size_t)row * DM + ((pn - 1) * 4 + wc) * 64 + 16 * fq, v);
                } else if (pn <= 8) {
                    store_bf16x16(V + (size_t)row * DM + ((pn - 5) * 4 + wc) * 64 + 16 * fq, v);
                } else if (wc == 0) {
                    head_norm_rope(v, true, false, g, cs + (size_t)row * 16, fq, 1.0f);
                    store_bf16x16(KI + (size_t)row * 64 + 16 * fq, v);
                } else if (fq == 0) {
                    *(f32x4*)(widx + (size_t)row * 8) = v[0][0] * wscale; *(f32x4*)(widx + (size_t)row * 8 + 4) = v[0][1] * wscale;
                }
            }
    }
};
struct EpiQup {
    static constexpr bool PERM = false, AFTER_DRAIN = false;
    const float* cqp; const float* cs; const float* qg; const float* widx; bf16_t* Q; bf16_t* QI; float* qin; float qscale; LAS float* T;
    __device__ __forceinline__ void operator()(const acc_t& acc, const pg8::Unit& u, int wr, int wc, int fr, int fq) const {
        const int pn = u.pn;
        f32x4 g[2][2] = {};
        if (pn < 4) load_gain16(g, qg, fq);
        { const int lane = fr + 16 * fq;
          const f32x4 c0 = *(const f32x4*)(cqp + (size_t)(u.pm * 256 + wr * 64 + lane) * 4), c1 = *(const f32x4*)(cqp + (size_t)(u.pm * 256 + 128 + wr * 64 + lane) * 4);
          T[lane] = 1.0f / sqrtf(((c0[0] + c0[1]) + (c0[2] + c0[3])) * (1.0f / 256.0f) + EPS); T[64 + lane] = 1.0f / sqrtf(((c1[0] + c1[1]) + (c1[2] + c1[3])) * (1.0f / 256.0f) + EPS); }
#pragma unroll
        for (int ai = 0; ai < 2; ++ai)
#pragma unroll
            for (int m = 0; m < 4; ++m) {
                const int row = u.pm * 256 + ai * 128 + wr * 64 + m * 16 + fr;
                const float rs = T[ai * 64 + m * 16 + fr];
                f32x4 v[2][2];
#pragma unroll
                for (int bj = 0; bj < 2; ++bj)
#pragma unroll
                    for (int n = 0; n < 2; ++n) v[bj][n] = acc[ai][bj][m][n] * rs;
                if (pn < 4) {
                    head_norm_rope(v, true, true, g, cs + (size_t)row * 16, fq, qscale);
                    store_bf16x16(Q + (size_t)row * DM + (pn * 4 + wc) * 64 + 16 * fq, v);
                } else {
                    const int hh = (pn - 4) * 4 + wc;
                    head_norm_rope(v, false, false, g, cs + (size_t)row * 16, fq, 1.0f);
                    const float nrm = sqrtf(quad_sum(sumsq16(v)));
                    const float inv = nrm > 0.f ? 1.0f / (8.2f * nrm) : 0.f;
#pragma unroll
                    for (int bj = 0; bj < 2; ++bj)
#pragma unroll
                        for (int n = 0; n < 2; ++n) v[bj][n] = v[bj][n] * inv;
                    store_bf16x16(QI + (size_t)row * 512 + hh * 64 + 16 * fq, v);
                    if (fq == 0) qin[(size_t)row * 8 + hh] = widx[(size_t)row * 8 + hh] * (8.2f * nrm);
                }
            }
    }
};
typedef GAS unsigned gu32;
#define RLX_AGENT __ATOMIC_RELAXED, __HIP_MEMORY_SCOPE_AGENT
#define LDS_WAIT() asm volatile("s_waitcnt lgkmcnt(0)" ::: "memory")
#define VM_WAIT() asm volatile("s_waitcnt vmcnt(0)" ::: "memory")

constexpr int RING_BYTES = 143360;
constexpr int MISC_OFF = RING_BYTES + 320;
constexpr int LDS_BYTES = 147456;
constexpr int NWAVES = 8;

#define XB_TMO      128
#define XB_XCNT(j)  (256  + 64 * (j))
#define XB_XSUB(j)  (1280 + 64 * (j))
#define XB_XGEN(j)  (2304 + 64 * (j))
#define XB_TOP      3328
#define XB_TOPGEN   3392
#define XCD_BAR_WORDS 3456
#define XB_SPIN_CAP (1u << 18)
__device__ __forceinline__ unsigned xb_ld(unsigned* p)              { return __hip_atomic_load(p, __ATOMIC_RELAXED, __HIP_MEMORY_SCOPE_AGENT); }
__device__ __forceinline__ unsigned xb_add(unsigned* p, unsigned v) { return __hip_atomic_fetch_add(p, v, __ATOMIC_RELAXED, __HIP_MEMORY_SCOPE_AGENT); }
__device__ __forceinline__ unsigned xb_xcc_id() { return (unsigned)__builtin_amdgcn_s_getreg((3 << 11) | 20) & 0xFu; }
#define XB_SPIN(cond, bar) do { unsigned _sp = 0; while (cond) { __builtin_amdgcn_s_sleep(1); \
    if ((++_sp & 255u) == 0u) { if (xb_ld(&(bar)[XB_TMO])) break; if (_sp > XB_SPIN_CAP) { atomicAdd(&(bar)[XB_TMO], 1u); break; } } } } while (0)
struct XcdBarrier { unsigned* bar; unsigned x; volatile LAS unsigned* st; };
__device__ __forceinline__ XcdBarrier xcd_barrier_post(unsigned* bar, volatile LAS unsigned* st) {
    XcdBarrier b; b.bar = bar; b.x = xb_xcc_id(); b.st = st;
    if (threadIdx.x == 0) (void)xb_add(&bar[XB_XCNT(b.x)], 1u);
    return b;
}
__device__ __forceinline__ void xcd_barrier_complete(unsigned* bar, unsigned x, unsigned& nloc, unsigned& nx) {
    const unsigned G = gridDim.x * gridDim.y * gridDim.z;
    unsigned sum, cnt, mine, sp = 0u;
    for (;;) {
        sum = 0u; cnt = 0u; mine = 0u;
#pragma unroll
        for (unsigned j = 0; j < 16; ++j) { const unsigned c = xb_ld(&bar[XB_XCNT(j)]); sum += c; cnt += (c > 0u) ? 1u : 0u; mine = (j == x) ? c : mine; }
        if (sum == G) break;
        __builtin_amdgcn_s_sleep(1);
        if ((++sp & 255u) == 0u) { if (xb_ld(&bar[XB_TMO])) break; if (sp > XB_SPIN_CAP) { atomicAdd(&bar[XB_TMO], 1u); break; } }
    }
    nloc = mine > 0u ? mine : 1u; nx = cnt > 0u ? cnt : 1u;
}
__device__ __forceinline__ void xcd_barrier(const XcdBarrier& b, const int wave) {
    asm volatile("s_waitcnt vmcnt(0)" ::: "memory");
    __syncthreads();
    if (wave == 0 && fresh_lane() == 0) {
        unsigned* bar = b.bar;
        __builtin_amdgcn_s_waitcnt(0);
        unsigned nloc = b.st[0], nx = b.st[1];
        if (nloc == 0u) { xcd_barrier_complete(bar, b.x, nloc, nx); b.st[0] = nloc; b.st[1] = nx; }
        const unsigned old = xb_add(&bar[XB_XSUB(b.x)], 1u);
        const unsigned gen = old / nloc;
        if (old + 1u == (gen + 1u) * nloc) {
            __builtin_amdgcn_fence(__ATOMIC_RELEASE, "agent");
            asm volatile("s_waitcnt vmcnt(0)" ::: "memory");
            const unsigned og = xb_add(&bar[XB_TOP], 1u);
            const unsigned tg = og / nx;
            if (og + 1u == (tg + 1u) * nx) xb_add(&bar[XB_TOPGEN], 1u);
            else XB_SPIN(xb_ld(&bar[XB_TOPGEN]) == tg, bar);
            __builtin_amdgcn_fence(__ATOMIC_ACQUIRE, "agent");
            xb_add(&bar[XB_XGEN(b.x)], 1u);
            asm volatile("s_waitcnt vmcnt(0)" ::: "memory");
        } else {
            XB_SPIN(xb_ld(&bar[XB_XGEN(b.x)]) == gen, bar);
            __builtin_amdgcn_fence(__ATOMIC_ACQUIRE, "agent");
            asm volatile("s_waitcnt vmcnt(0)" ::: "memory");
        }
    }
    __syncthreads();
}

__device__ __forceinline__ unsigned f2bf(float f) { unsigned u = __builtin_bit_cast(unsigned, f); return (u + 0x7fffu + ((u >> 16) & 1u)) >> 16; }
__device__ __forceinline__ unsigned pk2(float lo, float hi) { return f2bf(lo) | (f2bf(hi) << 16); }
__device__ __forceinline__ void p0_transpose_item(const float* __restrict__ W, int K, int N, const float* __restrict__ gain, bf16_t* WT, int row_off, LAS float* scr, int item, int nblk, int lane) {
    const int kb = item / nblk, nb = item % nblk, k0 = 64 * kb, n0 = 32 * nb;
    const int cc = n0 + (lane & 31);
    float wv[32];
#pragma unroll
    for (int i = 0; i < 32; ++i) { const int kk = 2 * i + (lane >> 5); wv[i] = (cc < N) ? W[(size_t)(k0 + kk) * N + cc] : 0.f; }
    if (gain) {
#pragma unroll
        for (int i = 0; i < 32; ++i) wv[i] *= gain[k0 + 2 * i + (lane >> 5)];
    }
#pragma unroll
    for (int i = 0; i < 32; ++i) scr[(2 * i + (lane >> 5)) * 33 + (lane & 31)] = wv[i];
    LDS_WAIT(); asm volatile("" ::: "memory");
    const int c = lane & 7;
#pragma unroll
    for (int j = 0; j < 4; ++j) { const int n = (lane >> 3) + 8 * j; const LAS float* s = scr + (8 * c) * 33 + n;
        u32x4 o; o.x = pk2(s[0 * 33], s[1 * 33]); o.y = pk2(s[2 * 33], s[3 * 33]); o.z = pk2(s[4 * 33], s[5 * 33]); o.w = pk2(s[6 * 33], s[7 * 33]);
        const int cl = n0 + n; const int drow = row_off + (cl & ~255) + tile_pos(cl & 255);
        *(GAS u32x4*)(WT + (size_t)drow * K + k0 + 8 * c) = o; }
    LDS_WAIT(); asm volatile("" ::: "memory");
}
struct WJob { const float* W; const float* gain; bf16_t* WT; int K, N, Npad, row_off; };
template <int NR> __device__ __forceinline__ void rows_to_bf16(const float* x, bf16_t* xb, float* part, int m, int rstride, int lane) {
    f32x4 v[NR][4];
#pragma unroll
    for (int r = 0; r < NR; ++r) { const GAS f32x4* xr = (const GAS f32x4*)(x + (size_t)(m + r * rstride) * DM) + lane;
#pragma unroll
        for (int j = 0; j < 4; ++j) v[r][j] = xr[64 * j]; }
#pragma unroll
    for (int r = 0; r < NR; ++r) {
        float s = 0.f;
#pragma unroll
        for (int j = 0; j < 4; ++j) s += (v[r][j][0] * v[r][j][0] + v[r][j][1] * v[r][j][1]) + (v[r][j][2] * v[r][j][2] + v[r][j][3] * v[r][j][3]);
        s = wave_sum(s);
        GAS u32x2* o8 = (GAS u32x2*)(xb + (size_t)(m + r * rstride) * DM) + lane;
#pragma unroll
        for (int j = 0; j < 4; ++j) { u32x2 w; w.x = cvt_pk_bf16(v[r][j][0], v[r][j][1]); w.y = cvt_pk_bf16(v[r][j][2], v[r][j][3]); o8[64 * j] = w; }
        if (lane < 16) part[(size_t)(m + r * rstride) * 16 + lane] = (lane == 0) ? s : 0.f;
    }
}
constexpr int ATT_SCR = 131072;
constexpr int ATT_NST = 4;
typedef short v4i16_t __attribute__((ext_vector_type(4)));
typedef short s16x4 __attribute__((ext_vector_type(4)));
__device__ __forceinline__ int crow(int r, int hi) { return (r & 3) + 8 * (r >> 2) + 4 * hi; }
__device__ __forceinline__ s16x4 vtr(const LAS unsigned char* p) { return __builtin_bit_cast(s16x4, __builtin_amdgcn_ds_read_tr16_b64_v4i16((LAS v4i16_t*)p)); }
__device__ __forceinline__ void glds16(const void* gsrc, unsigned lds_dst) { unsigned keep;
    asm volatile("s_mov_b32 %0, m0\n\ts_mov_b32 m0, %2\n\ts_nop 0\n\tglobal_load_lds_dwordx4 %1, off\n\ts_mov_b32 m0, %0" : "=&s"(keep) : "v"(gsrc), "s"(lds_dst) : "memory"); }
__device__ __forceinline__ void glds4(const void* gsrc, unsigned lds_dst) { unsigned keep;
    asm volatile("s_mov_b32 %0, m0\n\ts_mov_b32 m0, %2\n\ts_nop 0\n\tglobal_load_lds_dword %1, off\n\ts_mov_b32 m0, %0" : "=&s"(keep) : "v"(gsrc), "s"(lds_dst) : "memory"); }
#define ATT_WAIT_BAR() do { asm volatile("s_waitcnt vmcnt(0) lgkmcnt(0)" ::: "memory"); __builtin_amdgcn_s_barrier(); asm volatile("" ::: "memory"); } while (0)
#define ATT_WAIT_BAR_N(N) do { asm volatile("s_waitcnt vmcnt(" #N ") lgkmcnt(0)" ::: "memory"); __builtin_amdgcn_s_barrier(); asm volatile("" ::: "memory"); } while (0)

__device__ __forceinline__ int att_k_src_chunk(int row, int slot) { return slot ^ ((row >> 1) & 7); }
__device__ __forceinline__ void att_qkt(f32x16& p0, f32x16& p1, const LAS unsigned char* Kslot, const int (&koff)[4], const bf16x8 (&qr)[4]) {
    p0 = (f32x16){}; p1 = (f32x16){};
#pragma unroll
    for (int d0 = 0; d0 < 4; ++d0) {
        const bf16x8 b0 = *(const LAS bf16x8*)(Kslot + koff[d0]);
        const bf16x8 b1 = *(const LAS bf16x8*)(Kslot + koff[d0] + 4096);
        p0 = __builtin_amdgcn_mfma_f32_32x32x16_bf16(b0, qr[d0], p0, 0, 0, 0);
        p1 = __builtin_amdgcn_mfma_f32_32x32x16_bf16(b1, qr[d0], p1, 0, 0, 0);
    }
}
__device__ __forceinline__ bf16x8 pack8(const f32x16& p, int base) {
    u32x4 w; w.x = cvt_pk_bf16(p[base], p[base + 1]); w.y = cvt_pk_bf16(p[base + 2], p[base + 3]); w.z = cvt_pk_bf16(p[base + 4], p[base + 5]); w.w = cvt_pk_bf16(p[base + 6], p[base + 7]);
    return __builtin_bit_cast(bf16x8, w);
}

template <int NDB, bool MASKED, int VAR = 0> __device__ __forceinline__ void att_step(f32x16 (&o)[NDB], f32x16& ol, bf16x8 (&pa)[4], float& l, const LAS unsigned char* Kslot, const LAS unsigned char* Vslot,
                                                                       const int (&koff)[4], const int (&vboff)[NDB], const bf16x8 (&qr)[4], unsigned mlo, unsigned mhi, const bool live) {
    constexpr int ROWB = NDB * 64;
    bf16x8 vfa[NDB == 2 ? 8 : 1];
    if (NDB == 2) {
#pragma unroll
        for (int i = 0; i < 8; ++i) { const int d = i >> 2, ks = i & 3;
            const s16x4 lo = vtr(Vslot + vboff[d] + ks * 16 * ROWB), hi4 = vtr(Vslot + vboff[d] + ks * 16 * ROWB + 8 * ROWB);
            vfa[i] = (bf16x8){lo[0], lo[1], lo[2], lo[3], hi4[0], hi4[1], hi4[2], hi4[3]}; }
    }
    f32x16 p0, p1;
    if (VAR & 8) { p0 = (f32x16){}; p1 = (f32x16){}; asm volatile("" : "+v"(p0), "+v"(p1)); } else att_qkt(p0, p1, Kslot, koff, qr);
    __builtin_amdgcn_sched_barrier(0);
    bf16x8 pn[4];
#pragma unroll
    for (int sl = 0; sl < 4; ++sl) {
#pragma unroll
        for (int j = 0; j < NDB; ++j) {
            const int d = (NDB == 4) ? sl : (sl >> 1), ks = (NDB == 4) ? j : (2 * (sl & 1) + j);
            bf16x8 vf;
            if (NDB == 2) { vf = vfa[d * 4 + ks]; } else
            if (VAR & 16) { vf = pa[ks]; } else {
                const s16x4 lo = vtr(Vslot + vboff[d] + ks * 16 * ROWB), hi4 = vtr(Vslot + vboff[d] + ks * 16 * ROWB + 8 * ROWB);
                vf = (bf16x8){lo[0], lo[1], lo[2], lo[3], hi4[0], hi4[1], hi4[2], hi4[3]}; }
            if (VAR & 4) { asm volatile("" :: "v"(vf)); } else
            o[d] = __builtin_amdgcn_mfma_f32_32x32x16_bf16(pa[ks], vf, o[d], 0, 0, 0);
        }
        if (NDB == 2) {
            const bf16x8 ones = (bf16x8){0x3F80, 0x3F80, 0x3F80, 0x3F80, 0x3F80, 0x3F80, 0x3F80, 0x3F80};
            ol = __builtin_amdgcn_mfma_f32_32x32x16_bf16(pa[sl], ones, ol, 0, 0, 0);
        }
        f32x16& p = (sl < 2) ? p0 : p1;
        const unsigned mk = (sl < 2) ? mlo : mhi;
        const int rb0 = 8 * (sl & 1);
        float ps = 0.f;
        if (MASKED && !(VAR & 1)) {
            const unsigned m3 = mk, m2 = mk << 1, m1 = mk << 2, m0 = mk << 3;
            float e[8];
#pragma unroll
            for (int i = 0; i < 8; ++i) e[i] = (VAR & 2) ? p[rb0 + i] : __builtin_amdgcn_exp2f(p[rb0 + i]);
#define SDWA_AND_(d, m, B) "v_and_b32_sdwa " d ", " d ", sext(" m ") dst_sel:DWORD dst_unused:UNUSED_PAD src0_sel:DWORD src1_sel:BYTE_" B "\n\t"
            if (sl & 1)
                asm("s_nop 0\n\t" SDWA_AND_("%0", "%8", "2") SDWA_AND_("%1", "%9", "2") SDWA_AND_("%2", "%10", "2") SDWA_AND_("%3", "%11", "2")
                                  SDWA_AND_("%4", "%8", "3") SDWA_AND_("%5", "%9", "3") SDWA_AND_("%6", "%10", "3") SDWA_AND_("%7", "%11", "3")
                    : "+v"(e[0]), "+v"(e[1]), "+v"(e[2]), "+v"(e[3]), "+v"(e[4]), "+v"(e[5]), "+v"(e[6]), "+v"(e[7]) : "v"(m0), "v"(m1), "v"(m2), "v"(m3));
            else
                asm("s_nop 0\n\t" SDWA_AND_("%0", "%8", "0") SDWA_AND_("%1", "%9", "0") SDWA_AND_("%2", "%10", "0") SDWA_AND_("%3", "%11", "0")
                                  SDWA_AND_("%4", "%8", "1") SDWA_AND_("%5", "%9", "1") SDWA_AND_("%6", "%10", "1") SDWA_AND_("%7", "%11", "1")
                    : "+v"(e[0]), "+v"(e[1]), "+v"(e[2]), "+v"(e[3]), "+v"(e[4]), "+v"(e[5]), "+v"(e[6]), "+v"(e[7]) : "v"(m0), "v"(m1), "v"(m2), "v"(m3));
#undef SDWA_AND_
#pragma unroll
            for (int i = 0; i < 8; ++i) { p[rb0 + i] = e[i]; if (NDB != 2) ps += e[i]; }
        } else {
#pragma unroll
            for (int r = rb0; r < rb0 + 8; ++r) { const float e = (VAR & 2) ? p[r] : __builtin_amdgcn_exp2f(p[r]); p[r] = e; if (NDB != 2) ps += e; }
        }
        if (NDB != 2) l += live ? ps : 0.f;
        pn[sl] = pack8(p, rb0);
        __builtin_amdgcn_sched_barrier(0);
    }
#pragma unroll
    for (int ks = 0; ks < 4; ++ks) pa[ks] = pn[ks];
}

constexpr int A0_STAGE = 32768;
template <int VAR = 0> __device__ __forceinline__ void attn0_unit(LAS unsigned char* lds, const int wave, int b, int h, int qb, const bf16_t* Q, const bf16_t* __restrict__ K, const bf16_t* __restrict__ V, bf16_t* O,
                                           float lam, const float* __restrict__ subg, float outscale, bool dry) {
    const int lane = fresh_lane(), r32 = lane & 31, hi = lane >> 5;
    const int cc = wave >> 2, rb = wave & 3;
    const size_t rowbase = (size_t)b * SEQ;
    const int q0 = qb * 128 + rb * 32;
    const int NT = 2 * qb + 2;
    const int mylast = 2 * qb + (rb >> 1);
    const int krow = 8 * wave + (lane >> 3), kch = att_k_src_chunk(krow, lane & 7);
    const bf16_t* ksrc0 = K + (rowbase + krow) * DM + (2 * h + 0) * 64 + kch * 8;
    const bf16_t* ksrc1 = K + (rowbase + krow) * DM + (2 * h + 1) * 64 + kch * 8;
    const int vp0 = wave, vp1 = wave + 8;
    const int vrow0 = 4 * vp0 + (lane >> 4), vrow1 = 4 * vp1 + (lane >> 4), vs = lane & 15;
    const bf16_t* vsrc0 = V + (rowbase + vrow0) * DM + h * 128 + ((((vs >> 2) ^ (vrow0 & 3)) << 2) | (vs & 3)) * 8;
    const bf16_t* vsrc1 = V + (rowbase + vrow1) * DM + h * 128 + ((((vs >> 2) ^ (vrow1 & 3)) << 2) | (vs & 3)) * 8;
    const unsigned ldsb = (unsigned)(unsigned long long)lds;
#define A0_ISSUE(t, st) do { const unsigned sb_ = (unsigned)__builtin_amdgcn_readfirstlane(ldsb + (st) * A0_STAGE); const size_t go_ = (size_t)(t) * 64 * DM; \
        glds16(ksrc0 + go_, sb_ + wave * 1024); glds16(ksrc1 + go_, sb_ + 8192 + wave * 1024); \
        glds16(vsrc0 + go_, sb_ + 16384 + vp0 * 1024); glds16(vsrc1 + go_, sb_ + 16384 + vp1 * 1024); } while (0)
    bf16x8 qr[4];
    { const bf16_t* Qw = Q + (rowbase + q0) * DM + (2 * h + cc) * 64;
#pragma unroll
      for (int d0 = 0; d0 < 4; ++d0) qr[d0] = *(const bf16x8*)(Qw + (size_t)r32 * DM + d0 * 16 + hi * 8); }
    A0_ISSUE(0, 0); A0_ISSUE(1, 1);
    f32x16 o[4]; o[0] = (f32x16){}; o[1] = (f32x16){}; o[2] = (f32x16){}; o[3] = (f32x16){};
    float l = 0.f;
    int koff[4], vboff[4];
    { const int sw = (r32 >> 1) & 7, q4 = (lane & 15) >> 2, vbase = (4 * hi + q4) * 256 + ((lane >> 4) & 1) * 32 + (lane & 3) * 8;
#pragma unroll
      for (int d = 0; d < 4; ++d) { koff[d] = r32 * 128 + (((2 * d + hi) ^ sw) << 4); vboff[d] = vbase + ((d ^ q4) << 6); } }
    if (wave >= 4) __builtin_amdgcn_s_setprio(1);
    bf16x8 pa[4]; pa[0] = (bf16x8){}; pa[1] = (bf16x8){}; pa[2] = (bf16x8){}; pa[3] = (bf16x8){};
    int sk = 0, sv = 3;
    for (int t = 0; t <= NT; ++t) {
        if (t + 1 < NT) ATT_WAIT_BAR_N(4); else ATT_WAIT_BAR();
        if (t + 2 < NT) A0_ISSUE(t + 2, ((sk + 2) & 3));
        if (t <= mylast + 1) {
            const LAS unsigned char* Kslot = lds + sk * A0_STAGE + cc * 8192;
            const LAS unsigned char* Vslot = lds + (t == 0 ? 0 : sv) * A0_STAGE + 16384;
            att_step<4, false, VAR>(o, o[0], pa, l, Kslot, Vslot, koff, vboff, qr, 0u, 0u, t <= mylast);
        }
        sv = sk; sk = (sk + 1) & 3;
    }
#undef A0_ISSUE
    __builtin_amdgcn_s_setprio(0);
    ATT_WAIT_BAR();
    const int lane_e = fresh_lane(), r32e = lane_e & 31, hie = lane_e >> 5;
    l += __shfl_xor(l, 32);
    LAS float* wsf = (LAS float*)(lds + ATT_SCR + wave * 256);
    if (hie == 0) wsf[r32e] = l;
    asm volatile("s_waitcnt lgkmcnt(0)" ::: "memory");
    float rli[16];
#pragma unroll
    for (int r = 0; r < 16; ++r) rli[r] = 1.0f / wsf[crow(r, hie)];
    LAS float* X = (LAS float*)lds;
    if (cc == 1) {
#pragma unroll
        for (int r = 0; r < 16; ++r)
#pragma unroll
            for (int d = 0; d < 4; ++d) X[(rb * 32 + crow(r, hie)) * 128 + d * 32 + r32e] = o[d][r] * rli[r];
    }
    ATT_WAIT_BAR();
    if (cc == 0 && !dry) {
        float gsub[4];
#pragma unroll
        for (int d = 0; d < 4; ++d) gsub[d] = subg[d * 32 + r32e] * outscale;
#pragma unroll
        for (int r = 0; r < 16; ++r) {
            float v[4]; float ss = 0.f;
#pragma unroll
            for (int d = 0; d < 4; ++d) { v[d] = o[d][r] * rli[r] - lam * X[(rb * 32 + crow(r, hie)) * 128 + d * 32 + r32e]; ss += v[d] * v[d]; }
            ss += __shfl_xor(ss, 1); ss += __shfl_xor(ss, 2); ss += __shfl_xor(ss, 4); ss += __shfl_xor(ss, 8); ss += __shfl_xor(ss, 16);
            const float rn = 1.0f / sqrtf(ss * (1.0f / 128.0f) + EPS);
            bf16_t* op = O + (rowbase + q0 + crow(r, hie)) * DM + h * 128 + r32e;
#pragma unroll
            for (int d = 0; d < 4; ++d) op[d * 32] = (bf16_t)(cvt_pk_bf16(v[d] * rn * gsub[d], 0.f) & 0xffffu);
        }
    }
    ATT_WAIT_BAR();
}
__device__ __forceinline__ void attn0_phase(LAS unsigned char* lds, const int wave, unsigned char* ws, const float* subln, bool dry) {
    const int G = gridDim.x, bx = blockIdx.x;
    const bf16_t* Q = (const bf16_t*)(ws + WS_Q); const bf16_t* K = (const bf16_t*)(ws + WS_K); const bf16_t* V = (const bf16_t*)(ws + WS_V);
    const float lam = *(const float*)(ws + WS_MISC);
    for (int vb = bx; vb < 256; vb += G) {
        const int x = vb & 7, j = vb >> 3;
#pragma unroll 1
        for (int i = 0; i < 4; ++i) {
            const int r = i >> 1, jj = (j + 16 * r) & 31, qb = (i & 1) ? 63 - jj : jj, bh = 2 * x + r;
#if defined(PROBE_ATT0_VAR)
            if (dry) attn0_unit<PROBE_ATT0_VAR>(lds, wave, bh >> 3, bh & 7, qb, Q, K, V, (bf16_t*)(ws + WS_Q), lam, subln, 0.8f, dry); else
#endif
            attn0_unit<0>(lds, wave, bh >> 3, bh & 7, qb, Q, K, V, (bf16_t*)(ws + WS_Q), lam, subln, 0.8f, dry);
        }
    }
}

constexpr int A1_STAGE = 16384;
constexpr int A1_MASK = ATT_NST * A1_STAGE;
template <int VAR = 0> __device__ __forceinline__ void attn1_unit(LAS unsigned char* lds, const int wave, int b, int h, int qb, const bf16_t* Q, const bf16_t* __restrict__ K, const bf16_t* __restrict__ V, bf16_t* O,
                                           const unsigned long long* __restrict__ MASK, bool dry, const bool pre = false, const int nb = 0, const int nh = 0, const int nqb = -1) {
    const int lane = fresh_lane(), r32 = lane & 31, hi = lane >> 5;
    const size_t rowbase = (size_t)b * SEQ;
    const int q0 = qb * 256 + wave * 32;
    const int NT = 4 * qb + 4;
    const int mylast = 4 * qb + (wave >> 1);
    const int krow = 8 * wave + (lane >> 3);
    const bf16_t* ksrc = K + (rowbase + krow) * DM + h * 64 + att_k_src_chunk(krow, lane & 7) * 8;
    const bf16_t* vsrc = V + (rowbase + krow) * DM + h * 64 + ((lane & 7) ^ (((krow >> 1) & 1) << 2)) * 8;
    const unsigned ldsb = (unsigned)(unsigned long long)lds;
    const unsigned long long* mrow = MASK + (size_t)b * 128 * SEQ + q0;
#define A1_ISSUE(t, st) do { const unsigned sb_ = (unsigned)__builtin_amdgcn_readfirstlane(ldsb + (st) * A1_STAGE); const size_t go_ = (size_t)(t) * 64 * DM; \
        glds16(ksrc + go_, sb_ + wave * 1024); glds16(vsrc + go_, sb_ + 8192 + wave * 1024); \
        glds4((const unsigned*)(mrow + (size_t)(t) * SEQ) + lane, (unsigned)__builtin_amdgcn_readfirstlane(ldsb + A1_MASK + ((st) * NWAVES + wave) * 256)); } while (0)
    bf16x8 qr[4];
    { const bf16_t* Qw = Q + (rowbase + q0) * DM + h * 64;
#pragma unroll
      for (int d0 = 0; d0 < 4; ++d0) qr[d0] = *(const bf16x8*)(Qw + (size_t)r32 * DM + d0 * 16 + hi * 8); }
    if (!pre) { A1_ISSUE(0, 0); A1_ISSUE(1, 1); }
    f32x16 o[2]; o[0] = (f32x16){}; o[1] = (f32x16){};
    f32x16 ol = (f32x16){};
    float l = 0.f;
    int koff[4], vboff[2];
    { const int sw = (r32 >> 1) & 7, q4 = (lane & 15) >> 2, vbase = (4 * hi + q4) * 128 + ((lane >> 4) & 1) * 32 + (lane & 3) * 8;
#pragma unroll
      for (int d = 0; d < 4; ++d) koff[d] = r32 * 128 + (((2 * d + hi) ^ sw) << 4);
#pragma unroll
      for (int d = 0; d < 2; ++d) vboff[d] = vbase + ((d ^ ((q4 >> 1) & 1)) << 6); }
    bf16x8 pa[4]; pa[0] = (bf16x8){}; pa[1] = (bf16x8){}; pa[2] = (bf16x8){}; pa[3] = (bf16x8){};
    int sk = 0, sv = 3;
    if (wave >= 4) __builtin_amdgcn_s_setprio(1);
    for (int t = 0; t <= NT; ++t) {
        if (VAR & 32) { asm volatile("s_waitcnt vmcnt(0) lgkmcnt(0)" ::: "memory"); } else
        if (t + 1 < NT) ATT_WAIT_BAR_N(3); else ATT_WAIT_BAR();
        if (!(VAR & 64)) if (t + 2 < NT) A1_ISSUE(t + 2, ((sk + 2) & 3));
        const unsigned long long mw = *(const LAS unsigned long long*)(lds + A1_MASK + (sk * NWAVES + wave) * 256 + r32 * 8);
        const unsigned mlo = (unsigned)mw << (4 - 4 * hi), mhi = (unsigned)(mw >> 32) << (4 - 4 * hi);
        if (t <= mylast + 1) {
            const LAS unsigned char* Kslot = lds + sk * A1_STAGE;
            const LAS unsigned char* Vslot = lds + (t == 0 ? 0 : sv) * A1_STAGE + 8192;
            att_step<2, true, VAR>(o, ol, pa, l, Kslot, Vslot, koff, vboff, qr, mlo, mhi, t <= mylast);
        }
        sv = sk; sk = (sk + 1) & 3;
    }
#undef A1_ISSUE
    __builtin_amdgcn_s_setprio(0);
    if (nqb >= 0) {
        const int ln = fresh_lane(), krn = 8 * wave + (ln >> 3);
        const size_t nrow = (size_t)nb * SEQ;
        const bf16_t* ks_n = K + (nrow + krn) * DM + nh * 64 + att_k_src_chunk(krn, ln & 7) * 8;
        const bf16_t* vs_n = V + (nrow + krn) * DM + nh * 64 + ((ln & 7) ^ (((krn >> 1) & 1) << 2)) * 8;
        const unsigned long long* mr_n = MASK + (size_t)nb * 128 * SEQ + nqb * 256 + wave * 32;
#pragma unroll
        for (int tt = 0; tt < 2; ++tt) {
            const unsigned sb_ = (unsigned)__builtin_amdgcn_readfirstlane(ldsb + tt * A1_STAGE); const size_t go_ = (size_t)tt * 64 * DM;
            glds16(ks_n + go_, sb_ + wave * 1024); glds16(vs_n + go_, sb_ + 8192 + wave * 1024);
            glds4((const unsigned*)(mr_n + (size_t)tt * SEQ) + ln, (unsigned)__builtin_amdgcn_readfirstlane(ldsb + A1_MASK + (tt * NWAVES + wave) * 256));
        }
    }
    if (dry) asm volatile("" :: "v"(o[0]), "v"(o[1]), "v"(ol));
    const int lane_e = fresh_lane(), r32e = lane_e & 31, hie = lane_e >> 5;
    if (!dry)
#pragma unroll
    for (int r = 0; r < 16; ++r) {
        const float rl = 1.0f / ol[r];
        bf16_t* op = O + (rowbase + q0 + crow(r, hie)) * DM + h * 64 + r32e;
        op[0] = (bf16_t)(cvt_pk_bf16(o[0][r] * rl, 0.f) & 0xffffu); op[32] = (bf16_t)(cvt_pk_bf16(o[1][r] * rl, 0.f) & 0xffffu);
    }
    (void)l;
    ATT_WAIT_BAR();
}
__device__ __forceinline__ void attn1_phase(LAS unsigned char* lds, const int wave, unsigned char* ws, bool dry) {
    const int G = gridDim.x, bx = blockIdx.x;
    const bf16_t* Q = (const bf16_t*)(ws + WS_Q); const bf16_t* K = (const bf16_t*)(ws + WS_K); const bf16_t* V = (const bf16_t*)(ws + WS_V);
    for (int vb = bx; vb < 256; vb += G) {
        const int x = vb & 7, j = vb >> 3;
#pragma unroll 1
        for (int i = 0; i < 4; ++i) {
            const int jj = (j + 16 * (i >> 1)) & 31, qb = (i & 1) ? 31 - jj : jj, bh = 4 * x + i;
#if defined(PROBE_ATT1_VAR)
            if (dry) attn1_unit<PROBE_ATT1_VAR>(lds, wave, bh >> 4, bh & 15, qb, Q, K, V, (bf16_t*)(ws + WS_Q), (const unsigned long long*)(ws + WS_MASK), dry); else
#endif
            {   const int i2 = i + 1, jn = (j + 16 * (i2 >> 1)) & 31, nqb = (i2 < 4 && !dry) ? ((i2 & 1) ? 31 - jn : jn) : -1, nbh = 4 * x + i2;
                attn1_unit<0>(lds, wave, bh >> 4, bh & 15, qb, Q, K, V, (bf16_t*)(ws + WS_Q), (const unsigned long long*)(ws + WS_MASK), dry, i > 0 && !dry, nbh >> 4, nbh & 15, nqb); }
        }
    }
}
constexpr int IX_NB = 512, IX_HSTR = 513, IX_CAP = 320, IX_BSTR = 257;
constexpr int IX_HIST = 0, IX_CK = 0, IX_CI = 32 * IX_CAP * 4, IX_BM = 66560, IX_META = IX_BM + 32 * IX_BSTR * 4 + 128;
constexpr int IX_QS = 100352, IX_QPITCH = 1040;
static_assert(IX_META + 512 <= IX_QS && IX_QS + 32 * IX_QPITCH <= RING_BYTES, "indexer LDS map (query image)");
static_assert(IX_CI + 32 * IX_CAP * 2 <= IX_BM && 32 * IX_HSTR * 4 <= IX_BM && IX_META + 512 <= RING_BYTES, "indexer LDS map");

__device__ __forceinline__ void ix_abs_fma(f32x16& sc, const f32x16& d, float ah) {
#pragma unroll
    for (int r = 0; r < 16; ++r) { float t = sc[r]; asm("v_fma_f32 %0, %1, |%2|, %0" : "+v"(t) : "v"(ah), "v"(d[r])); sc[r] = t; }
}
__device__ __forceinline__ void ix_scores(f32x16& sc, const bf16x8 (&kf)[4], const bf16x8 (&qf)[8][4], const bf16x8 (&qc)[4], const float (&ah)[8]) {
    sc = (f32x16){};
#pragma unroll
    for (int s = 0; s < 4; ++s) sc = __builtin_amdgcn_mfma_f32_32x32x16_bf16(kf[s], qc[s], sc, 0, 0, 0);
    f32x16 d0 = (f32x16){}, d1;
#pragma unroll
    for (int s = 0; s < 4; ++s) d0 = __builtin_amdgcn_mfma_f32_32x32x16_bf16(kf[s], qf[0][s], d0, 0, 0, 0);
    asm volatile("" : "+v"(sc), "+v"(d0));
    __builtin_amdgcn_sched_barrier(0);
#pragma unroll
    for (int h = 0; h < 8; h += 2) {
        d1 = (f32x16){};
#pragma unroll
        for (int s = 0; s < 4; ++s) d1 = __builtin_amdgcn_mfma_f32_32x32x16_bf16(kf[s], qf[h + 1][s], d1, 0, 0, 0);
        asm volatile("" : "+v"(d1), "+v"(d0), "+v"(sc));
        __builtin_amdgcn_sched_barrier(0);
        ix_abs_fma(sc, d0, ah[h]);
        asm volatile("" : "+v"(sc));
        __builtin_amdgcn_sched_barrier(0);
        if (h + 2 < 8) {
            d0 = (f32x16){};
#pragma unroll
            for (int s = 0; s < 4; ++s) d0 = __builtin_amdgcn_mfma_f32_32x32x16_bf16(kf[s], qf[h + 2][s], d0, 0, 0, 0);
            asm volatile("" : "+v"(d0), "+v"(d1), "+v"(sc));
        } else {
            asm volatile("s_nop 15\n\ts_nop 3" : "+v"(d1), "+v"(sc));
        }
        __builtin_amdgcn_sched_barrier(0);
        ix_abs_fma(sc, d1, ah[h + 1]);
        asm volatile("" : "+v"(sc));
        __builtin_amdgcn_sched_barrier(0);
    }
}
__device__ __forceinline__ void ix_combine(bf16x8 (&qc)[4], const bf16x8 (&qf)[8][4], const float (&ah)[8]) {
#pragma unroll
    for (int s = 0; s < 4; ++s) {
        float acc[8];
#pragma unroll
        for (int j = 0; j < 8; ++j) acc[j] = 0.f;
#pragma unroll
        for (int h = 0; h < 8; ++h)
#pragma unroll
            for (int j = 0; j < 8; ++j) acc[j] = __builtin_fmaf(ah[h], __uint_as_float((unsigned)(unsigned short)qf[h][s][j] << 16), acc[j]);
        u32x4 w; w.x = cvt_pk_bf16(acc[0], acc[1]); w.y = cvt_pk_bf16(acc[2], acc[3]); w.z = cvt_pk_bf16(acc[4], acc[5]); w.w = cvt_pk_bf16(acc[6], acc[7]);
        qc[s] = __builtin_bit_cast(bf16x8, w);
    }
}
__device__ __forceinline__ int ix_bin(float sc, float Rs, float scale) {
    const int b = (int)__builtin_fmaf(sc, scale, Rs);
    return b < 0 ? 0 : (b > IX_NB - 1 ? IX_NB - 1 : b);
}
__device__ __forceinline__ void ix_loadk(bf16x8 (&kf)[4], const bf16_t* KIb, int kt, int r32, int hi) {
    const int l_ = fresh_lane();
    const bf16_t* p = KIb + (size_t)(unsigned)((kt * 32 + (l_ & 31)) * 64 + (l_ >> 5) * 8);
#pragma unroll
    for (int s = 0; s < 4; ++s) kf[s] = *(const bf16x8*)(p + s * 16);
}

__device__ __forceinline__ void idx_unit(LAS unsigned char* lds, const int wave, unsigned char* ws, int b, int qt, const int dry) {
    const int lane = fresh_lane(), r32 = lane & 31, hi = lane >> 5, tid = wave * 64 + lane;
    const int chunk = qt >> 1;
    const size_t tok0 = (size_t)b * SEQ + (size_t)qt * 32;
    unsigned* MASK32 = (unsigned*)(ws + WS_MASK);
    if (chunk < 4) {
        if (!dry) for (int t = wave; t <= chunk; t += 8) MASK32[((size_t)(b * 128 + t) * SEQ + qt * 32 + r32) * 2 + hi] = 0xFFFFFFFFu;
        return;
    }
    const bf16_t* KIb = (const bf16_t*)(ws + WS_KI) + (size_t)b * SEQ * 64;
    LAS unsigned* HIST = (LAS unsigned*)(lds + IX_HIST);
    LAS float* CK = (LAS float*)(lds + IX_CK);
    LAS unsigned short* CI = (LAS unsigned short*)(lds + IX_CI);
    LAS unsigned* BM = (LAS unsigned*)(lds + IX_BM);
    LAS int* META = (LAS int*)(lds + IX_META);
    { const unsigned ldsb_ = (unsigned)(unsigned long long)lds; const int lq_ = fresh_lane();
#pragma unroll
      for (int rr = 0; rr < 4; ++rr) { const int row_ = wave * 4 + rr;
          glds16((const bf16_t*)(ws + WS_QI) + (tok0 + row_) * 512 + lq_ * 8, (unsigned)__builtin_amdgcn_readfirstlane(ldsb_ + IX_QS + row_ * IX_QPITCH)); } }
#define IX_LOADQ(qf) do { const int l_ = fresh_lane(); const LAS unsigned char* qp_ = lds + IX_QS + (l_ & 31) * IX_QPITCH + (l_ >> 5) * 16; \
        _Pragma("unroll") for (int h = 0; h < 8; ++h) _Pragma("unroll") for (int s = 0; s < 4; ++s) qf[h][s] = *(const LAS bf16x8*)(qp_ + h * 128 + s * 32); } while (0)
    float a[8]; float R;
    { const float* np = (const float*)(ws + WS_QIN) + (tok0 + r32) * 8;
      const f32x4 n0 = *(const f32x4*)np, n1 = *(const f32x4*)(np + 4);
#pragma unroll
      for (int h = 0; h < 4; ++h) { a[h] = 0.5f * n0[h]; a[4 + h] = 0.5f * n1[h]; }
      R = (((fabsf(n0[0]) + fabsf(n0[1])) + (fabsf(n0[2]) + fabsf(n0[3]))) + ((fabsf(n1[0]) + fabsf(n1[1])) + (fabsf(n1[2]) + fabsf(n1[3])))) * 1.03f;
      R = fmaxf(R, 1e-30f); }
    const float scale = (float)(IX_NB / 2) / R, Rs = (float)(IX_NB / 2);
    const int nkt = 2 * (chunk + 1);
    for (int i = tid; i < 32 * IX_HSTR; i += NWAVES * 64) HIST[i] = 0u;
    for (int i = tid; i < 32 * IX_BSTR; i += NWAVES * 64) BM[i] = 0u;
    if (tid < 128) META[tid] = 0;
    asm volatile("s_waitcnt vmcnt(0)" ::: "memory");
    LDS_WAIT(); __builtin_amdgcn_s_barrier(); asm volatile("" ::: "memory");
#if defined(PROBE_IDX_DRY)
    if (dry == 5) return;
#endif
    {
        bf16x8 qf[8][4]; IX_LOADQ(qf);
        bf16x8 qc[4]; ix_combine(qc, qf, a);
#if defined(PROBE_IDX_DRY)
        if (dry == 6) { asm volatile("" :: "v"(qc[0]), "v"(qc[1]), "v"(qc[2]), "v"(qc[3])); return; }
#endif
        bf16x8 kf[4], kn[4];
        if (wave < nkt) ix_loadk(kf, KIb, wave, r32, hi);
#pragma unroll 1
        for (int kt = wave; kt < nkt; kt += 8) {
            if (kt + 8 < nkt) ix_loadk(kn, KIb, kt + 8, r32, hi);
            f32x16 sc;
            ix_scores(sc, kf, qf, qc, a);
#pragma unroll
            for (int r = 0; r < 16; ++r) {
                const int bin = ix_bin(sc[r], Rs, scale);
                __hip_atomic_fetch_add(HIST + r32 * IX_HSTR + bin, 1u, __ATOMIC_RELAXED, __HIP_MEMORY_SCOPE_WORKGROUP);
            }
#pragma unroll
            for (int s = 0; s < 4; ++s) kf[s] = kn[s];
        }
    }
    LDS_WAIT(); __builtin_amdgcn_s_barrier(); asm volatile("" ::: "memory");
#if defined(PROBE_IDX_DRY)
    if (dry == 7) return;
#endif
#pragma unroll 1
    for (int i = 0; i < 4; ++i) {
        const int q = wave * 4 + i;
        int lane8 = 8 * lane; asm volatile("" : "+v"(lane8));
        unsigned wv[8]; unsigned c = 0;
#pragma unroll
        for (int w = 0; w < 8; ++w) { wv[w] = HIST[q * IX_HSTR + lane8 + w]; c += wv[w]; }
        unsigned x = c;
#pragma unroll
        for (int off = 1; off < 64; off <<= 1) { const unsigned y = __shfl_down(x, off); if (lane + off < 64) x += y; }
        const unsigned sx = x - c;
        if (sx < 256u && x >= 256u) {
            unsigned cum = sx; int found = 0, tb = 0, kr = 0, tc = 0;
#pragma unroll
            for (int w = 7; w >= 0; --w) {
                if (!found) { if (cum + wv[w] >= 256u) { found = 1; tb = lane8 + w; kr = 256 - (int)cum; tc = (int)wv[w]; } else cum += wv[w]; }
            }
            META[q] = tb; META[32 + q] = kr; META[64 + q] = tc;
        }
    }
    LDS_WAIT(); __builtin_amdgcn_s_barrier(); asm volatile("" ::: "memory");
    if (dry == 1) return;
    {
        const int tb = META[r32];
        const float fl = (tb <= 0) ? -__builtin_inff() : (float)tb, fh = (tb >= IX_NB - 1) ? __builtin_inff() : (float)(tb + 1);
        bf16x8 qf[8][4]; IX_LOADQ(qf);
        bf16x8 qc[4]; ix_combine(qc, qf, a);
        bf16x8 kf[4], kn[4];
        if (wave < nkt) ix_loadk(kf, KIb, wave, r32, hi);
#pragma unroll 1
        for (int kt = wave; kt < nkt; kt += 8) {
            if (kt + 8 < nkt) ix_loadk(kn, KIb, kt + 8, r32, hi);
            f32x16 sc;
            ix_scores(sc, kf, qf, qc, a);
            unsigned sb = 0u, cb = 0u;
#pragma unroll
            for (int r = 15; r >= 1; r -= 2) {
                const float f1 = __builtin_fmaf(sc[r], scale, Rs), f0 = __builtin_fmaf(sc[r - 1], scale, Rs);
                unsigned long long t0, t1, t2, t3;
                asm("v_cmp_ge_f32_e64 %2, %6, %8\n\tv_cmp_ge_f32_e64 %3, %7, %8\n\tv_cmp_ge_f32_e64 %4, %6, %9\n\tv_cmp_ge_f32_e64 %5, %7, %9\n\t"
                    "v_addc_co_u32_e64 %0, vcc, %0, %0, %2\n\tv_addc_co_u32_e64 %0, vcc, %0, %0, %3\n\tv_addc_co_u32_e64 %1, vcc, %1, %1, %4\n\tv_addc_co_u32_e64 %1, vcc, %1, %1, %5"
                    : "+v"(sb), "+v"(cb), "=&s"(t0), "=&s"(t1), "=&s"(t2), "=&s"(t3) : "v"(f1), "v"(f0), "v"(fh), "v"(fl) : "vcc");
            }
            const unsigned cbits = cb & ~sb;
            if (__ballot(cbits != 0u)) {
                int base = 0;
                if (cbits) base = __hip_atomic_fetch_add(META + 96 + r32, __popc(cbits), __ATOMIC_RELAXED, __HIP_MEMORY_SCOPE_WORKGROUP);
#pragma unroll
                for (int r = 0; r < 16; ++r) {
                    const bool c = (cbits >> r) & 1u;
                    if (__ballot(c)) {
                        if (c) { if (base < IX_CAP) { CK[r32 * IX_CAP + base] = sc[r]; CI[r32 * IX_CAP + base] = (unsigned short)(kt * 32 + (r & 3) + 8 * (r >> 2) + 4 * hi); } ++base; }
                    }
                }
            }
            unsigned bits = (sb & 0xFu) | ((sb & 0xF0u) << 4) | ((sb & 0xF00u) << 8) | ((sb & 0xF000u) << 12);
            bits <<= 4 * hi;
            bits |= __shfl_xor(bits, 32);
            if (hi == 0) BM[r32 * IX_BSTR + kt] = bits;
#pragma unroll
            for (int s = 0; s < 4; ++s) kf[s] = kn[s];
        }
    }
    LDS_WAIT(); __builtin_amdgcn_s_barrier(); asm volatile("" ::: "memory");
    if (dry == 2) return;
    {
        const int q0 = wave * 4;
        unsigned key[4][5]; int kr[4], cq[4]; unsigned prefix[4];
        int maxc = 0; unsigned dmax = 0u;
#pragma unroll
        for (int i = 0; i < 4; ++i) {
            int c = META[96 + q0 + i]; c = c > IX_CAP ? IX_CAP : c; cq[i] = c; maxc = c > maxc ? c : maxc;
            kr[i] = META[32 + q0 + i];
            unsigned orv = 0u, andv = 0xFFFFFFFFu;
#pragma unroll
            for (int sl = 0; sl < 5; ++sl) {
                const int e = lane + 64 * sl; const bool v = e < c;
                const unsigned u = v ? __float_as_uint(CK[(q0 + i) * IX_CAP + e]) : 0u;
                const unsigned k = (u & 0x80000000u) ? ~u : (u | 0x80000000u);
                key[i][sl] = v ? k : 0u; orv |= key[i][sl]; andv &= v ? k : 0xFFFFFFFFu;
            }
#pragma unroll
            for (int o = 1; o < 64; o <<= 1) { orv |= (unsigned)__shfl_xor((int)orv, o); andv &= (unsigned)__shfl_xor((int)andv, o); }
            const unsigned diff = orv ^ andv;
            const unsigned low = diff ? (0xFFFFFFFFu >> __builtin_clz(diff)) : 0u;
            prefix[i] = (c > 0) ? (andv & ~low) : 0u; dmax |= diff;
        }
        maxc = __builtin_amdgcn_readfirstlane(maxc); dmax = __builtin_amdgcn_readfirstlane(dmax);
        const int nsl = (maxc + 63) >> 6;
#pragma unroll 1
        for (int bit = dmax ? 31 - __builtin_clz(dmax) : -1; bit >= 0; --bit) {
            int cnt[4] = {0, 0, 0, 0};
#pragma unroll
            for (int sl = 0; sl < 5; ++sl) if (sl < nsl) {
#pragma unroll
                for (int i = 0; i < 4; ++i) cnt[i] += __popcll(__ballot(key[i][sl] >= (prefix[i] | (1u << bit))));
            }
#pragma unroll
            for (int i = 0; i < 4; ++i) prefix[i] = (cnt[i] >= kr[i]) ? (prefix[i] | (1u << bit)) : prefix[i];
        }
#pragma unroll
        for (int i = 0; i < 4; ++i) {
            const int q = q0 + i;
            int cgt = 0, ceq = 0;
#pragma unroll
            for (int sl = 0; sl < 5; ++sl) if (sl < nsl) { const bool v = lane + 64 * sl < cq[i];
                cgt += __popcll(__ballot(v && key[i][sl] > prefix[i])); ceq += __popcll(__ballot(v && key[i][sl] == prefix[i])); }
            const int need = kr[i] - cgt;
            int idx[5];
#pragma unroll
            for (int sl = 0; sl < 5; ++sl) { const int e = lane + 64 * sl; idx[sl] = (e < cq[i]) ? (int)CI[q * IX_CAP + e] : 0x7fffffff; }
            int ithr = 0x7fffffff;
            if (need < ceq) {
                int pre = 0;
#pragma unroll 1
                for (int bit = 12; bit >= 0; --bit) {
                    const int trial = pre | (1 << bit); int cnt = 0;
#pragma unroll
                    for (int sl = 0; sl < 5; ++sl) cnt += __popcll(__ballot(lane + 64 * sl < cq[i] && key[i][sl] == prefix[i] && idx[sl] < trial));
                    if (cnt < need) pre = trial;
                }
                ithr = pre;
            }
#pragma unroll
            for (int sl = 0; sl < 5; ++sl)
                if (lane + 64 * sl < cq[i] && (key[i][sl] > prefix[i] || (key[i][sl] == prefix[i] && idx[sl] <= ithr)))
                    __hip_atomic_fetch_or(BM + q * IX_BSTR + (idx[sl] >> 5), 1u << (idx[sl] & 31), __ATOMIC_RELAXED, __HIP_MEMORY_SCOPE_WORKGROUP);
        }
    }
    LDS_WAIT(); __builtin_amdgcn_s_barrier(); asm volatile("" ::: "memory");
#undef IX_LOADQ
    if (dry) return;
    for (int t = wave; t <= chunk; t += 8) MASK32[((size_t)(b * 128 + t) * SEQ + qt * 32 + r32) * 2 + hi] = BM[r32 * IX_BSTR + 2 * t + hi];
    LDS_WAIT(); __builtin_amdgcn_s_barrier(); asm volatile("" ::: "memory");
}
__device__ __forceinline__ void idx_phase(LAS unsigned char* lds, const int wave, unsigned char* ws) {
    for (int v = blockIdx.x; v < 256; v += gridDim.x) {
        const int b = v >> 7, j = v & 127;
#if defined(PROBE_IDX_DRY)
#pragma unroll 1
        for (int u = 0; u < 6; ++u) idx_unit(lds, wave, ws, b, (u & 1) ? 255 - j : j, u < 2 ? 0 : PROBE_IDX_DRY);
#else
#pragma unroll 1
        for (int u = 0; u < 2; ++u) idx_unit(lds, wave, ws, b, u ? 255 - j : j, 0);
#endif
    }
}
struct Args { const float* in[22]; float* out; unsigned char* ws; int ph_lo, ph_hi, coop, pad; };
enum Phase { P_PRO = 0, P_IN0, P_ATT0, P_OUT0, P_UP0, P_DN0, P_IN1, P_QUP, P_IDX, P_ATT1, P_OUT1, P_UP1, P_DN1, P_N, P_BRIDGE = 20 };

constexpr int CTL_ROWCNT = 4096;
struct In1Order : pg8::StaticOrder {
    unsigned* cnt; int wave;
    __device__ __forceinline__ bool next(int i, pg8::Unit& u) const { if (!pg8::StaticOrder::next(i, u)) return false; u.pn = (u.pn == 1) ? 9 : (u.pn == 9) ? 1 : u.pn; return true; }
    __device__ __forceinline__ void a_ready(const pg8::Unit&) const {}
    __device__ __forceinline__ void done(const pg8::Unit& u) const {
        if (u.pn == 0 || u.pn == 9) {
            asm volatile("s_waitcnt vmcnt(0)" ::: "memory");
            __builtin_amdgcn_s_barrier();
            if (wave == 0) {
                __builtin_amdgcn_fence(__ATOMIC_RELEASE, "agent");
                asm volatile("s_waitcnt vmcnt(0)" ::: "memory");
                if (fresh_lane() == 0) (void)xb_add(&cnt[u.pm * 16], 8u);
            }
        }
    }
};
__device__ __forceinline__ void qup_wait_rows(const pg8::StaticOrder& S, unsigned* cnt, unsigned* tmo, const unsigned need = 16u) {
#pragma unroll 1
    for (int i = 0; ; ++i) {
        pg8::Unit u; if (!S.next(i, u)) break;
        unsigned sp = 0;
        while (xb_ld(&cnt[u.pm * 16]) < need) { __builtin_amdgcn_s_sleep(1); if ((++sp & 255u) == 0u) { if (xb_ld(tmo)) break; if (sp > XB_SPIN_CAP) { atomicAdd(tmo, 1u); break; } } }
    }
    __builtin_amdgcn_fence(__ATOMIC_ACQUIRE, "agent");
}
template <class Epi> __device__ __forceinline__ void run_gemm(LAS unsigned char* lds, const int wave, const bf16_t* A, const bf16_t* Bt, int N, int K, const Epi& E) {
    pg8::Gemm g{A, Bt, TOK, N, K}; pg8::StaticOrder S; S.init(TOK, N, (int)gridDim.x, (int)blockIdx.x);
    pg8::gemm_phase<Epi, pg8::StaticOrder, true, true>(lds, g, S, E, wave, fresh_lane());
}
__global__ void __launch_bounds__(NWAVES * 64, 2) mk_fwd(Args args) {
    extern __shared__ __attribute__((aligned(16))) unsigned char lds_raw[];
    LAS unsigned char* lds = (LAS unsigned char*)lds_raw;
    const int wave = __builtin_amdgcn_readfirstlane(threadIdx.x >> 6);
    const int G = gridDim.x;
    unsigned char* ws = args.ws;
    const int lo = args.ph_lo, hi = args.ph_hi;
    volatile LAS unsigned* MISC = (volatile LAS unsigned*)(lds + MISC_OFF);
    { const int tid = wave * 64 + fresh_lane(); for (int u = tid; u < (LDS_BYTES - RING_BYTES) / 4; u += NWAVES * 64) ((LAS unsigned*)(lds + RING_BYTES))[u] = 0u; }
    __syncthreads();
    XcdBarrier bar; bar.bar = (unsigned*)(ws + WS_CTL); bar.x = 0; bar.st = nullptr;
    if (args.coop) bar = xcd_barrier_post((unsigned*)(ws + WS_CTL), MISC + 8);
#define IN(k) (lo <= (k) && (k) < hi)
#define NREP(k) ((PROBE_PHASE == (k)) ? 3 : 1)
#define SEAM(k) do { if (args.coop && IN(k) && IN((k) + 1)) xcd_barrier(bar, wave); } while (0)
    LAS float* ETBL = (LAS float*)(lds + EPI_TBL_OFF + wave * 512);
    bf16_t* XB = (bf16_t*)(ws + WS_XB); bf16_t* QB = (bf16_t*)(ws + WS_Q); bf16_t* KB = (bf16_t*)(ws + WS_K); bf16_t* VB = (bf16_t*)(ws + WS_V); bf16_t* UB = (bf16_t*)(ws + WS_U);
    float* PART = (float*)(ws + WS_PART); float* CS = (float*)(ws + WS_CS); float* LAM = (float*)(ws + WS_MISC);

    if (IN(P_PRO)) for (int rep_ = 0; rep_ < NREP(P_PRO); ++rep_) {
        const int lane = fresh_lane(), tid = wave * 64 + lane;
        LAS float* scr = (LAS float*)(lds + wave * 16384);
        const int gw = blockIdx.x * NWAVES + wave, NGW = G * NWAVES;
        const float* nmix = args.in[2]; const float* nmlp = args.in[3];
        int base = 0;
#define DOJOB(W_, gain_, WT_, K_, N_, Npad_, roff_) do { const int nblk = (Npad_) / 32, nitems = ((K_) / 64) * nblk; \
            for (int it = (gw - base % NGW + NGW) % NGW; it < nitems; it += NGW) p0_transpose_item((W_), (K_), (N_), (gain_), (bf16_t*)(ws + (WT_)), (roff_), scr, it, nblk, lane); \
            base += nitems; } while (0)
        DOJOB(args.in[6], nmix, WS_WIN0, DM, 3072, 3072, 0);
        DOJOB(args.in[14], (const float*)nullptr, WS_WOUT0, DM, DM, DM, 0);
        DOJOB(args.in[4], nmlp, WS_W1_0, DM, DFF, DFF, 0);
        DOJOB(args.in[5], (const float*)nullptr, WS_W2_0, DFF, DM, DM, 0);
        DOJOB(args.in[15], nmix + DM, WS_WIN1, DM, NIN1, NIN1P, 0);
        DOJOB(args.in[17], args.in[16], WS_WUQ, 256, DM, DM, 0);
        DOJOB(args.in[18], args.in[16], WS_WUQ, 256, 512, 512, 1024);
        DOJOB(args.in[21], (const float*)nullptr, WS_WOUT1, DM, DM, DM, 0);
        DOJOB(args.in[4] + (size_t)DM * DFF, nmlp + DM, WS_W1_1, DM, DFF, DFF, 0);
        DOJOB(args.in[5] + (size_t)DM * DFF, (const float*)nullptr, WS_W2_1, DFF, DM, DM, 0);
#undef DOJOB
        if (TOK % (4 * NGW) == 0) { for (int m = gw; m < TOK; m += 4 * NGW) rows_to_bf16<4>(args.in[0], XB, PART, m, NGW, lane); }
        else { for (int m = gw; m < TOK; m += NGW) rows_to_bf16<1>(args.in[0], XB, PART, m, NGW, lane); }
        const int* pos = (const int*)args.in[1];
        for (int t = blockIdx.x * (NWAVES * 64) + tid; t < TOK * 8; t += G * NWAVES * 64) {
            const int tok = t >> 3, i = t & 7;
            const float inv = (float)pow(500000.0, -(double)i / 8.0);
            const float ang = (float)pos[tok] * inv;
            CS[tok * 16 + i] = (float)cos((double)ang); CS[tok * 16 + 8 + i] = (float)sin((double)ang);
        }
        if (blockIdx.x == 0 && tid == 0) {
            float s1 = 0.f, s2 = 0.f;
            for (int i = 0; i < 64; ++i) { s1 += args.in[9][i] * args.in[10][i]; s2 += args.in[11][i] * args.in[12][i]; }
            LAM[0] = expf(s1) - expf(s2) + 0.2f;
        }
    }
    SEAM(P_PRO);
    if (IN(P_BRIDGE)) {
        const int lane = fresh_lane();
        const int gw = blockIdx.x * NWAVES + wave, NGW = G * NWAVES;
        for (int m = gw; m < TOK; m += NGW) rows_to_bf16<1>(args.out, XB, PART, m, NGW, lane);
    }
    if (IN(P_IN0)) { for (int rep_ = 0; rep_ < NREP(P_IN0); ++rep_) { EpiQKV0 E{PART, CS, args.in[7], args.in[8], QB, (size_t)(WS_K - WS_Q) / 2, 0.125f * LOG2E, ETBL}; run_gemm(lds, wave, XB, (const bf16_t*)(ws + WS_WIN0), 3072, DM, E); } }
    SEAM(P_IN0);
    if (IN(P_ATT0)) { for (int rep_ = NREP(P_ATT0) - 1; rep_ >= 0; --rep_) attn0_phase(lds, wave, ws, args.in[13], rep_ != 0); }
    SEAM(P_ATT0);
    if (IN(P_OUT0)) { for (int rep_ = 0; rep_ < NREP(P_OUT0); ++rep_) { EpiResidT<true, false> E{nullptr, XB, nullptr, XB, PART}; run_gemm(lds, wave, QB, (const bf16_t*)(ws + WS_WOUT0), DM, DM, E); } }
    SEAM(P_OUT0);
    if (IN(P_UP0)) { for (int rep_ = 0; rep_ < NREP(P_UP0); ++rep_) { EpiUp E{PART, UB, ETBL}; run_gemm(lds, wave, XB, (const bf16_t*)(ws + WS_W1_0), DFF, DM, E); } }
    SEAM(P_UP0);
    if (IN(P_DN0)) { EpiResidT<true, false> E{nullptr, XB, nullptr, XB, PART}; run_gemm(lds, wave, UB, (const bf16_t*)(ws + WS_W2_0), DM, DFF, E); }
    SEAM(P_DN0);
    if (IN(P_IN1)) { for (int rep_ = 0; rep_ < NREP(P_IN1); ++rep_) { EpiIn1 E{PART, CS, args.in[20], (bf16_t*)(ws + WS_CQ), (float*)(ws + WS_CQP), KB, VB, (bf16_t*)(ws + WS_KI), (float*)(ws + WS_WIDX), 0.35355339059327373f * 0.125f, ETBL};
        pg8::Gemm g{XB, (const bf16_t*)(ws + WS_WIN1), TOK, NIN1P, DM}; In1Order S; S.init(TOK, NIN1P, G, (int)blockIdx.x); S.cnt = (unsigned*)(ws + WS_CTL) + CTL_ROWCNT; S.wave = wave;
        pg8::gemm_phase<EpiIn1, In1Order, true, true>(lds, g, S, E, wave, fresh_lane()); } }
    if (IN(P_QUP)) { for (int rep_ = 0; rep_ < NREP(P_QUP); ++rep_) { EpiQup E{(const float*)(ws + WS_CQP), CS, args.in[19], (const float*)(ws + WS_WIDX), QB, (bf16_t*)(ws + WS_QI), (float*)(ws + WS_QIN), 0.125f * LOG2E, ETBL};
        const int c = (int)blockIdx.x, cm = (G % 8 == 0) ? ((c & 7) | ((G / 8 - 1 - (c >> 3)) << 3)) : c;
        pg8::Gemm g{(const bf16_t*)(ws + WS_CQ), (const bf16_t*)(ws + WS_WUQ), TOK, 1536, 256}; pg8::StaticOrder S; S.init(TOK, 1536, G, cm);
        qup_wait_rows(S, (unsigned*)(ws + WS_CTL) + CTL_ROWCNT, (unsigned*)(ws + WS_CTL) + XB_TMO);
        pg8::gemm_phase<EpiQup, pg8::StaticOrder, true, true>(lds, g, S, E, wave, fresh_lane()); } }
    SEAM(P_QUP);
    if (IN(P_IDX)) { for (int rep_ = 0; rep_ < NREP(P_IDX); ++rep_) { idx_phase(lds, wave, ws); } }
    SEAM(P_IDX);
    if (IN(P_ATT1)) { for (int rep_ = NREP(P_ATT1) - 1; rep_ >= 0; --rep_) attn1_phase(lds, wave, ws, rep_ != 0); }
    SEAM(P_ATT1);
    if (IN(P_OUT1)) { EpiResidT<true, false> E{nullptr, XB, nullptr, XB, PART}; run_gemm(lds, wave, QB, (const bf16_t*)(ws + WS_WOUT1), DM, DM, E); }
    SEAM(P_OUT1);
    if (IN(P_UP1)) { for (int rep_ = 0; rep_ < NREP(P_UP1); ++rep_) { EpiUp E{PART, UB, ETBL}; run_gemm(lds, wave, XB, (const bf16_t*)(ws + WS_W1_1), DFF, DM, E); } }
    SEAM(P_UP1);
    if (IN(P_DN1)) { EpiResidT<true, true> E{nullptr, XB, args.out, nullptr, nullptr}; run_gemm(lds, wave, UB, (const bf16_t*)(ws + WS_W2_1), DM, DFF, E); }
#undef IN
#undef SEAM
}

static int g_mk_ready = 0;
static void mk_launch(hipStream_t st, void* const* d_in, void* d_out, void* d_ws, int lo, int hi, int coop) {
    if (!g_mk_ready) { (void)hipFuncSetAttribute((const void*)mk_fwd, hipFuncAttributeMaxDynamicSharedMemorySize, LDS_BYTES); g_mk_ready = 1; }
    Args a{};
    for (int i = 0; i < 22; ++i) a.in[i] = (const float*)d_in[i];
    a.out = (float*)d_out; a.ws = (unsigned char*)d_ws; a.ph_lo = lo; a.ph_hi = hi; a.coop = coop; a.pad = 0;
    hipLaunchKernelGGL(mk_fwd, dim3(256), dim3(NWAVES * 64), LDS_BYTES, st, a);
}

extern "C" void kernel_launch(void* const* d_in, const int* in_sizes, int n_in, void* d_out, int out_size, void* d_ws, size_t ws_size, hipStream_t stream) {
    static int grid = 0;
    if (grid == 0) {
        int dev = 0, cus = 0, per_cu = 0;
        (void)hipGetDevice(&dev);
        (void)hipDeviceGetAttribute(&cus, hipDeviceAttributeMultiprocessorCount, dev);
        (void)hipFuncSetAttribute((const void*)mk_fwd, hipFuncAttributeMaxDynamicSharedMemorySize, LDS_BYTES);
        (void)hipOccupancyMaxActiveBlocksPerMultiprocessor(&per_cu, (const void*)mk_fwd, NWAVES * 64, LDS_BYTES);
        if (per_cu < 1) per_cu = 1;
        if (per_cu > 1) per_cu = 1;
        grid = cus * per_cu; if (grid > 256) grid = 256; if (grid < 1) grid = 1;
        if (ws_size < WS_END) { fprintf(stderr, "kernel_launch: workspace too small (%zu)\n", ws_size); }
    }
    (void)hipMemsetAsync((char*)d_ws + WS_CTL, 0, CTL_BYTES, stream);
    Args a{};
    for (int i = 0; i < 22; ++i) a.in[i] = (const float*)d_in[i];
    a.out = (float*)d_out; a.ws = (unsigned char*)d_ws; a.ph_lo = 0; a.ph_hi = P_N; a.coop = 1; a.pad = 0;
    void* kargs[] = {&a};
    hipError_t e = hipLaunchCooperativeKernel((const void*)mk_fwd, dim3(grid), dim3(NWAVES * 64), kargs, LDS_BYTES, stream);
    if (e != hipSuccess) fprintf(stderr, "cooperative launch failed: %s (grid %d)\n", hipGetErrorString(e), grid);
}
```

```cpp
#include <hip/hip_runtime.h>
#include <stdint.h>
#include <math.h>
#include <stdio.h>
#ifndef PROBE_PHASE
#define PROBE_PHASE (-1)
#endif
#define LAS __attribute__((address_space(3)))
#define GAS __attribute__((address_space(1)))
typedef unsigned short bf16_t;
typedef short bf16x8 __attribute__((ext_vector_type(8)));
typedef float f32x4 __attribute__((ext_vector_type(4)));
typedef float f32x16 __attribute__((ext_vector_type(16)));
typedef unsigned u32x4 __attribute__((ext_vector_type(4)));
typedef unsigned u32x2 __attribute__((ext_vector_type(2)));

constexpr int BATCH = 2, SEQ = 8192, DM = 1024, DFF = 4096, TOK = BATCH * SEQ;
constexpr float EPS = 1e-6f;
constexpr float LOG2E = 1.4426950408889634f;
constexpr int NIN1 = 2376, NIN1P = 2560;
constexpr size_t MiB = 1u << 20;
constexpr size_t WS_XB = 0, WS_Q = 32 * MiB, WS_K = 64 * MiB, WS_V = 96 * MiB, WS_U = 32 * MiB;
constexpr size_t WS_CQ = 160 * MiB, WS_QI = 168 * MiB, WS_KI = 184 * MiB, WS_MASK = 186 * MiB;
constexpr size_t WS_CS = 204 * MiB, WS_MISC = 205 * MiB, WS_PART = 206 * MiB, WS_CQP = 207 * MiB, WS_WIDX = 207 * MiB + 256 * 1024;
constexpr size_t WS_QIN = WS_MISC + 512 * 1024;
constexpr size_t WS_CTL = WS_MISC + 4096;
constexpr size_t CTL_BYTES = 64 * 1024;
constexpr size_t WS_WIN0 = 208 * MiB, WS_WOUT0 = 214 * MiB, WS_W1_0 = 216 * MiB, WS_W2_0 = 224 * MiB, WS_WIN1 = 232 * MiB, WS_WUQ = 237 * MiB,
                 WS_WOUT1 = 238 * MiB, WS_W1_1 = 240 * MiB, WS_W2_1 = 248 * MiB, WS_END = 256 * MiB;

__device__ __forceinline__ unsigned cvt_pk_bf16(float lo, float hi) {
    typedef float f32x2_t __attribute__((ext_vector_type(2))); typedef __bf16 bf16x2_t __attribute__((ext_vector_type(2)));
    f32x2_t v = {lo, hi}; bf16x2_t b = __builtin_convertvector(v, bf16x2_t); return __builtin_bit_cast(unsigned, b);
}
__host__ __device__ __forceinline__ int tile_pos(int cl) { const int wc = cl >> 6, fq = (cl >> 4) & 3, bj = (cl >> 3) & 1, n = (cl >> 2) & 1, j = cl & 3; return 128 * bj + 32 * wc + 16 * n + 4 * fq + j; }
__device__ __forceinline__ int fresh_lane() { int l; asm volatile("v_mbcnt_lo_u32_b32 %0, -1, 0\n\tv_mbcnt_hi_u32_b32 %0, -1, %0" : "=v"(l)); return l; }
__device__ __forceinline__ float wave_sum(float v) {
#pragma unroll
    for (int o = 1; o < 64; o <<= 1) v += __shfl_xor(v, o);
    return v;
}
namespace pg8 {
#define PG8_LAS __attribute__((address_space(3)))
typedef unsigned short bf16_t;
typedef short bf16x8 __attribute__((ext_vector_type(8)));
typedef float f32x4 __attribute__((ext_vector_type(4)));
typedef unsigned u32x4 __attribute__((ext_vector_type(4)));
constexpr int BM = 256, BK = 64, HALF = 128, HTB = HALF * BK * 2  , STAGE_BYTES = 8 * HTB, NXCD = 8, WGM = 8;

__host__ __device__ __forceinline__ int lds_byte(int r, int c) { const int st = (r >> 4) * 2 + (c >> 5), rr = r & 15, cc = c & 31, ob = rr * 64 + cc * 2; return st * 1024 + (ob ^ (((ob >> 9) & 1) << 5)); }
__host__ __device__ __forceinline__ void stage_rc(int b, int& R, int& C) { const int st = b / 1024, sb = b % 1024, swz = sb ^ (((sb >> 9) & 1) << 5); R = (st >> 1) * 16 + swz / 64; C = (st & 1) * 32 + (swz % 64) / 2; }
__host__ __device__ __forceinline__ int perm32(int rho) { const int n = rho >> 4, i = rho & 15; return 8 * (i >> 2) + 4 * n + (i & 3); }

struct Unit { int pm, pn; };
struct Gemm { const bf16_t* A; const bf16_t* Bt; int M, N, K; };

struct StaticOrder {
    int nM, nN, nwg, G, c;
    __host__ __device__ void init(int M, int N, int G_, int c_) { nM = M / BM; nN = N / BM; nwg = nM * nN; G = G_; c = c_; }
    __host__ __device__ bool next(int i, Unit& u) const {
        const long L = (long)i * G + c; if (L >= nwg) return false;
        int wgid = (int)L; { const int q = nwg / NXCD, r = nwg % NXCD, xcd = wgid % NXCD, off = wgid / NXCD; wgid = (xcd < r ? xcd * (q + 1) : r * (q + 1) + (xcd - r) * q) + off; }
        const int nig = WGM * nN, gid = wgid / nig, fm = gid * WGM, gsz = (nM - fm) < WGM ? (nM - fm) : WGM;
        u.pm = fm + ((wgid % nig) % gsz); u.pn = (wgid % nig) / gsz; return true;
    }
    __device__ __forceinline__ void a_ready(const Unit&) const {}
    __device__ __forceinline__ void done(const Unit&) const {}
};

__device__ __forceinline__ unsigned cvt_pk_bf16(float lo, float hi) { unsigned r; asm volatile("v_cvt_pk_bf16_f32 %0, %1, %2" : "=v"(r) : "v"(lo), "v"(hi)); return r; }
typedef float f32x2 __attribute__((ext_vector_type(2)));
template <class Epi, class Sched, bool ALIGN_EPI = false, bool SP2 = false>
__device__ __forceinline__ void gemm_phase(PG8_LAS unsigned char* lds, const Gemm g, const Sched& S, const Epi& E, const int wid, const int lane) {
    const int tid = wid * 64 + lane, wr = wid >> 2, wc = wid & 3, fr = lane & 15, fq = lane >> 4;
    const int K = g.K, nt = K / BK;
    unsigned voffA[2], voffB[2];
#pragma unroll
    for (int i = 0; i < 2; ++i) { int R, C; stage_rc(tid * 16 + i * 8192, R, C); const int Rb = Epi::PERM ? ((R & ~31) + perm32(R & 31)) : R;
        voffA[i] = (unsigned)(R * K + C) * 2u; voffB[i] = (unsigned)(Rb * K + C) * 2u; }
    const size_t kstep = (size_t)(BK * 2);
    const size_t hstep = (size_t)HALF * K * 2;
    const size_t tstep = 2 * hstep;
    const unsigned ldsw = (unsigned)wid * 1024u;
    const int aoff = lds_byte(wr * 64 + fr, fq * 8), boff = lds_byte(wc * 32 + fr, fq * 8);
#define PG8_SA(b, h) (((b) * 2 + (h)) * HTB)
#define PG8_SB(b, h) ((4 + (b) * 2 + (h)) * HTB)
#define PG8_STAGE(bufoff, gbase, voff) do { _Pragma("unroll") for (int _i = 0; _i < 2; ++_i) \
        __builtin_amdgcn_global_load_lds((const unsigned*)((const char*)(gbase) + (voff)[_i]), (PG8_LAS unsigned*)(lds + (bufoff) + ldsw + _i * 8192), 16, 0, 0); } while (0)
#define PG8_LDA(dst, b, h) do { _Pragma("unroll") for (int m = 0; m < 4; ++m) _Pragma("unroll") for (int k = 0; k < 2; ++k) dst[m][k] = *(const PG8_LAS bf16x8*)(lds + PG8_SA(b, h) + aoff + m * 2048 + k * 1024); } while (0)
#define PG8_LDB(dst, b, h) do { _Pragma("unroll") for (int n = 0; n < 2; ++n) _Pragma("unroll") for (int k = 0; k < 2; ++k) dst[n][k] = *(const PG8_LAS bf16x8*)(lds + PG8_SB(b, h) + boff + n * 2048 + k * 1024); } while (0)
#define PG8_MMA(ai, bj, At, Bt) do { __builtin_amdgcn_s_setprio(1); _Pragma("unroll") for (int k = 0; k < 2; ++k) _Pragma("unroll") for (int m = 0; m < 4; ++m) _Pragma("unroll") for (int n = 0; n < 2; ++n)   \
        acc[ai][bj][m][n] = __builtin_amdgcn_mfma_f32_16x16x32_bf16(Bt[n][k], At[m][k], acc[ai][bj][m][n], 0, 0, 0); __builtin_amdgcn_s_setprio(0); } while (0)
#define PG8_WAIT_V(n) asm volatile("s_waitcnt vmcnt(" #n ")" ::: "memory")
#define PG8_WAIT_L(n) asm volatile("s_waitcnt lgkmcnt(" #n ")" ::: "memory")
#define PG8_BAR __builtin_amdgcn_s_barrier()
#define PG8_SCHED __builtin_amdgcn_sched_barrier(0)
    Unit cur, nxt; int ui = 0;
    if (!S.next(0, cur)) return;
    f32x4 acc[2][2][4][2];
#pragma unroll
    for (int a = 0; a < 2; ++a)
#pragma unroll
        for (int b = 0; b < 2; ++b)
#pragma unroll
            for (int m = 0; m < 4; ++m)
#pragma unroll
                for (int n = 0; n < 2; ++n) acc[a][b][m][n] = (f32x4){0.f, 0.f, 0.f, 0.f};
    bf16x8 At[4][2], B0[2][2], B1[2][2];
    const char* cA = (const char*)g.A + (size_t)cur.pm * tstep; const char* cB = (const char*)g.Bt + (size_t)cur.pn * tstep;
    S.a_ready(cur);
    if constexpr (SP2) {
        PG8_STAGE(PG8_SB(0, 0), cB, voffB); PG8_STAGE(PG8_SB(0, 1), cB + hstep, voffB); PG8_STAGE(PG8_SA(0, 0), cA, voffA); PG8_STAGE(PG8_SA(0, 1), cA + hstep, voffA);
        if (wr == 1) PG8_BAR;
        PG8_WAIT_V(2); PG8_BAR;
        PG8_STAGE(PG8_SB(1, 0), cB + kstep, voffB); PG8_STAGE(PG8_SA(1, 0), cA + kstep, voffA); PG8_STAGE(PG8_SB(1, 1), cB + hstep + kstep, voffB);
        PG8_WAIT_V(6); PG8_BAR;
    } else {
        PG8_STAGE(PG8_SB(0, 0), cB, voffB); PG8_STAGE(PG8_SA(0, 0), cA, voffA); PG8_STAGE(PG8_SB(0, 1), cB + hstep, voffB); PG8_STAGE(PG8_SA(0, 1), cA + hstep, voffA);
        if (wr == 1) PG8_BAR;
        PG8_WAIT_V(4); PG8_BAR;
        PG8_STAGE(PG8_SB(1, 0), cB + kstep, voffB); PG8_STAGE(PG8_SA(1, 0), cA + kstep, voffA); PG8_STAGE(PG8_SB(1, 1), cB + hstep + kstep, voffB);
        PG8_WAIT_V(6); PG8_BAR;
    }
    for (;;) {
        const bool has_next = S.next(ui + 1, nxt);
        const char* nA = has_next ? (const char*)g.A + (size_t)nxt.pm * tstep : cA; const char* nB = has_next ? (const char*)g.Bt + (size_t)nxt.pn * tstep : cB;
        for (int t = 0; t < nt; t += 2) {
            const bool last = (t == nt - 2);
            const char* a1 = cA + (size_t)(t + 1) * kstep;
            const char* a2 = last ? nA : cA + (size_t)(t + 2) * kstep; const char* b2 = last ? nB : cB + (size_t)(t + 2) * kstep;
            const char* a3 = a2 + kstep; const char* b3 = b2 + kstep;
            if (last && has_next) S.a_ready(nxt);
            if constexpr (SP2) {
            PG8_LDB(B0, 0, 0); PG8_LDB(B1, 0, 1); PG8_SCHED; PG8_LDA(At, 0, 0); PG8_STAGE(PG8_SA(1, 1), a1 + hstep, voffA);
            PG8_WAIT_V(8); PG8_WAIT_L(0); PG8_BAR; PG8_MMA(0, 0, At, B0); PG8_MMA(0, 1, At, B1); PG8_BAR; PG8_SCHED;
            PG8_LDA(At, 0, 1); PG8_STAGE(PG8_SB(0, 0), b2, voffB); PG8_STAGE(PG8_SB(0, 1), b2 + hstep, voffB); PG8_STAGE(PG8_SA(0, 0), a2, voffA);
            PG8_WAIT_V(8); PG8_WAIT_L(0); PG8_BAR; PG8_MMA(1, 0, At, B0); PG8_MMA(1, 1, At, B1); PG8_BAR; PG8_SCHED;
            PG8_LDB(B0, 1, 0); PG8_LDB(B1, 1, 1); PG8_SCHED; PG8_LDA(At, 1, 0); PG8_STAGE(PG8_SA(0, 1), a2 + hstep, voffA);
            PG8_WAIT_V(8); PG8_WAIT_L(0); PG8_BAR; PG8_MMA(0, 0, At, B0); PG8_MMA(0, 1, At, B1); PG8_BAR; PG8_SCHED;
            PG8_LDA(At, 1, 1); PG8_STAGE(PG8_SB(1, 0), b3, voffB); PG8_STAGE(PG8_SB(1, 1), b3 + hstep, voffB); PG8_STAGE(PG8_SA(1, 0), a3, voffA);
            PG8_WAIT_V(8); PG8_WAIT_L(0); PG8_BAR; PG8_MMA(1, 0, At, B0); PG8_MMA(1, 1, At, B1); PG8_BAR; PG8_SCHED;
            } else {
            PG8_LDB(B0, 0, 0); PG8_SCHED; PG8_LDA(At, 0, 0); PG8_STAGE(PG8_SA(1, 1), a1 + hstep, voffA);
            PG8_WAIT_L(8); PG8_BAR; PG8_WAIT_L(0); PG8_MMA(0, 0, At, B0); PG8_BAR; PG8_SCHED;
            PG8_LDB(B1, 0, 1); PG8_STAGE(PG8_SB(0, 0), b2, voffB);
            PG8_BAR; PG8_WAIT_L(0); PG8_MMA(0, 1, At, B1); PG8_BAR;
            PG8_LDA(At, 0, 1); PG8_STAGE(PG8_SA(0, 0), a2, voffA);
            PG8_BAR; PG8_WAIT_L(0); PG8_MMA(1, 0, At, B0); PG8_BAR; PG8_SCHED;
            PG8_STAGE(PG8_SB(0, 1), b2 + hstep, voffB);
            PG8_WAIT_V(6); PG8_BAR; PG8_MMA(1, 1, At, B1); PG8_BAR;
            PG8_LDB(B0, 1, 0); PG8_SCHED; PG8_LDA(At, 1, 0); PG8_STAGE(PG8_SA(0, 1), a2 + hstep, voffA);
            PG8_WAIT_L(8); PG8_BAR; PG8_WAIT_L(0); PG8_MMA(0, 0, At, B0); PG8_BAR; PG8_SCHED;
            PG8_LDB(B1, 1, 1); PG8_STAGE(PG8_SB(1, 0), b3, voffB);
            PG8_BAR; PG8_WAIT_L(0); PG8_MMA(0, 1, At, B1); PG8_BAR;
            PG8_LDA(At, 1, 1); PG8_STAGE(PG8_SA(1, 0), a3, voffA);
            PG8_BAR; PG8_WAIT_L(0); PG8_MMA(1, 0, At, B0); PG8_BAR; PG8_SCHED;
            PG8_STAGE(PG8_SB(1, 1), b3 + hstep, voffB);
            PG8_WAIT_V(6); PG8_BAR; PG8_MMA(1, 1, At, B1); PG8_BAR;
            }
        }
        if constexpr (ALIGN_EPI) { if (wr == 0) PG8_BAR; }
        if constexpr (!Epi::AFTER_DRAIN) { const int le = fresh_lane(); E(acc, cur, wr, wc, le & 15, le >> 4); S.done(cur); }
        if (!has_next) break;
#pragma unroll
        for (int a = 0; a < 2; ++a)
#pragma unroll
            for (int b = 0; b < 2; ++b)
#pragma unroll
                for (int m = 0; m < 4; ++m)
#pragma unroll
                    for (int n = 0; n < 2; ++n) acc[a][b][m][n] = (f32x4){0.f, 0.f, 0.f, 0.f};
        cur = nxt; cA = nA; cB = nB; ++ui;
        if constexpr (ALIGN_EPI) { if (wr == 1) PG8_BAR; }
    }
    PG8_WAIT_V(0);
    if constexpr (!ALIGN_EPI) { if (wr == 0) PG8_BAR; }
    PG8_BAR;
    if constexpr (Epi::AFTER_DRAIN) { E.fused(acc, cur, wr, wc, fr, fq, lds, wid, lane); S.done(cur); }
#undef PG8_SA
#undef PG8_SB
#undef PG8_STAGE
#undef PG8_LDA
#undef PG8_LDB
#undef PG8_MMA
#undef PG8_WAIT_V
#undef PG8_WAIT_L
#undef PG8_BAR
#undef PG8_SCHED
}
}
typedef f32x4 acc_t[2][2][4][2];

__device__ __forceinline__ float rstd_from_parts16(const float* __restrict__ part, int row) {
    const f32x4* p = (const f32x4*)(part + (size_t)row * 16);
    const f32x4 a = p[0], b = p[1], c = p[2], d = p[3];
    const float s = ((a[0] + a[1]) + (a[2] + a[3])) + ((b[0] + b[1]) + (b[2] + b[3])) + ((c[0] + c[1]) + (c[2] + c[3])) + ((d[0] + d[1]) + (d[2] + d[3]));
    return 1.0f / sqrtf(s * (1.0f / 1024.0f) + EPS);
}
constexpr int EPI_TBL_OFF = 131072;
__device__ __forceinline__ void fill_rstd16(LAS float* T, const float* __restrict__ part, int pm, int wr, int lane) {
    const float r0 = rstd_from_parts16(part, pm * 256 + wr * 64 + lane), r1 = rstd_from_parts16(part, pm * 256 + 128 + wr * 64 + lane);
    T[lane] = r0; T[64 + lane] = r1;
}
__device__ __forceinline__ float quad_sum(float s) { s += __shfl_xor(s, 16); s += __shfl_xor(s, 32); return s; }
__device__ __forceinline__ float sumsq16(const f32x4 (&v)[2][2]) {
    float s = 0.f;
#pragma unroll
    for (int bj = 0; bj < 2; ++bj)
#pragma unroll
        for (int n = 0; n < 2; ++n) s += (v[bj][n][0] * v[bj][n][0] + v[bj][n][1] * v[bj][n][1]) + (v[bj][n][2] * v[bj][n][2] + v[bj][n][3] * v[bj][n][3]);
    return s;
}
__device__ __forceinline__ void head_norm_rope(f32x4 (&v)[2][2], bool do_norm, bool use_gain, const f32x4 (&g)[2][2], const float* __restrict__ cs_row, int fq, float scale) {
    if (do_norm) {
        const float ss = quad_sum(sumsq16(v));
        const float rn = 1.0f / sqrtf(ss * (1.0f / 64.0f) + EPS);
#pragma unroll
        for (int bj = 0; bj < 2; ++bj)
#pragma unroll
            for (int n = 0; n < 2; ++n) { v[bj][n] = v[bj][n] * rn; if (use_gain) v[bj][n] = v[bj][n] * g[bj][n]; }
    }
    if (fq == 0) {
        const f32x4* c4 = (const f32x4*)cs_row;
#pragma unroll
        for (int n = 0; n < 2; ++n) {
            const f32x4 c = c4[n], s = c4[2 + n];
            const f32x4 x1 = v[0][n], x2 = v[1][n];
            v[0][n] = x1 * c - x2 * s;
            v[1][n] = x2 * c + x1 * s;
        }
    }
    if (scale != 1.0f) {
#pragma unroll
        for (int bj = 0; bj < 2; ++bj)
#pragma unroll
            for (int n = 0; n < 2; ++n) v[bj][n] = v[bj][n] * scale;
    }
}
__device__ __forceinline__ void store_bf16x16(bf16_t* p, const f32x4 (&v)[2][2]) {
#pragma unroll
    for (int bj = 0; bj < 2; ++bj) {
        u32x4 w; w.x = cvt_pk_bf16(v[bj][0][0], v[bj][0][1]); w.y = cvt_pk_bf16(v[bj][0][2], v[bj][0][3]); w.z = cvt_pk_bf16(v[bj][1][0], v[bj][1][1]); w.w = cvt_pk_bf16(v[bj][1][2], v[bj][1][3]);
        *(u32x4*)(p + 8 * bj) = w;
    }
}
__device__ __forceinline__ void load_gain16(f32x4 (&g)[2][2], const float* __restrict__ gp, int fq) {
#pragma unroll
    for (int bj = 0; bj < 2; ++bj)
#pragma unroll
        for (int n = 0; n < 2; ++n) g[bj][n] = *(const f32x4*)(gp + 16 * fq + 8 * bj + 4 * n);
}

struct EpiQKV0 {
    static constexpr bool PERM = false, AFTER_DRAIN = false;
    const float* part; const float* cs; const float* qg; const float* kg; bf16_t* QKV; size_t stride; float qscale; LAS float* T;
    mutable int last_pm = -1;
    __device__ __forceinline__ void operator()(const acc_t& acc, const pg8::Unit& u, int wr, int wc, int fr, int fq) const {
        const int kind = u.pn >> 2, head = (u.pn & 3) * 4 + wc;
        bf16_t* dst = QKV + (size_t)kind * stride + head * 64 + 16 * fq;
        f32x4 g[2][2] = {};
        if (kind < 2) load_gain16(g, kind == 0 ? qg : kg, fq);
        if (u.pm != last_pm) { fill_rstd16(T, part, u.pm, wr, fr + 16 * fq); last_pm = u.pm; }
#pragma unroll
        for (int ai = 0; ai < 2; ++ai)
#pragma unroll
            for (int m = 0; m < 4; ++m) {
                const int row = u.pm * 256 + ai * 128 + wr * 64 + m * 16 + fr;
                const float rs = T[ai * 64 + m * 16 + fr];
                f32x4 v[2][2];
#pragma unroll
                for (int bj = 0; bj < 2; ++bj)
#pragma unroll
                    for (int n = 0; n < 2; ++n) v[bj][n] = acc[ai][bj][m][n] * rs;
                if (kind < 2) head_norm_rope(v, true, true, g, cs + (size_t)row * 16, fq, kind == 0 ? qscale : 1.0f);
                store_bf16x16(dst + (size_t)row * DM, v);
            }
    }
};
template <bool RES_BF16, bool OUT_F32> struct EpiResidT {
    static constexpr bool PERM = false, AFTER_DRAIN = false;
    const float* R; const bf16_t* Rb; float* out; bf16_t* xb; float* part;
    __device__ __forceinline__ void operator()(const acc_t& acc, const pg8::Unit& u, int wr, int wc, int fr, int fq) const {
        const int col0 = u.pn * 256 + wc * 64 + 16 * fq;
#pragma unroll
        for (int ai = 0; ai < 2; ++ai)
#pragma unroll
            for (int m = 0; m < 4; ++m) {
                const int row = u.pm * 256 + ai * 128 + wr * 64 + m * 16 + fr;
                const size_t off = (size_t)row * DM + col0;
                f32x4 v[2][2];
                if (RES_BF16) {
#pragma unroll
                    for (int bj = 0; bj < 2; ++bj) {
                        const u32x4 w = *(const u32x4*)(Rb + off + 8 * bj);
                        const unsigned ww[4] = {w.x, w.y, w.z, w.w};
#pragma unroll
                        for (int n = 0; n < 2; ++n) {
                            f32x4 r; r[0] = __builtin_bit_cast(float, ww[2 * n] << 16); r[1] = __builtin_bit_cast(float, ww[2 * n] & 0xffff0000u);
                            r[2] = __builtin_bit_cast(float, ww[2 * n + 1] << 16); r[3] = __builtin_bit_cast(float, ww[2 * n + 1] & 0xffff0000u);
                            v[bj][n] = r + acc[ai][bj][m][n];
                        }
                    }
                } else {
#pragma unroll
                    for (int bj = 0; bj < 2; ++bj)
#pragma unroll
                        for (int n = 0; n < 2; ++n) v[bj][n] = *(const f32x4*)(R + off + 8 * bj + 4 * n) + acc[ai][bj][m][n];
                }
                if (OUT_F32) {
#pragma unroll
                    for (int bj = 0; bj < 2; ++bj)
#pragma unroll
                        for (int n = 0; n < 2; ++n) __builtin_nontemporal_store(v[bj][n], (f32x4*)(out + off + 8 * bj + 4 * n));
                }
                if (xb) store_bf16x16(xb + off, v);
                if (part) { const float ss = quad_sum(sumsq16(v)); if (fq == 0) part[(size_t)row * 16 + u.pn * 4 + wc] = ss; }
            }
    }
};
struct EpiUp {
    static constexpr bool PERM = false, AFTER_DRAIN = false;
    const float* part; bf16_t* U; LAS float* T;
    mutable int last_pm = -1;
    __device__ __forceinline__ void operator()(const acc_t& acc, const pg8::Unit& u, int wr, int wc, int fr, int fq) const {
        const int col0 = u.pn * 256 + wc * 64 + 16 * fq;
        if (u.pm != last_pm) { fill_rstd16(T, part, u.pm, wr, fr + 16 * fq); last_pm = u.pm; }
#pragma unroll
        for (int ai = 0; ai < 2; ++ai)
#pragma unroll
            for (int m = 0; m < 4; ++m) {
                const int row = u.pm * 256 + ai * 128 + wr * 64 + m * 16 + fr;
                const float rs = T[ai * 64 + m * 16 + fr];
                f32x4 v[2][2];
#pragma unroll
                for (int bj = 0; bj < 2; ++bj)
#pragma unroll
                    for (int n = 0; n < 2; ++n) {
                        f32x4 t = acc[ai][bj][m][n] * rs;
#pragma unroll
                        for (int j = 0; j < 4; ++j) { const float r = fmaxf(t[j], 0.f); t[j] = r * r; }
                        v[bj][n] = t;
                    }
                store_bf16x16(U + (size_t)row * DFF + col0, v);
            }
    }
};
struct EpiIn1 {
    static constexpr bool PERM = false, AFTER_DRAIN = false;
    const float* part; const float* cs; const float* kg; bf16_t* CQ; float* cqp; bf16_t* K; bf16_t* V; bf16_t* KI; float* widx; float wscale; LAS float* T;
    mutable int last_pm = -1;
    __device__ __forceinline__ void operator()(const acc_t& acc, const pg8::Unit& u, int wr, int wc, int fr, int fq) const {
        const int pn = u.pn;
        if (pn == 9 && wc >= 2) return;
        f32x4 g[2][2] = {};
        if (pn >= 1 && pn <= 4) load_gain16(g, kg, fq);
        if (u.pm != last_pm) { fill_rstd16(T, part, u.pm, wr, fr + 16 * fq); last_pm = u.pm; }
#pragma unroll
        for (int ai = 0; ai < 2; ++ai)
#pragma unroll
            for (int m = 0; m < 4; ++m) {
                const int row = u.pm * 256 + ai * 128 + wr * 64 + m * 16 + fr;
                const float rs = T[ai * 64 + m * 16 + fr];
                f32x4 v[2][2];
#pragma unroll
                for (int bj = 0; bj < 2; ++bj)
#pragma unroll
                    for (int n = 0; n < 2; ++n) v[bj][n] = acc[ai][bj][m][n] * rs;
                if (pn == 0) {
                    store_bf16x16(CQ + (size_t)row * 256 + wc * 64 + 16 * fq, v);
                    const float ss = quad_sum(sumsq16(v)); if (fq == 0) cqp[(size_t)row * 4 + wc] = ss;
                } else if (pn <= 4) {
                    head_norm_rope(v, true, true, g, cs + (size_t)row * 16, fq, 1.0f);
                    store_bf16x16(K + (size_t)row * DM + ((pn - 1) * 4 + wc) * 64 + 16 * fq, v);
                } else if (pn <= 8) {
                    store_bf16x16(V + (size_t)row * DM + ((pn - 5) * 4 + wc) * 64 + 16 * fq, v);
                } else if (wc == 0) {
                    head_norm_rope(v, true, false, g, cs + (size_t)row * 16, fq, 1.0f);
                    store_bf16x16(KI + (size_t)row * 64 + 16 * fq, v);
                } else if (fq == 0) {
                    *(f32x4*)(widx + (size_t)row * 8) = v[0][0] * wscale; *(f32x4*)(widx + (size_t)row * 8 + 4) = v[0][1] * wscale;
                }
            }
    }
};
struct EpiQup {
    static constexpr bool PERM = false, AFTER_DRAIN = false;
    const float* cqp; const float* cs; const float* qg; const float* widx; bf16_t* Q; bf16_t* QI; float* qin; float qscale; LAS float* T;
    __device__ __forceinline__ void operator()(const acc_t& acc, const pg8::Unit& u, int wr, int wc, int fr, int fq) const {
        const int pn = u.pn;
        f32x4 g[2][2] = {};
        if (pn < 4) load_gain16(g, qg, fq);
        { const int lane = fr + 16 * fq;
          const f32x4 c0 = *(const f32x4*)(cqp + (size_t)(u.pm * 256 + wr * 64 + lane) * 4), c1 = *(const f32x4*)(cqp + (size_t)(u.pm * 256 + 128 + wr * 64 + lane) * 4);
          T[lane] = 1.0f / sqrtf(((c0[0] + c0[1]) + (c0[2] + c0[3])) * (1.0f / 256.0f) + EPS); T[64 + lane] = 1.0f / sqrtf(((c1[0] + c1[1]) + (c1[2] + c1[3])) * (1.0f / 256.0f) + EPS); }
#pragma unroll
        for (int ai = 0; ai < 2; ++ai)
#pragma unroll
            for (int m = 0; m < 4; ++m) {
                const int row = u.pm * 256 + ai * 128 + wr * 64 + m * 16 + fr;
                const float rs = T[ai * 64 + m * 16 + fr];
                f32x4 v[2][2];
#pragma unroll
                for (int bj = 0; bj < 2; ++bj)
#pragma unroll
                    for (int n = 0; n < 2; ++n) v[bj][n] = acc[ai][bj][m][n] * rs;
                if (pn < 4) {
                    head_norm_rope(v, true, true, g, cs + (size_t)row * 16, fq, qscale);
                    store_bf16x16(Q + (size_t)row * DM + (pn * 4 + wc) * 64 + 16 * fq, v);
                } else {
                    const int hh = (pn - 4) * 4 + wc;
                    head_norm_rope(v, false, false, g, cs + (size_t)row * 16, fq, 1.0f);
                    const float nrm = sqrtf(quad_sum(sumsq16(v)));
                    const float inv = nrm > 0.f ? 1.0f / (8.2f * nrm) : 0.f;
#pragma unroll
                    for (int bj = 0; bj < 2; ++bj)
#pragma unroll
                        for (int n = 0; n < 2; ++n) v[bj][n] = v[bj][n] * inv;
                    store_bf16x16(QI + (size_t)row * 512 + hh * 64 + 16 * fq, v);
                    if (fq == 0) qin[(size_t)row * 8 + hh] = widx[(size_t)row * 8 + hh] * (8.2f * nrm);
                }
            }
    }
};
typedef GAS unsigned gu32;
#define RLX_AGENT __ATOMIC_RELAXED, __HIP_MEMORY_SCOPE_AGENT
#define LDS_WAIT() asm volatile("s_waitcnt lgkmcnt(0)" ::: "memory")
#define VM_WAIT() asm volatile("s_waitcnt vmcnt(0)" ::: "memory")

constexpr int RING_BYTES = 143360;
constexpr int MISC_OFF = RING_BYTES + 320;
constexpr int LDS_BYTES = 147456;
constexpr int NWAVES = 8;

#define XB_TMO      128
#define XB_XCNT(j)  (256  + 64 * (j))
#define XB_XSUB(j)  (1280 + 64 * (j))
#define XB_XGEN(j)  (2304 + 64 * (j))
#define XB_TOP      3328
#define XB_TOPGEN   3392
#define XCD_BAR_WORDS 3456
#define XB_SPIN_CAP (1u << 18)
__device__ __forceinline__ unsigned xb_ld(unsigned* p)              { return __hip_atomic_load(p, __ATOMIC_RELAXED, __HIP_MEMORY_SCOPE_AGENT); }
__device__ __forceinline__ unsigned xb_add(unsigned* p, unsigned v) { return __hip_atomic_fetch_add(p, v, __ATOMIC_RELAXED, __HIP_MEMORY_SCOPE_AGENT); }
__device__ __forceinline__ unsigned xb_xcc_id() { return (unsigned)__builtin_amdgcn_s_getreg((3 << 11) | 20) & 0xFu; }
#define XB_SPIN(cond, bar) do { unsigned _sp = 0; while (cond) { __builtin_amdgcn_s_sleep(1); \
    if ((++_sp & 255u) == 0u) { if (xb_ld(&(bar)[XB_TMO])) break; if (_sp > XB_SPIN_CAP) { atomicAdd(&(bar)[XB_TMO], 1u); break; } } } } while (0)
struct XcdBarrier { unsigned* bar; unsigned x; volatile LAS unsigned* st; };
__device__ __forceinline__ XcdBarrier xcd_barrier_post(unsigned* bar, volatile LAS unsigned* st) {
    XcdBarrier b; b.bar = bar; b.x = xb_xcc_id(); b.st = st;
    if (threadIdx.x == 0) (void)xb_add(&bar[XB_XCNT(b.x)], 1u);
    return b;
}
__device__ __forceinline__ void xcd_barrier_complete(unsigned* bar, unsigned x, unsigned& nloc, unsigned& nx) {
    const unsigned G = gridDim.x * gridDim.y * gridDim.z;
    unsigned sum, cnt, mine, sp = 0u;
    for (;;) {
        sum = 0u; cnt = 0u; mine = 0u;
#pragma unroll
        for (unsigned j = 0; j < 16; ++j) { const unsigned c = xb_ld(&bar[XB_XCNT(j)]); sum += c; cnt += (c > 0u) ? 1u : 0u; mine = (j == x) ? c : mine; }
        if (sum == G) break;
        __builtin_amdgcn_s_sleep(1);
        if ((++sp & 255u) == 0u) { if (xb_ld(&bar[XB_TMO])) break; if (sp > XB_SPIN_CAP) { atomicAdd(&bar[XB_TMO], 1u); break; } }
    }
    nloc = mine > 0u ? mine : 1u; nx = cnt > 0u ? cnt : 1u;
}
__device__ __forceinline__ void xcd_barrier(const XcdBarrier& b, const int wave) {
    asm volatile("s_waitcnt vmcnt(0)" ::: "memory");
    __syncthreads();
    if (wave == 0 && fresh_lane() == 0) {
        unsigned* bar = b.bar;
        __builtin_amdgcn_s_waitcnt(0);
        unsigned nloc = b.st[0], nx = b.st[1];
        if (nloc == 0u) { xcd_barrier_complete(bar, b.x, nloc, nx); b.st[0] = nloc; b.st[1] = nx; }
        const unsigned old = xb_add(&bar[XB_XSUB(b.x)], 1u);
        const unsigned gen = old / nloc;
        if (old + 1u == (gen + 1u) * nloc) {
            __builtin_amdgcn_fence(__ATOMIC_RELEASE, "agent");
            asm volatile("s_waitcnt vmcnt(0)" ::: "memory");
            const unsigned og = xb_add(&bar[XB_TOP], 1u);
            const unsigned tg = og / nx;
            if (og + 1u == (tg + 1u) * nx) xb_add(&bar[XB_TOPGEN], 1u);
            else XB_SPIN(xb_ld(&bar[XB_TOPGEN]) == tg, bar);
            __builtin_amdgcn_fence(__ATOMIC_ACQUIRE, "agent");
            xb_add(&bar[XB_XGEN(b.x)], 1u);
            asm volatile("s_waitcnt vmcnt(0)" ::: "memory");
        } else {
            XB_SPIN(xb_ld(&bar[XB_XGEN(b.x)]) == gen, bar);
            __builtin_amdgcn_fence(__ATOMIC_ACQUIRE, "agent");
            asm volatile("s_waitcnt vmcnt(0)" ::: "memory");
        }
    }
    __syncthreads();
}

__device__ __forceinline__ unsigned f2bf(float f) { unsigned u = __builtin_bit_cast(unsigned, f); return (u + 0x7fffu + ((u >> 16) & 1u)) >> 16; }
__device__ __forceinline__ unsigned pk2(float lo, float hi) { return f2bf(lo) | (f2bf(hi) << 16); }
__device__ __forceinline__ void p0_transpose_item(const float* __restrict__ W, int K, int N, const float* __restrict__ gain, bf16_t* WT, int row_off, LAS float* scr, int item, int nblk, int lane) {
    const int kb = item / nblk, nb = item % nblk, k0 = 64 * kb, n0 = 32 * nb;
    const int cc = n0 + (lane & 31);
    float wv[32];
#pragma unroll
    for (int i = 0; i < 32; ++i) { const int kk = 2 * i + (lane >> 5); wv[i] = (cc < N) ? __builtin_nontemporal_load(W + (size_t)(k0 + kk) * N + cc) : 0.f; }
    if (gain) {
#pragma unroll
        for (int i = 0; i < 32; ++i) wv[i] *= gain[k0 + 2 * i + (lane >> 5)];
    }
#pragma unroll
    for (int i = 0; i < 32; ++i) scr[(2 * i + (lane >> 5)) * 33 + (lane & 31)] = wv[i];
    LDS_WAIT(); asm volatile("" ::: "memory");
    const int c = lane & 7;
#pragma unroll
    for (int j = 0; j < 4; ++j) { const int n = (lane >> 3) + 8 * j; const LAS float* s = scr + (8 * c) * 33 + n;
        u32x4 o; o.x = pk2(s[0 * 33], s[1 * 33]); o.y = pk2(s[2 * 33], s[3 * 33]); o.z = pk2(s[4 * 33], s[5 * 33]); o.w = pk2(s[6 * 33], s[7 * 33]);
        const int cl = n0 + n; const int drow = row_off + (cl & ~255) + tile_pos(cl & 255);
        *(GAS u32x4*)(WT + (size_t)drow * K + k0 + 8 * c) = o; }
    LDS_WAIT(); asm volatile("" ::: "memory");
}
struct WJob { const float* W; const float* gain; bf16_t* WT; int K, N, Npad, row_off; };
template <int NR> __device__ __forceinline__ void rows_to_bf16(const float* x, bf16_t* xb, float* part, int m, int rstride, int lane) {
    f32x4 v[NR][4];
#pragma unroll
    for (int r = 0; r < NR; ++r) { const GAS f32x4* xr = (const GAS f32x4*)(x + (size_t)(m + r * rstride) * DM) + lane;
#pragma unroll
        for (int j = 0; j < 4; ++j) v[r][j] = __builtin_nontemporal_load(xr + 64 * j); }
#pragma unroll
    for (int r = 0; r < NR; ++r) {
        float s = 0.f;
#pragma unroll
        for (int j = 0; j < 4; ++j) s += (v[r][j][0] * v[r][j][0] + v[r][j][1] * v[r][j][1]) + (v[r][j][2] * v[r][j][2] + v[r][j][3] * v[r][j][3]);
        s = wave_sum(s);
        GAS u32x2* o8 = (GAS u32x2*)(xb + (size_t)(m + r * rstride) * DM) + lane;
#pragma unroll
        for (int j = 0; j < 4; ++j) { u32x2 w; w.x = cvt_pk_bf16(v[r][j][0], v[r][j][1]); w.y = cvt_pk_bf16(v[r][j][2], v[r][j][3]); o8[64 * j] = w; }
        if (lane < 16) part[(size_t)(m + r * rstride) * 16 + lane] = (lane == 0) ? s : 0.f;
    }
}
constexpr int ATT_SCR = 131072;
constexpr int ATT_NST = 4;
typedef short v4i16_t __attribute__((ext_vector_type(4)));
typedef short s16x4 __attribute__((ext_vector_type(4)));
__device__ __forceinline__ int crow(int r, int hi) { return (r & 3) + 8 * (r >> 2) + 4 * hi; }
__device__ __forceinline__ s16x4 vtr(const LAS unsigned char* p) { return __builtin_bit_cast(s16x4, __builtin_amdgcn_ds_read_tr16_b64_v4i16((LAS v4i16_t*)p)); }
__device__ __forceinline__ void glds16(const void* gsrc, unsigned lds_dst) { unsigned keep;
    asm volatile("s_mov_b32 %0, m0\n\ts_mov_b32 m0, %2\n\ts_nop 0\n\tglobal_load_lds_dwordx4 %1, off\n\ts_mov_b32 m0, %0" : "=&s"(keep) : "v"(gsrc), "s"(lds_dst) : "memory"); }
__device__ __forceinline__ void glds4(const void* gsrc, unsigned lds_dst) { unsigned keep;
    asm volatile("s_mov_b32 %0, m0\n\ts_mov_b32 m0, %2\n\ts_nop 0\n\tglobal_load_lds_dword %1, off\n\ts_mov_b32 m0, %0" : "=&s"(keep) : "v"(gsrc), "s"(lds_dst) : "memory"); }
#define ATT_WAIT_BAR() do { asm volatile("s_waitcnt vmcnt(0) lgkmcnt(0)" ::: "memory"); __builtin_amdgcn_s_barrier(); asm volatile("" ::: "memory"); } while (0)
#define ATT_WAIT_BAR_N(N) do { asm volatile("s_waitcnt vmcnt(" #N ") lgkmcnt(0)" ::: "memory"); __builtin_amdgcn_s_barrier(); asm volatile("" ::: "memory"); } while (0)

__device__ __forceinline__ int att_k_src_chunk(int row, int slot) { return slot ^ ((row >> 1) & 7); }
__device__ __forceinline__ void att_qkt(f32x16& p0, f32x16& p1, const LAS unsigned char* Kslot, const int (&koff)[4], const bf16x8 (&qr)[4]) {
    p0 = (f32x16){}; p1 = (f32x16){};
#pragma unroll
    for (int d0 = 0; d0 < 4; ++d0) {
        const bf16x8 b0 = *(const LAS bf16x8*)(Kslot + koff[d0]);
        const bf16x8 b1 = *(const LAS bf16x8*)(Kslot + koff[d0] + 4096);
        p0 = __builtin_amdgcn_mfma_f32_32x32x16_bf16(b0, qr[d0], p0, 0, 0, 0);
        p1 = __builtin_amdgcn_mfma_f32_32x32x16_bf16(b1, qr[d0], p1, 0, 0, 0);
    }
}
__device__ __forceinline__ bf16x8 pack8(const f32x16& p, int base) {
    u32x4 w; w.x = cvt_pk_bf16(p[base], p[base + 1]); w.y = cvt_pk_bf16(p[base + 2], p[base + 3]); w.z = cvt_pk_bf16(p[base + 4], p[base + 5]); w.w = cvt_pk_bf16(p[base + 6], p[base + 7]);
    return __builtin_bit_cast(bf16x8, w);
}

template <int NDB, bool MASKED, int VAR = 0> __device__ __forceinline__ void att_step(f32x16 (&o)[NDB], f32x16& ol, bf16x8 (&pa)[4], float& l, const LAS unsigned char* Kslot, const LAS unsigned char* Vslot,
                                                                       const int (&koff)[4], const int (&vboff)[NDB], const bf16x8 (&qr)[4], unsigned mlo, unsigned mhi, const bool live) {
    constexpr int ROWB = NDB * 64;
    bf16x8 vfa[NDB == 2 ? 8 : 1];
    if (NDB == 2) {
#pragma unroll
        for (int i = 0; i < 8; ++i) { const int d = i >> 2, ks = i & 3;
            const s16x4 lo = vtr(Vslot + vboff[d] + ks * 16 * ROWB), hi4 = vtr(Vslot + vboff[d] + ks * 16 * ROWB + 8 * ROWB);
            vfa[i] = (bf16x8){lo[0], lo[1], lo[2], lo[3], hi4[0], hi4[1], hi4[2], hi4[3]}; }
    }
    f32x16 p0, p1;
    if (VAR & 8) { p0 = (f32x16){}; p1 = (f32x16){}; asm volatile("" : "+v"(p0), "+v"(p1)); } else att_qkt(p0, p1, Kslot, koff, qr);
    __builtin_amdgcn_sched_barrier(0);
    bf16x8 pn[4];
#pragma unroll
    for (int sl = 0; sl < 4; ++sl) {
#pragma unroll
        for (int j = 0; j < NDB; ++j) {
            const int d = j, ks = sl;
            bf16x8 vf;
            if (NDB == 2) { vf = vfa[d * 4 + ks]; } else
            if (VAR & 16) { vf = pa[ks]; } else {
                const s16x4 lo = vtr(Vslot + vboff[d] + ks * 16 * ROWB), hi4 = vtr(Vslot + vboff[d] + ks * 16 * ROWB + 8 * ROWB);
                vf = (bf16x8){lo[0], lo[1], lo[2], lo[3], hi4[0], hi4[1], hi4[2], hi4[3]}; }
            if (VAR & 4) { asm volatile("" :: "v"(vf)); } else
            o[d] = __builtin_amdgcn_mfma_f32_32x32x16_bf16(pa[ks], vf, o[d], 0, 0, 0);
        }
        if (NDB == 2) {
            const bf16x8 ones = (bf16x8){0x3F80, 0x3F80, 0x3F80, 0x3F80, 0x3F80, 0x3F80, 0x3F80, 0x3F80};
            ol = __builtin_amdgcn_mfma_f32_32x32x16_bf16(pa[sl], ones, ol, 0, 0, 0);
        }
        f32x16& p = (sl < 2) ? p0 : p1;
        const unsigned mk = (sl < 2) ? mlo : mhi;
        const int rb0 = 8 * (sl & 1);
        float ps = 0.f;
        if (MASKED && !(VAR & 1)) {
            const unsigned m3 = mk, m2 = mk << 1, m1 = mk << 2, m0 = mk << 3;
            float e[8];
#pragma unroll
            for (int i = 0; i < 8; ++i) e[i] = (VAR & 2) ? p[rb0 + i] : __builtin_amdgcn_exp2f(p[rb0 + i]);
#define SDWA_AND_(d, m, B) "v_and_b32_sdwa " d ", " d ", sext(" m ") dst_sel:DWORD dst_unused:UNUSED_PAD src0_sel:DWORD src1_sel:BYTE_" B "\n\t"
            if (sl & 1)
                asm("s_nop 0\n\t" SDWA_AND_("%0", "%8", "2") SDWA_AND_("%1", "%9", "2") SDWA_AND_("%2", "%10", "2") SDWA_AND_("%3", "%11", "2")
                                  SDWA_AND_("%4", "%8", "3") SDWA_AND_("%5", "%9", "3") SDWA_AND_("%6", "%10", "3") SDWA_AND_("%7", "%11", "3")
                    : "+v"(e[0]), "+v"(e[1]), "+v"(e[2]), "+v"(e[3]), "+v"(e[4]), "+v"(e[5]), "+v"(e[6]), "+v"(e[7]) : "v"(m0), "v"(m1), "v"(m2), "v"(m3));
            else
                asm("s_nop 0\n\t" SDWA_AND_("%0", "%8", "0") SDWA_AND_("%1", "%9", "0") SDWA_AND_("%2", "%10", "0") SDWA_AND_("%3", "%11", "0")
                                  SDWA_AND_("%4", "%8", "1") SDWA_AND_("%5", "%9", "1") SDWA_AND_("%6", "%10", "1") SDWA_AND_("%7", "%11", "1")
                    : "+v"(e[0]), "+v"(e[1]), "+v"(e[2]), "+v"(e[3]), "+v"(e[4]), "+v"(e[5]), "+v"(e[6]), "+v"(e[7]) : "v"(m0), "v"(m1), "v"(m2), "v"(m3));
#undef SDWA_AND_
#pragma unroll
            for (int i = 0; i < 8; ++i) { p[rb0 + i] = e[i]; if (NDB != 2) ps += e[i]; }
        } else {
#pragma unroll
            for (int r = rb0; r < rb0 + 8; ++r) { const float e = (VAR & 2) ? p[r] : __builtin_amdgcn_exp2f(p[r]); p[r] = e; if (NDB != 2) ps += e; }
        }
        if (NDB != 2) l += live ? ps : 0.f;
        pn[sl] = pack8(p, rb0);
        __builtin_amdgcn_sched_barrier(0);
    }
#pragma unroll
    for (int ks = 0; ks < 4; ++ks) pa[ks] = pn[ks];
}

constexpr int A0_STAGE = 32768;
template <int VAR = 0> __device__ __forceinline__ void attn0_unit(LAS unsigned char* lds, const int wave, int b, int h, int qb, const bf16_t* Q, const bf16_t* __restrict__ K, const bf16_t* __restrict__ V, bf16_t* O,
                                           float lam, const float* __restrict__ subg, float outscale, bool dry) {
    const int lane = fresh_lane(), r32 = lane & 31, hi = lane >> 5;
    const int cc = wave >> 2, rb = wave & 3;
    const size_t rowbase = (size_t)b * SEQ;
    const int q0 = qb * 128 + rb * 32;
    const int NT = 2 * qb + 2;
    const int mylast = 2 * qb + (rb >> 1);
    const int krow = 8 * wave + (lane >> 3), kch = att_k_src_chunk(krow, lane & 7);
    const bf16_t* ksrc0 = K + (rowbase + krow) * DM + (2 * h + 0) * 64 + kch * 8;
    const bf16_t* ksrc1 = K + (rowbase + krow) * DM + (2 * h + 1) * 64 + kch * 8;
    const int vp0 = wave, vp1 = wave + 8;
    const int vrow0 = 4 * vp0 + (lane >> 4), vrow1 = 4 * vp1 + (lane >> 4), vs = lane & 15;
    const bf16_t* vsrc0 = V + (rowbase + vrow0) * DM + h * 128 + ((((vs >> 2) ^ (vrow0 & 3)) << 2) | (vs & 3)) * 8;
    const bf16_t* vsrc1 = V + (rowbase + vrow1) * DM + h * 128 + ((((vs >> 2) ^ (vrow1 & 3)) << 2) | (vs & 3)) * 8;
    const unsigned ldsb = (unsigned)(unsigned long long)lds;
#define A0_ISSUE(t, st) do { const unsigned sb_ = (unsigned)__builtin_amdgcn_readfirstlane(ldsb + (st) * A0_STAGE); const size_t go_ = (size_t)(t) * 64 * DM; \
        glds16(ksrc0 + go_, sb_ + wave * 1024); glds16(ksrc1 + go_, sb_ + 8192 + wave * 1024); \
        glds16(vsrc0 + go_, sb_ + 16384 + vp0 * 1024); glds16(vsrc1 + go_, sb_ + 16384 + vp1 * 1024); } while (0)
    bf16x8 qr[4];
    { const bf16_t* Qw = Q + (rowbase + q0) * DM + (2 * h + cc) * 64;
#pragma unroll
      for (int d0 = 0; d0 < 4; ++d0) qr[d0] = *(const bf16x8*)(Qw + (size_t)r32 * DM + d0 * 16 + hi * 8); }
    A0_ISSUE(0, 0); A0_ISSUE(1, 1);
    f32x16 o[4]; o[0] = (f32x16){}; o[1] = (f32x16){}; o[2] = (f32x16){}; o[3] = (f32x16){};
    float l = 0.f;
    int koff[4], vboff[4];
    { const int sw = (r32 >> 1) & 7, q4 = (lane & 15) >> 2, vbase = (4 * hi + q4) * 256 + ((lane >> 4) & 1) * 32 + (lane & 3) * 8;
#pragma unroll
      for (int d = 0; d < 4; ++d) { koff[d] = r32 * 128 + (((2 * d + hi) ^ sw) << 4); vboff[d] = vbase + ((d ^ q4) << 6); } }
    if (wave >= 4) __builtin_amdgcn_s_setprio(1);
    bf16x8 pa[4]; pa[0] = (bf16x8){}; pa[1] = (bf16x8){}; pa[2] = (bf16x8){}; pa[3] = (bf16x8){};
    int sk = 0, sv = 3;
    for (int t = 0; t <= NT; ++t) {
        if (t + 1 < NT) ATT_WAIT_BAR_N(4); else ATT_WAIT_BAR();
        if (t + 2 < NT) A0_ISSUE(t + 2, ((sk + 2) & 3));
        if (t <= mylast + 1) {
            const LAS unsigned char* Kslot = lds + sk * A0_STAGE + cc * 8192;
            const LAS unsigned char* Vslot = lds + (t == 0 ? 0 : sv) * A0_STAGE + 16384;
            att_step<4, false, VAR>(o, o[0], pa, l, Kslot, Vslot, koff, vboff, qr, 0u, 0u, t <= mylast);
        }
        sv = sk; sk = (sk + 1) & 3;
    }
#undef A0_ISSUE
    __builtin_amdgcn_s_setprio(0);
    ATT_WAIT_BAR();
    const int lane_e = fresh_lane(), r32e = lane_e & 31, hie = lane_e >> 5;
    l += __shfl_xor(l, 32);
    LAS float* wsf = (LAS float*)(lds + ATT_SCR + wave * 256);
    if (hie == 0) wsf[r32e] = l;
    asm volatile("s_waitcnt lgkmcnt(0)" ::: "memory");
    float rli[16];
#pragma unroll
    for (int r = 0; r < 16; ++r) rli[r] = 1.0f / wsf[crow(r, hie)];
    LAS float* X = (LAS float*)lds;
    if (cc == 1) {
#pragma unroll
        for (int r = 0; r < 16; ++r)
#pragma unroll
            for (int d = 0; d < 4; ++d) X[(rb * 32 + crow(r, hie)) * 128 + d * 32 + r32e] = o[d][r] * rli[r];
    }
    ATT_WAIT_BAR();
    if (cc == 0 && !dry) {
        float gsub[4];
#pragma unroll
        for (int d = 0; d < 4; ++d) gsub[d] = subg[d * 32 + r32e] * outscale;
#pragma unroll
        for (int r = 0; r < 16; ++r) {
            float v[4]; float ss = 0.f;
#pragma unroll
            for (int d = 0; d < 4; ++d) { v[d] = o[d][r] * rli[r] - lam * X[(rb * 32 + crow(r, hie)) * 128 + d * 32 + r32e]; ss += v[d] * v[d]; }
            ss += __shfl_xor(ss, 1); ss += __shfl_xor(ss, 2); ss += __shfl_xor(ss, 4); ss += __shfl_xor(ss, 8); ss += __shfl_xor(ss, 16);
            const float rn = 1.0f / sqrtf(ss * (1.0f / 128.0f) + EPS);
            bf16_t* op = O + (rowbase + q0 + crow(r, hie)) * DM + h * 128 + r32e;
#pragma unroll
            for (int d = 0; d < 4; ++d) op[d * 32] = (bf16_t)(cvt_pk_bf16(v[d] * rn * gsub[d], 0.f) & 0xffffu);
        }
    }
    ATT_WAIT_BAR();
}
__device__ __forceinline__ void attn0_phase(LAS unsigned char* lds, const int wave, unsigned char* ws, const float* subln, bool dry) {
    const int G = gridDim.x, bx = blockIdx.x;
    const bf16_t* Q = (const bf16_t*)(ws + WS_Q); const bf16_t* K = (const bf16_t*)(ws + WS_K); const bf16_t* V = (const bf16_t*)(ws + WS_V);
    const float lam = *(const float*)(ws + WS_MISC);
    for (int vb = bx; vb < 256; vb += G) {
        const int x = vb & 7, j = vb >> 3;
#pragma unroll 1
        for (int i = 0; i < 4; ++i) {
            const int r = i >> 1, jj = (j + 16 * r) & 31, qb = (i & 1) ? 63 - jj : jj, bh = 2 * x + r;
#if defined(PROBE_ATT0_VAR)
            if (dry) attn0_unit<PROBE_ATT0_VAR>(lds, wave, bh >> 3, bh & 7, qb, Q, K, V, (bf16_t*)(ws + WS_Q), lam, subln, 0.8f, dry); else
#endif
            attn0_unit<0>(lds, wave, bh >> 3, bh & 7, qb, Q, K, V, (bf16_t*)(ws + WS_Q), lam, subln, 0.8f, dry);
        }
    }
}

constexpr int A1_STAGE = 16384;
constexpr int A1_MASK = ATT_NST * A1_STAGE;
template <int VAR = 0> __device__ __forceinline__ void attn1_unit(LAS unsigned char* lds, const int wave, int b, int h, int qb, const bf16_t* Q, const bf16_t* __restrict__ K, const bf16_t* __restrict__ V, bf16_t* O,
                                           const unsigned long long* __restrict__ MASK, bool dry, const bool pre = false, const int nb = 0, const int nh = 0, const int nqb = -1) {
    const int lane = fresh_lane(), r32 = lane & 31, hi = lane >> 5;
    const size_t rowbase = (size_t)b * SEQ;
    const int q0 = qb * 256 + wave * 32;
    const int NT = 4 * qb + 4;
    const int mylast = 4 * qb + (wave >> 1);
    const int krow = 8 * wave + (lane >> 3);
    const bf16_t* ksrc = K + (rowbase + krow) * DM + h * 64 + att_k_src_chunk(krow, lane & 7) * 8;
    const bf16_t* vsrc = V + (rowbase + krow) * DM + h * 64 + ((lane & 7) ^ (((krow >> 1) & 1) << 2)) * 8;
    const unsigned ldsb = (unsigned)(unsigned long long)lds;
    const unsigned long long* mrow = MASK + (size_t)b * 128 * SEQ + q0;
#define A1_ISSUE(t, st) do { const unsigned sb_ = (unsigned)__builtin_amdgcn_readfirstlane(ldsb + (st) * A1_STAGE); const size_t go_ = (size_t)(t) * 64 * DM; \
        glds16(ksrc + go_, sb_ + wave * 1024); glds16(vsrc + go_, sb_ + 8192 + wave * 1024); \
        glds4((const unsigned*)(mrow + (size_t)(t) * SEQ) + lane, (unsigned)__builtin_amdgcn_readfirstlane(ldsb + A1_MASK + ((st) * NWAVES + wave) * 256)); } while (0)
    bf16x8 qr[4];
    { const bf16_t* Qw = Q + (rowbase + q0) * DM + h * 64;
#pragma unroll
      for (int d0 = 0; d0 < 4; ++d0) qr[d0] = *(const bf16x8*)(Qw + (size_t)r32 * DM + d0 * 16 + hi * 8); }
    if (!pre) { A1_ISSUE(0, 0); A1_ISSUE(1, 1); }
    f32x16 o[2]; o[0] = (f32x16){}; o[1] = (f32x16){};
    f32x16 ol = (f32x16){};
    float l = 0.f;
    int koff[4], vboff[2];
    { const int sw = (r32 >> 1) & 7, q4 = (lane & 15) >> 2, vbase = (4 * hi + q4) * 128 + ((lane >> 4) & 1) * 32 + (lane & 3) * 8;
#pragma unroll
      for (int d = 0; d < 4; ++d) koff[d] = r32 * 128 + (((2 * d + hi) ^ sw) << 4);
#pragma unroll
      for (int d = 0; d < 2; ++d) vboff[d] = vbase + ((d ^ ((q4 >> 1) & 1)) << 6); }
    bf16x8 pa[4]; pa[0] = (bf16x8){}; pa[1] = (bf16x8){}; pa[2] = (bf16x8){}; pa[3] = (bf16x8){};
    int sk = 0, sv = 3;
    if (wave >= 4) __builtin_amdgcn_s_setprio(1);
    for (int t = 0; t <= NT; ++t) {
        if (VAR & 32) { asm volatile("s_waitcnt vmcnt(0) lgkmcnt(0)" ::: "memory"); } else
        if (t + 1 < NT) ATT_WAIT_BAR_N(3); else ATT_WAIT_BAR();
        if (!(VAR & 64)) if (t + 2 < NT) A1_ISSUE(t + 2, ((sk + 2) & 3));
        const unsigned long long mw = *(const LAS unsigned long long*)(lds + A1_MASK + (sk * NWAVES + wave) * 256 + r32 * 8);
        const unsigned mlo = (unsigned)mw << (4 - 4 * hi), mhi = (unsigned)(mw >> 32) << (4 - 4 * hi);
        if (t <= mylast + 1) {
            const LAS unsigned char* Kslot = lds + sk * A1_STAGE;
            const LAS unsigned char* Vslot = lds + (t == 0 ? 0 : sv) * A1_STAGE + 8192;
            att_step<2, true, VAR>(o, ol, pa, l, Kslot, Vslot, koff, vboff, qr, mlo, mhi, t <= mylast);
        }
        sv = sk; sk = (sk + 1) & 3;
    }
#undef A1_ISSUE
    __builtin_amdgcn_s_setprio(0);
    if (nqb >= 0) {
        const int ln = fresh_lane(), krn = 8 * wave + (ln >> 3);
        const size_t nrow = (size_t)nb * SEQ;
        const bf16_t* ks_n = K + (nrow + krn) * DM + nh * 64 + att_k_src_chunk(krn, ln & 7) * 8;
        const bf16_t* vs_n = V + (nrow + krn) * DM + nh * 64 + ((ln & 7) ^ (((krn >> 1) & 1) << 2)) * 8;
        const unsigned long long* mr_n = MASK + (size_t)nb * 128 * SEQ + nqb * 256 + wave * 32;
#pragma unroll
        for (int tt = 0; tt < 2; ++tt) {
            const unsigned sb_ = (unsigned)__builtin_amdgcn_readfirstlane(ldsb + tt * A1_STAGE); const size_t go_ = (size_t)tt * 64 * DM;
            glds16(ks_n + go_, sb_ + wave * 1024); glds16(vs_n + go_, sb_ + 8192 + wave * 1024);
            glds4((const unsigned*)(mr_n + (size_t)tt * SEQ) + ln, (unsigned)__builtin_amdgcn_readfirstlane(ldsb + A1_MASK + (tt * NWAVES + wave) * 256));
        }
    }
    if (dry) asm volatile("" :: "v"(o[0]), "v"(o[1]), "v"(ol));
    const int lane_e = fresh_lane(), r32e = lane_e & 31, hie = lane_e >> 5;
    if (!dry)
#pragma unroll
    for (int r = 0; r < 16; ++r) {
        const float rl = 1.0f / ol[r];
        bf16_t* op = O + (rowbase + q0 + crow(r, hie)) * DM + h * 64 + r32e;
        op[0] = (bf16_t)(cvt_pk_bf16(o[0][r] * rl, 0.f) & 0xffffu); op[32] = (bf16_t)(cvt_pk_bf16(o[1][r] * rl, 0.f) & 0xffffu);
    }
    (void)l;
    ATT_WAIT_BAR();
}
__device__ __forceinline__ void attn1_phase(LAS unsigned char* lds, const int wave, unsigned char* ws, bool dry) {
    const int G = gridDim.x, bx = blockIdx.x;
    const bf16_t* Q = (const bf16_t*)(ws + WS_Q); const bf16_t* K = (const bf16_t*)(ws + WS_K); const bf16_t* V = (const bf16_t*)(ws + WS_V);
    for (int vb = bx; vb < 256; vb += G) {
        const int x = vb & 7, j = vb >> 3;
#pragma unroll 1
        for (int i = 0; i < 4; ++i) {
            const int jj = (j + 16 * (i >> 1)) & 31, qb = (i & 1) ? 31 - jj : jj, bh = 4 * x + i;
#if defined(PROBE_ATT1_VAR)
            if (dry) attn1_unit<PROBE_ATT1_VAR>(lds, wave, bh >> 4, bh & 15, qb, Q, K, V, (bf16_t*)(ws + WS_Q), (const unsigned long long*)(ws + WS_MASK), dry); else
#endif
            {   const int i2 = i + 1, jn = (j + 16 * (i2 >> 1)) & 31, nqb = (i2 < 4 && !dry) ? ((i2 & 1) ? 31 - jn : jn) : -1, nbh = 4 * x + i2;
                attn1_unit<0>(lds, wave, bh >> 4, bh & 15, qb, Q, K, V, (bf16_t*)(ws + WS_Q), (const unsigned long long*)(ws + WS_MASK), dry, i > 0 && !dry, nbh >> 4, nbh & 15, nqb); }
        }
    }
}
constexpr int IX_NB = 512, IX_HSTR = 513, IX_CAP = 320, IX_BSTR = 257;
constexpr int IX_HIST = 0, IX_CK = 0, IX_CI = 32 * IX_CAP * 4, IX_BM = 66560, IX_META = IX_BM + 32 * IX_BSTR * 4 + 128;
constexpr float IX_FINE = 4.0f;
constexpr int IX_QS = 100352, IX_QPITCH = 1040;
static_assert(IX_META + 512 <= IX_QS && IX_QS + 32 * IX_QPITCH <= RING_BYTES, "indexer LDS map (query image)");
static_assert(IX_CI + 32 * IX_CAP * 2 <= IX_BM && 32 * IX_HSTR * 4 <= IX_BM && IX_META + 512 <= RING_BYTES, "indexer LDS map");

__device__ __forceinline__ void ix_abs_fma(f32x16& sc, const f32x16& d, float ah) {
#pragma unroll
    for (int r = 0; r < 16; ++r) { float t = sc[r]; asm("v_fma_f32 %0, %1, |%2|, %0" : "+v"(t) : "v"(ah), "v"(d[r])); sc[r] = t; }
}
__device__ __forceinline__ void ix_scores(f32x16& sc, const bf16x8 (&kf)[4], const bf16x8 (&qf)[8][4], const bf16x8 (&qc)[4], const float (&ah)[8]) {
#define IX_PAIR_(X, hx, Y, hy) do { X = (f32x16){}; Y = (f32x16){}; _Pragma("unroll") for (int s = 0; s < 4; ++s) { \
        X = __builtin_amdgcn_mfma_f32_32x32x16_bf16(kf[s], qf[hx][s], X, 0, 0, 0); Y = __builtin_amdgcn_mfma_f32_32x32x16_bf16(kf[s], qf[hy][s], Y, 0, 0, 0); } } while (0)
#define IX_FMA_(D, h) do { ix_abs_fma(sc, D, ah[h]); asm volatile("" : "+v"(sc)); __builtin_amdgcn_sched_barrier(0); } while (0)
    sc = (f32x16){};
    f32x16 A = (f32x16){}, B, C;
#pragma unroll
    for (int s = 0; s < 4; ++s) {
        sc = __builtin_amdgcn_mfma_f32_32x32x16_bf16(kf[s], qc[s], sc, 0, 0, 0);
        A = __builtin_amdgcn_mfma_f32_32x32x16_bf16(kf[s], qf[0][s], A, 0, 0, 0);
    }
    asm volatile("" : "+v"(sc), "+v"(A));
    __builtin_amdgcn_sched_barrier(0);
    IX_PAIR_(B, 1, C, 2); asm volatile("" : "+v"(B), "+v"(C), "+v"(A), "+v"(sc)); __builtin_amdgcn_sched_barrier(0);
    IX_FMA_(A, 0); IX_FMA_(B, 1);
    IX_PAIR_(A, 3, B, 4); asm volatile("" : "+v"(A), "+v"(B), "+v"(C), "+v"(sc)); __builtin_amdgcn_sched_barrier(0);
    IX_FMA_(C, 2); IX_FMA_(A, 3);
    IX_PAIR_(C, 5, A, 6); asm volatile("" : "+v"(C), "+v"(A), "+v"(B), "+v"(sc)); __builtin_amdgcn_sched_barrier(0);
    IX_FMA_(B, 4); IX_FMA_(C, 5);
    B = (f32x16){};
#pragma unroll
    for (int s = 0; s < 4; ++s) B = __builtin_amdgcn_mfma_f32_32x32x16_bf16(kf[s], qf[7][s], B, 0, 0, 0);
    asm volatile("" : "+v"(B), "+v"(A), "+v"(sc)); __builtin_amdgcn_sched_barrier(0);
    IX_FMA_(A, 6); IX_FMA_(B, 7);
#undef IX_PAIR_
#undef IX_FMA_
}
__device__ __forceinline__ void ix_combine(bf16x8 (&qc)[4], const bf16x8 (&qf)[8][4], const float (&ah)[8]) {
#pragma unroll
    for (int s = 0; s < 4; ++s) {
        float acc[8];
#pragma unroll
        for (int j = 0; j < 8; ++j) acc[j] = 0.f;
#pragma unroll
        for (int h = 0; h < 8; ++h)
#pragma unroll
            for (int j = 0; j < 8; ++j) acc[j] = __builtin_fmaf(ah[h], __uint_as_float((unsigned)(unsigned short)qf[h][s][j] << 16), acc[j]);
        u32x4 w; w.x = cvt_pk_bf16(acc[0], acc[1]); w.y = cvt_pk_bf16(acc[2], acc[3]); w.z = cvt_pk_bf16(acc[4], acc[5]); w.w = cvt_pk_bf16(acc[6], acc[7]);
        qc[s] = __builtin_bit_cast(bf16x8, w);
    }
}
__device__ __forceinline__ int ix_bin(float sc, float Rs, float scale) {
    const int b = (int)__builtin_fmaf(sc, scale, Rs);
    return b < 0 ? 0 : (b > IX_NB - 1 ? IX_NB - 1 : b);
}
__device__ __forceinline__ void ix_loadk(bf16x8 (&kf)[4], const bf16_t* KIb, int kt, int r32, int hi) {
    const int l_ = fresh_lane();
    const bf16_t* p = KIb + (size_t)(unsigned)((kt * 32 + (l_ & 31)) * 64 + (l_ >> 5) * 8);
#pragma unroll
    for (int s = 0; s < 4; ++s) kf[s] = *(const bf16x8*)(p + s * 16);
}

__device__ __forceinline__ void ix_dmak(const bf16_t* KIb, int kt, unsigned ldsbuf) {
    const int l_ = fresh_lane();
#pragma unroll
    for (int i = 0; i < 4; ++i) { const int row = 8 * i + (l_ >> 3);
        glds16(KIb + (size_t)(unsigned)((kt * 32 + row) * 64 + att_k_src_chunk(row, l_ & 7) * 8), ldsbuf + i * 1024); }
}
__device__ __forceinline__ void ix_readk(bf16x8 (&kf)[4], const LAS unsigned char* buf) {
    const int l_ = fresh_lane(); const int r_ = l_ & 31, h_ = l_ >> 5, sw_ = (r_ >> 1) & 7;
#pragma unroll
    for (int s = 0; s < 4; ++s) kf[s] = *(const LAS bf16x8*)(buf + r_ * 128 + (((2 * s + h_) ^ sw_) << 4));
}
__device__ __forceinline__ void idx_unit(LAS unsigned char* lds, const int wave, unsigned char* ws, int b, int qt, const int dry) {
    const int lane = fresh_lane(), r32 = lane & 31, hi = lane >> 5, tid = wave * 64 + lane;
    const int chunk = qt >> 1;
    const size_t tok0 = (size_t)b * SEQ + (size_t)qt * 32;
    unsigned* MASK32 = (unsigned*)(ws + WS_MASK);
    if (chunk < 4) {
        if (!dry) for (int t = wave; t <= chunk; t += 8) MASK32[((size_t)(b * 128 + t) * SEQ + qt * 32 + r32) * 2 + hi] = 0xFFFFFFFFu;
        return;
    }
    const bf16_t* KIb = (const bf16_t*)(ws + WS_KI) + (size_t)b * SEQ * 64;
    LAS unsigned* HIST = (LAS unsigned*)(lds + IX_HIST);
    LAS float* CK = (LAS float*)(lds + IX_CK);
    LAS unsigned short* CI = (LAS unsigned short*)(lds + IX_CI);
    LAS unsigned* BM = (LAS unsigned*)(lds + IX_BM);
    LAS int* META = (LAS int*)(lds + IX_META);
    { const unsigned ldsb_ = (unsigned)(unsigned long long)lds; const int lq_ = fresh_lane();
#pragma unroll
      for (int rr = 0; rr < 4; ++rr) { const int row_ = wave * 4 + rr;
          glds16((const bf16_t*)(ws + WS_QI) + (tok0 + row_) * 512 + lq_ * 8, (unsigned)__builtin_amdgcn_readfirstlane(ldsb_ + IX_QS + row_ * IX_QPITCH)); } }
#define IX_LOADQ(qf) do { const int l_ = fresh_lane(); const LAS unsigned char* qp_ = lds + IX_QS + (l_ & 31) * IX_QPITCH + (l_ >> 5) * 16; \
        _Pragma("unroll") for (int h = 0; h < 8; ++h) _Pragma("unroll") for (int s = 0; s < 4; ++s) qf[h][s] = *(const LAS bf16x8*)(qp_ + h * 128 + s * 32); } while (0)
    float a[8]; float R;
    { const float* np = (const float*)(ws + WS_QIN) + (tok0 + r32) * 8;
      const f32x4 n0 = *(const f32x4*)np, n1 = *(const f32x4*)(np + 4);
#pragma unroll
      for (int h = 0; h < 4; ++h) { a[h] = 0.5f * n0[h]; a[4 + h] = 0.5f * n1[h]; }
      R = (((fabsf(n0[0]) + fabsf(n0[1])) + (fabsf(n0[2]) + fabsf(n0[3]))) + ((fabsf(n1[0]) + fabsf(n1[1])) + (fabsf(n1[2]) + fabsf(n1[3])))) * 1.03f;
      R = fmaxf(R, 1e-30f); }
    float scale; const float Rs = (float)(IX_NB / 2);
    const LAS unsigned char* kbuf = lds + IX_QS + wave * 4096;
    const unsigned kbuf_a = (unsigned)__builtin_amdgcn_readfirstlane((unsigned)(unsigned long long)lds + IX_QS + wave * 4096);
    bf16x8 qf[8][4], qc[4];
    const int nkt = 2 * (chunk + 1);
#pragma unroll 1
    for (int att = 0; att < 2; ++att) {
    scale = (float)(IX_NB / 2) * (att ? 1.0f : IX_FINE) / R;
    for (int i = tid; i < 32 * IX_HSTR; i += NWAVES * 64) HIST[i] = 0u;
    for (int i = tid; i < 32 * IX_BSTR; i += NWAVES * 64) BM[i] = 0u;
    if (tid < 132) META[tid] = 0;
    asm volatile("s_waitcnt vmcnt(0)" ::: "memory");
    LDS_WAIT(); __builtin_amdgcn_s_barrier(); asm volatile("" ::: "memory");
#if defined(PROBE_IDX_DRY)
    if (dry == 5) return;
#endif
    {
        if (att == 0) { IX_LOADQ(qf); ix_combine(qc, qf, a); }
#if defined(PROBE_IDX_DRY)
        if (dry == 6) { asm volatile("" :: "v"(qc[0]), "v"(qc[1]), "v"(qc[2]), "v"(qc[3])); return; }
#endif
        bf16x8 kf[4];
        if (att == 0) { LDS_WAIT(); __builtin_amdgcn_s_barrier(); asm volatile("" ::: "memory"); }
        if (wave < nkt) ix_dmak(KIb, wave, kbuf_a);
#pragma unroll 1
        for (int kt = wave; kt < nkt; kt += 8) {
            asm volatile("s_waitcnt vmcnt(0)" ::: "memory");
            ix_readk(kf, kbuf);
            asm volatile("s_waitcnt lgkmcnt(0)" : "+v"(kf[0]), "+v"(kf[1]), "+v"(kf[2]), "+v"(kf[3]) :: "memory");
            if (kt + 8 < nkt) ix_dmak(KIb, kt + 8, kbuf_a);
            f32x16 sc;
            ix_scores(sc, kf, qf, qc, a);
#pragma unroll
            for (int r = 0; r < 16; ++r) {
                const int bin = ix_bin(sc[r], Rs, scale);
                __hip_atomic_fetch_add(HIST + r32 * IX_HSTR + bin, 1u, __ATOMIC_RELAXED, __HIP_MEMORY_SCOPE_WORKGROUP);
            }
        }
    }
    LDS_WAIT(); __builtin_amdgcn_s_barrier(); asm volatile("" ::: "memory");
#if defined(PROBE_IDX_DRY)
    if (dry == 7) return;
#endif
#pragma unroll 1
    for (int i = 0; i < 4; ++i) {
        const int q = wave * 4 + i;
        int lane8 = 8 * lane; asm volatile("" : "+v"(lane8));
        unsigned wv[8]; unsigned c = 0;
#pragma unroll
        for (int w = 0; w < 8; ++w) { wv[w] = HIST[q * IX_HSTR + lane8 + w]; c += wv[w]; }
        unsigned x = c;
#pragma unroll
        for (int off = 1; off < 64; off <<= 1) { const unsigned y = __shfl_down(x, off); if (lane + off < 64) x += y; }
        const unsigned sx = x - c;
        if (sx < 256u && x >= 256u) {
            unsigned cum = sx; int found = 0, tb = 0, kr = 0, tc = 0;
#pragma unroll
            for (int w = 7; w >= 0; --w) {
                if (!found) { if (cum + wv[w] >= 256u) { found = 1; tb = lane8 + w; kr = 256 - (int)cum; tc = (int)wv[w]; } else cum += wv[w]; }
            }
            META[q] = tb; META[32 + q] = kr; META[64 + q] = tc;
            if (tc > IX_CAP) META[128] = 1;
        }
    }
    LDS_WAIT(); __builtin_amdgcn_s_barrier(); asm volatile("" ::: "memory");
    if (att == 1 || META[128] == 0) break;
    LDS_WAIT(); __builtin_amdgcn_s_barrier(); asm volatile("" ::: "memory");
    }
    if (dry == 1) return;
    {
        const int tb = META[r32];
        const float fl = (tb <= 0) ? -__builtin_inff() : (float)tb, fh = (tb >= IX_NB - 1) ? __builtin_inff() : (float)(tb + 1);
        bf16x8 kf[4];
        if (wave < nkt) ix_dmak(KIb, wave, kbuf_a);
#pragma unroll 1
        for (int kt = wave; kt < nkt; kt += 8) {
            asm volatile("s_waitcnt vmcnt(0)" ::: "memory");
            ix_readk(kf, kbuf);
            asm volatile("s_waitcnt lgkmcnt(0)" : "+v"(kf[0]), "+v"(kf[1]), "+v"(kf[2]), "+v"(kf[3]) :: "memory");
            if (kt + 8 < nkt) ix_dmak(KIb, kt + 8, kbuf_a);
            f32x16 sc;
            ix_scores(sc, kf, qf, qc, a);
            unsigned sb = 0u, cb = 0u;
#pragma unroll
            for (int r = 15; r >= 1; r -= 2) {
                const float f1 = __builtin_fmaf(sc[r], scale, Rs), f0 = __builtin_fmaf(sc[r - 1], scale, Rs);
                unsigned long long t0, t1, t2, t3;
                asm("v_cmp_ge_f32_e64 %2, %6, %8\n\tv_cmp_ge_f32_e64 %3, %7, %8\n\tv_cmp_ge_f32_e64 %4, %6, %9\n\tv_cmp_ge_f32_e64 %5, %7, %9\n\t"
                    "v_addc_co_u32_e64 %0, vcc, %0, %0, %2\n\tv_addc_co_u32_e64 %0, vcc, %0, %0, %3\n\tv_addc_co_u32_e64 %1, vcc, %1, %1, %4\n\tv_addc_co_u32_e64 %1, vcc, %1, %1, %5"
                    : "+v"(sb), "+v"(cb), "=&s"(t0), "=&s"(t1), "=&s"(t2), "=&s"(t3) : "v"(f1), "v"(f0), "v"(fh), "v"(fl) : "vcc");
            }
            const unsigned cbits = cb & ~sb;
            if (__ballot(cbits != 0u)) {
                int base = 0;
                if (cbits) base = __hip_atomic_fetch_add(META + 96 + r32, __popc(cbits), __ATOMIC_RELAXED, __HIP_MEMORY_SCOPE_WORKGROUP);
#pragma unroll
                for (int r = 0; r < 16; ++r) {
                    const bool c = (cbits >> r) & 1u;
                    if (__ballot(c)) {
                        if (c) { if (base < IX_CAP) { CK[r32 * IX_CAP + base] = sc[r]; CI[r32 * IX_CAP + base] = (unsigned short)(kt * 32 + (r & 3) + 8 * (r >> 2) + 4 * hi); } ++base; }
                    }
                }
            }
            unsigned bits = (sb & 0xFu) | ((sb & 0xF0u) << 4) | ((sb & 0xF00u) << 8) | ((sb & 0xF000u) << 12);
            bits <<= 4 * hi;
            bits |= __shfl_xor(bits, 32);
            if (hi == 0) BM[r32 * IX_BSTR + kt] = bits;
        }
    }
    LDS_WAIT(); __builtin_amdgcn_s_barrier(); asm volatile("" ::: "memory");
    if (dry == 2) return;
    {
        const int q0 = wave * 4;
        unsigned key[4][5]; int kr[4], cq[4]; unsigned prefix[4];
        int maxc = 0; unsigned dmax = 0u;
#pragma unroll
        for (int i = 0; i < 4; ++i) {
            int c = META[96 + q0 + i]; c = c > IX_CAP ? IX_CAP : c; cq[i] = c; maxc = c > maxc ? c : maxc;
            kr[i] = META[32 + q0 + i];
            unsigned orv = 0u, andv = 0xFFFFFFFFu;
#pragma unroll
            for (int sl = 0; sl < 5; ++sl) {
                const int e = lane + 64 * sl; const bool v = e < c;
                const unsigned u = v ? __float_as_uint(CK[(q0 + i) * IX_CAP + e]) : 0u;
                const unsigned k = (u & 0x80000000u) ? ~u : (u | 0x80000000u);
                key[i][sl] = v ? k : 0u; orv |= key[i][sl]; andv &= v ? k : 0xFFFFFFFFu;
            }
#pragma unroll
            for (int o = 1; o < 64; o <<= 1) { orv |= (unsigned)__shfl_xor((int)orv, o); andv &= (unsigned)__shfl_xor((int)andv, o); }
            const unsigned diff = orv ^ andv;
            const unsigned low = diff ? (0xFFFFFFFFu >> __builtin_clz(diff)) : 0u;
            prefix[i] = (c > 0) ? (andv & ~low) : 0u; dmax |= diff;
        }
        maxc = __builtin_amdgcn_readfirstlane(maxc); dmax = __builtin_amdgcn_readfirstlane(dmax);
        const int nsl = (maxc + 63) >> 6;
#pragma unroll 1
        for (int bit = dmax ? 31 - __builtin_clz(dmax) : -1; bit >= 0; --bit) {
            int cnt[4] = {0, 0, 0, 0};
#pragma unroll
            for (int sl = 0; sl < 5; ++sl) if (sl < nsl) {
#pragma unroll
                for (int i = 0; i < 4; ++i) cnt[i] += __popcll(__ballot(key[i][sl] >= (prefix[i] | (1u << bit))));
            }
#pragma unroll
            for (int i = 0; i < 4; ++i) prefix[i] = (cnt[i] >= kr[i]) ? (prefix[i] | (1u << bit)) : prefix[i];
        }
#pragma unroll
        for (int i = 0; i < 4; ++i) {
            const int q = q0 + i;
            int cgt = 0, ceq = 0;
#pragma unroll
            for (int sl = 0; sl < 5; ++sl) if (sl < nsl) { const bool v = lane + 64 * sl < cq[i];
                cgt += __popcll(__ballot(v && key[i][sl] > prefix[i])); ceq += __popcll(__ballot(v && key[i][sl] == prefix[i])); }
            const int need = kr[i] - cgt;
            int idx[5];
#pragma unroll
            for (int sl = 0; sl < 5; ++sl) { const int e = lane + 64 * sl; idx[sl] = (e < cq[i]) ? (int)CI[q * IX_CAP + e] : 0x7fffffff; }
            int ithr = 0x7fffffff;
            if (need < ceq) {
                int pre = 0;
#pragma unroll 1
                for (int bit = 12; bit >= 0; --bit) {
                    const int trial = pre | (1 << bit); int cnt = 0;
#pragma unroll
                    for (int sl = 0; sl < 5; ++sl) cnt += __popcll(__ballot(lane + 64 * sl < cq[i] && key[i][sl] == prefix[i] && idx[sl] < trial));
                    if (cnt < need) pre = trial;
                }
                ithr = pre;
            }
#pragma unroll
            for (int sl = 0; sl < 5; ++sl)
                if (lane + 64 * sl < cq[i] && (key[i][sl] > prefix[i] || (key[i][sl] == prefix[i] && idx[sl] <= ithr)))
                    __hip_atomic_fetch_or(BM + q * IX_BSTR + (idx[sl] >> 5), 1u << (idx[sl] & 31), __ATOMIC_RELAXED, __HIP_MEMORY_SCOPE_WORKGROUP);
        }
    }
    LDS_WAIT(); __builtin_amdgcn_s_barrier(); asm volatile("" ::: "memory");
#undef IX_LOADQ
    if (dry) return;
    { const int lw = fresh_lane();
      for (int t = wave; t <= chunk; t += 8) MASK32[((size_t)(b * 128 + t) * SEQ + qt * 32) * 2 + (unsigned)(((lw & 31) << 1) | (lw >> 5))] = BM[(lw & 31) * IX_BSTR + 2 * t + (lw >> 5)]; }
    LDS_WAIT(); __builtin_amdgcn_s_barrier(); asm volatile("" ::: "memory");
}
__device__ __forceinline__ void idx_phase(LAS unsigned char* lds, const int wave, unsigned char* ws) {
    for (int v = blockIdx.x; v < 256; v += gridDim.x) {
        const int b = v >> 7, j = v & 127;
#if defined(PROBE_IDX_DRY)
#pragma unroll 1
        for (int u = 0; u < 6; ++u) idx_unit(lds, wave, ws, b, (u & 1) ? 255 - j : j, u < 2 ? 0 : PROBE_IDX_DRY);
#else
#pragma unroll 1
        for (int u = 0; u < 2; ++u) idx_unit(lds, wave, ws, b, u ? 255 - j : j, 0);
#endif
    }
}
struct Args { const float* in[22]; float* out; unsigned char* ws; int ph_lo, ph_hi, coop, pad; };
enum Phase { P_PRO = 0, P_IN0, P_ATT0, P_OUT0, P_UP0, P_DN0, P_IN1, P_QUP, P_IDX, P_ATT1, P_OUT1, P_UP1, P_DN1, P_N, P_BRIDGE = 20 };

constexpr int CTL_ROWCNT = 4096;
struct In1Order : pg8::StaticOrder {
    unsigned* cnt; int wave;
    __device__ __forceinline__ bool next(int i, pg8::Unit& u) const { if (!pg8::StaticOrder::next(i, u)) return false; u.pn = (u.pn == 1) ? 9 : (u.pn == 9) ? 1 : u.pn; return true; }
    __device__ __forceinline__ void a_ready(const pg8::Unit&) const {}
    __device__ __forceinline__ void done(const pg8::Unit& u) const {
        if (u.pn == 0 || u.pn == 9) {
            asm volatile("s_waitcnt vmcnt(0)" ::: "memory");
            __builtin_amdgcn_s_barrier();
            if (wave == 0) {
                __builtin_amdgcn_fence(__ATOMIC_RELEASE, "agent");
                asm volatile("s_waitcnt vmcnt(0)" ::: "memory");
                if (fresh_lane() == 0) (void)xb_add(&cnt[u.pm * 16], 8u);
            }
        }
    }
};
__device__ __forceinline__ void qup_wait_rows(const pg8::StaticOrder& S, unsigned* cnt, unsigned* tmo, const unsigned need = 16u) {
#pragma unroll 1
    for (int i = 0; ; ++i) {
        pg8::Unit u; if (!S.next(i, u)) break;
        unsigned sp = 0;
        while (xb_ld(&cnt[u.pm * 16]) < need) { __builtin_amdgcn_s_sleep(1); if ((++sp & 255u) == 0u) { if (xb_ld(tmo)) break; if (sp > XB_SPIN_CAP) { atomicAdd(tmo, 1u); break; } } }
    }
    __builtin_amdgcn_fence(__ATOMIC_ACQUIRE, "agent");
}
template <class Epi> __device__ __forceinline__ void run_gemm(LAS unsigned char* lds, const int wave, const bf16_t* A, const bf16_t* Bt, int N, int K, const Epi& E) {
    pg8::Gemm g{A, Bt, TOK, N, K}; pg8::StaticOrder S; S.init(TOK, N, (int)gridDim.x, (int)blockIdx.x);
    pg8::gemm_phase<Epi, pg8::StaticOrder, true, true>(lds, g, S, E, wave, fresh_lane());
}
__global__ void __launch_bounds__(NWAVES * 64, 2) mk_fwd(Args args) {
    extern __shared__ __attribute__((aligned(16))) unsigned char lds_raw[];
    LAS unsigned char* lds = (LAS unsigned char*)lds_raw;
    const int wave = __builtin_amdgcn_readfirstlane(threadIdx.x >> 6);
    const int G = gridDim.x;
    unsigned char* ws = args.ws;
    const int lo = args.ph_lo, hi = args.ph_hi;
    volatile LAS unsigned* MISC = (volatile LAS unsigned*)(lds + MISC_OFF);
    { const int tid = wave * 64 + fresh_lane(); for (int u = tid; u < (LDS_BYTES - RING_BYTES) / 4; u += NWAVES * 64) ((LAS unsigned*)(lds + RING_BYTES))[u] = 0u; }
    __syncthreads();
    XcdBarrier bar; bar.bar = (unsigned*)(ws + WS_CTL); bar.x = 0; bar.st = nullptr;
    if (args.coop) bar = xcd_barrier_post((unsigned*)(ws + WS_CTL), MISC + 8);
#define IN(k) (lo <= (k) && (k) < hi)
#define NREP(k) ((PROBE_PHASE == (k)) ? 3 : 1)
#define SEAM(k) do { if (args.coop && IN(k) && IN((k) + 1)) xcd_barrier(bar, wave); } while (0)
    LAS float* ETBL = (LAS float*)(lds + EPI_TBL_OFF + wave * 512);
    bf16_t* XB = (bf16_t*)(ws + WS_XB); bf16_t* QB = (bf16_t*)(ws + WS_Q); bf16_t* KB = (bf16_t*)(ws + WS_K); bf16_t* VB = (bf16_t*)(ws + WS_V); bf16_t* UB = (bf16_t*)(ws + WS_U);
    float* PART = (float*)(ws + WS_PART); float* CS = (float*)(ws + WS_CS); float* LAM = (float*)(ws + WS_MISC);

    if (IN(P_PRO)) for (int rep_ = 0; rep_ < NREP(P_PRO); ++rep_) {
        const int lane = fresh_lane(), tid = wave * 64 + lane;
        LAS float* scr = (LAS float*)(lds + wave * 16384);
        const int gw = blockIdx.x * NWAVES + wave, NGW = G * NWAVES;
        const float* nmix = args.in[2]; const float* nmlp = args.in[3];
        int base = 0;
#define DOJOB(W_, gain_, WT_, K_, N_, Npad_, roff_) do { const int nblk = (Npad_) / 32, nitems = ((K_) / 64) * nblk; \
            for (int it = (gw - base % NGW + NGW) % NGW; it < nitems; it += NGW) p0_transpose_item((W_), (K_), (N_), (gain_), (bf16_t*)(ws + (WT_)), (roff_), scr, it, nblk, lane); \
            base += nitems; } while (0)
        DOJOB(args.in[6], nmix, WS_WIN0, DM, 3072, 3072, 0);
        DOJOB(args.in[14], (const float*)nullptr, WS_WOUT0, DM, DM, DM, 0);
        DOJOB(args.in[4], nmlp, WS_W1_0, DM, DFF, DFF, 0);
        DOJOB(args.in[5], (const float*)nullptr, WS_W2_0, DFF, DM, DM, 0);
        DOJOB(args.in[15], nmix + DM, WS_WIN1, DM, NIN1, NIN1P, 0);
        DOJOB(args.in[17], args.in[16], WS_WUQ, 256, DM, DM, 0);
        DOJOB(args.in[18], args.in[16], WS_WUQ, 256, 512, 512, 1024);
        DOJOB(args.in[21], (const float*)nullptr, WS_WOUT1, DM, DM, DM, 0);
        DOJOB(args.in[4] + (size_t)DM * DFF, nmlp + DM, WS_W1_1, DM, DFF, DFF, 0);
        DOJOB(args.in[5] + (size_t)DM * DFF, (const float*)nullptr, WS_W2_1, DFF, DM, DM, 0);
#undef DOJOB
        if (TOK % (4 * NGW) == 0) { for (int m = gw; m < TOK; m += 4 * NGW) rows_to_bf16<4>(args.in[0], XB, PART, m, NGW, lane); }
        else { for (int m = gw; m < TOK; m += NGW) rows_to_bf16<1>(args.in[0], XB, PART, m, NGW, lane); }
        const int* pos = (const int*)args.in[1];
        for (int t = blockIdx.x * (NWAVES * 64) + tid; t < TOK * 8; t += G * NWAVES * 64) {
            const int tok = t >> 3, i = t & 7;
            const float inv = (float)pow(500000.0, -(double)i / 8.0);
            const float ang = (float)pos[tok] * inv;
            CS[tok * 16 + i] = (float)cos((double)ang); CS[tok * 16 + 8 + i] = (float)sin((double)ang);
        }
        if (blockIdx.x == 0 && tid == 0) {
            float s1 = 0.f, s2 = 0.f;
            for (int i = 0; i < 64; ++i) { s1 += args.in[9][i] * args.in[10][i]; s2 += args.in[11][i] * args.in[12][i]; }
            LAM[0] = expf(s1) - expf(s2) + 0.2f;
        }
    }
    SEAM(P_PRO);
    if (IN(P_BRIDGE)) {
        const int lane = fresh_lane();
        const int gw = blockIdx.x * NWAVES + wave, NGW = G * NWAVES;
        for (int m = gw; m < TOK; m += NGW) rows_to_bf16<1>(args.out, XB, PART, m, NGW, lane);
    }
    if (IN(P_IN0)) { for (int rep_ = 0; rep_ < NREP(P_IN0); ++rep_) { EpiQKV0 E{PART, CS, args.in[7], args.in[8], QB, (size_t)(WS_K - WS_Q) / 2, 0.125f * LOG2E, ETBL}; run_gemm(lds, wave, XB, (const bf16_t*)(ws + WS_WIN0), 3072, DM, E); } }
    SEAM(P_IN0);
    if (IN(P_ATT0)) { for (int rep_ = NREP(P_ATT0) - 1; rep_ >= 0; --rep_) attn0_phase(lds, wave, ws, args.in[13], rep_ != 0); }
    SEAM(P_ATT0);
    if (IN(P_OUT0)) { for (int rep_ = 0; rep_ < NREP(P_OUT0); ++rep_) { EpiResidT<true, false> E{nullptr, XB, nullptr, XB, PART}; run_gemm(lds, wave, QB, (const bf16_t*)(ws + WS_WOUT0), DM, DM, E); } }
    SEAM(P_OUT0);
    if (IN(P_UP0)) { for (int rep_ = 0; rep_ < NREP(P_UP0); ++rep_) { EpiUp E{PART, UB, ETBL}; run_gemm(lds, wave, XB, (const bf16_t*)(ws + WS_W1_0), DFF, DM, E); } }
    SEAM(P_UP0);
    if (IN(P_DN0)) { EpiResidT<true, false> E{nullptr, XB, nullptr, XB, PART}; run_gemm(lds, wave, UB, (const bf16_t*)(ws + WS_W2_0), DM, DFF, E); }
    SEAM(P_DN0);
    if (IN(P_IN1)) { for (int rep_ = 0; rep_ < NREP(P_IN1); ++rep_) { EpiIn1 E{PART, CS, args.in[20], (bf16_t*)(ws + WS_CQ), (float*)(ws + WS_CQP), KB, VB, (bf16_t*)(ws + WS_KI), (float*)(ws + WS_WIDX), 0.35355339059327373f * 0.125f, ETBL};
        pg8::Gemm g{XB, (const bf16_t*)(ws + WS_WIN1), TOK, NIN1P, DM}; In1Order S; S.init(TOK, NIN1P, G, (int)blockIdx.x); S.cnt = (unsigned*)(ws + WS_CTL) + CTL_ROWCNT; S.wave = wave;
        pg8::gemm_phase<EpiIn1, In1Order, true, true>(lds, g, S, E, wave, fresh_lane()); } }
    if (IN(P_QUP)) { for (int rep_ = 0; rep_ < NREP(P_QUP); ++rep_) { EpiQup E{(const float*)(ws + WS_CQP), CS, args.in[19], (const float*)(ws + WS_WIDX), QB, (bf16_t*)(ws + WS_QI), (float*)(ws + WS_QIN), 0.125f * LOG2E, ETBL};
        const int c = (int)blockIdx.x, cm = (G % 8 == 0) ? ((c & 7) | ((G / 8 - 1 - (c >> 3)) << 3)) : c;
        pg8::Gemm g{(const bf16_t*)(ws + WS_CQ), (const bf16_t*)(ws + WS_WUQ), TOK, 1536, 256}; pg8::StaticOrder S; S.init(TOK, 1536, G, cm);
        qup_wait_rows(S, (unsigned*)(ws + WS_CTL) + CTL_ROWCNT, (unsigned*)(ws + WS_CTL) + XB_TMO);
        pg8::gemm_phase<EpiQup, pg8::StaticOrder, true, true>(lds, g, S, E, wave, fresh_lane()); } }
    SEAM(P_QUP);
    if (IN(P_IDX)) { for (int rep_ = 0; rep_ < NREP(P_IDX); ++rep_) { idx_phase(lds, wave, ws); } }
    SEAM(P_IDX);
    if (IN(P_ATT1)) { for (int rep_ = NREP(P_ATT1) - 1; rep_ >= 0; --rep_) attn1_phase(lds, wave, ws, rep_ != 0); }
    SEAM(P_ATT1);
    if (IN(P_OUT1)) { EpiResidT<true, false> E{nullptr, XB, nullptr, XB, PART}; run_gemm(lds, wave, QB, (const bf16_t*)(ws + WS_WOUT1), DM, DM, E); }
    SEAM(P_OUT1);
    if (IN(P_UP1)) { for (int rep_ = 0; rep_ < NREP(P_UP1); ++rep_) { EpiUp E{PART, UB, ETBL}; run_gemm(lds, wave, XB, (const bf16_t*)(ws + WS_W1_1), DFF, DM, E); } }
    SEAM(P_UP1);
    if (IN(P_DN1)) { EpiResidT<true, true> E{nullptr, XB, args.out, nullptr, nullptr}; run_gemm(lds, wave, UB, (const bf16_t*)(ws + WS_W2_1), DM, DFF, E); }
#undef IN
#undef SEAM
}

static int g_mk_ready = 0;
static void mk_launch(hipStream_t st, void* const* d_in, void* d_out, void* d_ws, int lo, int hi, int coop) {
    if (!g_mk_ready) { (void)hipFuncSetAttribute((const void*)mk_fwd, hipFuncAttributeMaxDynamicSharedMemorySize, LDS_BYTES); g_mk_ready = 1; }
    Args a{};
    for (int i = 0; i < 22; ++i) a.in[i] = (const float*)d_in[i];
    a.out = (float*)d_out; a.ws = (unsigned char*)d_ws; a.ph_lo = lo; a.ph_hi = hi; a.coop = coop; a.pad = 0;
    hipLaunchKernelGGL(mk_fwd, dim3(256), dim3(NWAVES * 64), LDS_BYTES, st, a);
}

extern "C" void kernel_launch(void* const* d_in, const int* in_sizes, int n_in, void* d_out, int out_size, void* d_ws, size_t ws_size, hipStream_t stream) {
    static int grid = 0;
    if (grid == 0) {
        int dev = 0, cus = 0, per_cu = 0;
        (void)hipGetDevice(&dev);
        (void)hipDeviceGetAttribute(&cus, hipDeviceAttributeMultiprocessorCount, dev);
        (void)hipFuncSetAttribute((const void*)mk_fwd, hipFuncAttributeMaxDynamicSharedMemorySize, LDS_BYTES);
        (void)hipOccupancyMaxActiveBlocksPerMultiprocessor(&per_cu, (const void*)mk_fwd, NWAVES * 64, LDS_BYTES);
        if (per_cu < 1) per_cu = 1;
        if (per_cu > 1) per_cu = 1;
        grid = cus * per_cu; if (grid > 256) grid = 256; if (grid < 1) grid = 1;
        if (ws_size < WS_END) { fprintf(stderr, "kernel_launch: workspace too small (%zu)\n", ws_size); }
    }
    (void)hipMemsetAsync((char*)d_ws + WS_CTL, 0, CTL_BYTES, stream);
    Args a{};
    for (int i = 0; i < 22; ++i) a.in[i] = (const float*)d_in[i];
    a.out = (float*)d_out; a.ws = (unsigned char*)d_ws; a.ph_lo = 0; a.ph_hi = P_N; a.coop = 1; a.pad = 0;
    void* kargs[] = {&a};
    hipError_t e = hipLaunchCooperativeKernel((const void*)mk_fwd, dim3(grid), dim3(NWAVES * 64), kargs, LDS_BYTES, stream);
    if (e != hipSuccess) fprintf(stderr, "cooperative launch failed: %s (grid %d)\n", hipGetErrorString(e), grid);
}
```
